# Optimizing an MI355X kernel written in HIP

```python
import jax, jax.numpy as jnp
from jax import lax
import numpy as np

D_MODEL = 1024
BATCH = 4
SEQ = 8192
DEPTH = 2

GRID_W = 64
CTX_LEN = 256
N_EVEN = (DEPTH + 1) // 2
N_ODD = DEPTH // 2
N_MOD = 6

POOL_WINDOWS = (2, 4, 8, 16)
POOL_GROUPS = len(POOL_WINDOWS)
D_POOL = D_MODEL // 2
POOL_GW = D_POOL // POOL_GROUPS
D_CONV = D_MODEL // 2
CONV_W = 31
AB_IN = D_POOL + 2 * D_CONV
AB_MIX = D_POOL + D_CONV
MLSTM_HEADS = 4
MLSTM_DH = D_MODEL // 8
D_MLSTM = MLSTM_HEADS * MLSTM_DH
MLSTM_CHUNK = 128
N_GATE = 4 * MLSTM_HEADS
ATT_QH = 8
ATT_KVH = 2
ATT_DH = D_MODEL // 16
ATT_GROUP = ATT_QH // ATT_KVH
ATT_BLOCK = 128
ROPE_THETA = 10000.0
ROPE_F = ATT_DH // 4
CD_SPLITS = (D_MLSTM, D_MLSTM, D_MLSTM, D_MLSTM, N_GATE, ATT_QH * ATT_DH, ATT_KVH * ATT_DH, ATT_KVH * ATT_DH)
CD_IN = sum(CD_SPLITS)
CD_CUTS = tuple(sum(CD_SPLITS[:i + 1]) for i in range(len(CD_SPLITS) - 1))
CD_MIX = D_MLSTM + ATT_QH * ATT_DH
PEER_HEADS = 8
PEER_NKEYS = 128
PEER_N = PEER_NKEYS * PEER_NKEYS
PEER_TOPK = 16
PEER_DKEY = 256
PEER_BLOCK = 128
DN_ALPHA = (2 * DEPTH) ** 0.25
DN_BETA = (8 * DEPTH) ** -0.25
LN_EPS = 1e-5
RMS_EPS = 1e-6

kernel_name = "hybrid_pool_conv_mlstm_gqa_peer_trunk"

F32 = jnp.float32


def layer_norm(x, g, b):
    xf = x.astype(F32)
    mu = jnp.mean(xf, -1, keepdims=True)
    var = jnp.mean(jnp.square(xf - mu), -1, keepdims=True)
    return ((xf - mu) * lax.rsqrt(var + LN_EPS) * g + b).astype(x.dtype)


def rms_norm(x, g):
    xf = x.astype(F32)
    return (xf * lax.rsqrt(jnp.mean(xf * xf, -1, keepdims=True) + RMS_EPS) * g).astype(x.dtype)


def multiscale_pool(xa, w_pool, ls_pool):
    T = xa.shape[1]
    xf = xa.astype(F32)
    cs = jnp.concatenate([jnp.zeros_like(xf[:, :1]), jnp.cumsum(xf, axis=1)], axis=1)
    t = jnp.arange(T)
    outs = []
    for g, w in enumerate(POOL_WINDOWS):
        lo = jnp.clip(t - w // 2, 0, T)
        hi = jnp.clip(t + w // 2, 0, T)
        sl = slice(g * POOL_GW, (g + 1) * POOL_GW)
        csg = cs[:, :, sl]
        mean = (csg[:, hi] - csg[:, lo]) / (hi - lo).astype(F32)[None, :, None]
        outs.append((mean - xf[:, :, sl]).astype(xa.dtype) @ w_pool[g])
    return jnp.concatenate(outs, axis=-1) * ls_pool


def conformer_conv(xb, conv_w, conv_b, ln_g, ln_b):
    a, gt = jnp.split(xb, 2, axis=-1)
    u = a * jax.nn.sigmoid(gt)
    y = lax.conv_general_dilated(u, conv_w[:, None, :], window_strides=(1,),
                                 padding=[(CONV_W // 2, CONV_W // 2)],
                                 dimension_numbers=('NWC', 'WIO', 'NWC'),
                                 feature_group_count=D_CONV) + conv_b
    return jax.nn.silu(layer_norm(y, ln_g, ln_b))


def mixer_ab(h, w_in, w_pool, ls_pool, conv_w, conv_b, cln_g, cln_b, w_out):
    z = h @ w_in
    ya = multiscale_pool(z[..., :D_POOL], w_pool, ls_pool)
    yb = conformer_conv(z[..., D_POOL:], conv_w, conv_b, cln_g, cln_b)
    return jnp.concatenate([ya, yb], axis=-1) @ w_out


def mlstm_chunkwise(q, k, v, ig, fg, state):
    B_, H, T, _ = q.shape
    L = MLSTM_CHUNK
    nc = T // L

    def chunks(a):
        return jnp.moveaxis(a.reshape(B_, H, nc, L, *a.shape[3:]), 2, 0)

    causal = jnp.tril(jnp.ones((L, L), dtype=bool))

    def step(carry, inp):
        C, n, m = carry
        qj, kj, vj, ij, fj = inp
        b = jnp.cumsum(jax.nn.log_sigmoid(fj), axis=-1)
        dmat = jnp.where(causal, b[..., :, None] - b[..., None, :] + ij[..., None, :], -jnp.inf)
        inter = b + m[..., None]
        m_t = jnp.maximum(inter, jnp.max(dmat, -1))
        w_inter = jnp.exp(inter - m_t)
        s = jnp.einsum('bhid,bhjd->bhij', qj, kj) * jnp.exp(dmat - m_t[..., None])
        num = jnp.einsum('bhij,bhjv->bhiv', s, vj) + w_inter[..., None] * jnp.einsum('bhid,bhdv->bhiv', qj, C)
        den = jnp.sum(s, -1) + w_inter * jnp.einsum('bhid,bhd->bhi', qj, n)
        h = num / jnp.maximum(jnp.abs(den), jnp.exp(-m_t))[..., None]
        b_last = b[..., -1]
        g_log = b_last[..., None] - b + ij
        m_new = jnp.maximum(b_last + m, jnp.max(g_log, -1))
        wk = jnp.exp(g_log - m_new[..., None])
        decay = jnp.exp(b_last + m - m_new)
        C_new = decay[..., None, None] * C + jnp.einsum('bhj,bhjd,bhjv->bhdv', wk, kj, vj)
        n_new = decay[..., None] * n + jnp.einsum('bhj,bhjd->bhd', wk, kj)
        return (C_new, n_new, m_new), h

    state, hs = lax.scan(step, state, tuple(chunks(a) for a in (q, k, v, ig, fg)))
    return jnp.moveaxis(hs, 0, 2).reshape(B_, H, T, -1), state


def mlstm_direction(q, k, v, ig, fg, state, reverse):
    if reverse:
        q, k, v, ig, fg = (jnp.flip(a, axis=2) for a in (q, k, v, ig, fg))
    h, state = mlstm_chunkwise(q, k, v, ig, fg, state)
    if reverse:
        h = jnp.flip(h, axis=2)
    return h, state


def mlstm_inputs(zq, zk, zv, zg, gate_b):
    B_, T, _ = zq.shape

    def heads(a):
        return a.reshape(B_, T, MLSTM_HEADS, MLSTM_DH).transpose(0, 2, 1, 3).astype(F32)

    g = (zg.astype(F32).reshape(B_, T, 4, MLSTM_HEADS) + gate_b.astype(F32)).transpose(2, 0, 3, 1)
    return heads(zq), heads(zk) * (MLSTM_DH ** -0.5), heads(zv), g


def mlstm_out(h, o_pre, norm_g):
    B_, H, T, dv = h.shape
    mu = jnp.mean(h, -1, keepdims=True)
    var = jnp.mean(jnp.square(h - mu), -1, keepdims=True)
    hn = ((h - mu) * lax.rsqrt(var + LN_EPS)).transpose(0, 2, 1, 3).reshape(B_, T, H * dv) * norm_g
    return (hn * jax.nn.sigmoid(o_pre.astype(F32))).astype(o_pre.dtype)


def mlstm_zero_state(b_):
    return (jnp.zeros((b_, MLSTM_HEADS, MLSTM_DH, MLSTM_DH), F32),
            jnp.zeros((b_, MLSTM_HEADS, MLSTM_DH), F32),
            jnp.zeros((b_, MLSTM_HEADS), F32))


def axial_rope_tables(row, col):
    freqs = ROPE_THETA ** (-jnp.arange(ROPE_F, dtype=F32) / ROPE_F)
    ar = row.astype(F32)[:, None] * freqs
    ac = col.astype(F32)[:, None] * freqs
    return (jnp.cos(ar), jnp.sin(ar), jnp.cos(ac), jnp.sin(ac))


def rope_1d(x, cos, sin):
    x1, x2 = jnp.split(x, 2, axis=-1)
    cos, sin = cos[:, None, :], sin[:, None, :]
    return jnp.concatenate([x1 * cos - x2 * sin, x1 * sin + x2 * cos], axis=-1)


def apply_axial_rope(x, tabs):
    cr, sr, cc, sc = tabs
    xr, xc = jnp.split(x, 2, axis=-1)
    return jnp.concatenate([rope_1d(xr, cr, sr), rope_1d(xc, cc, sc)], axis=-1).astype(x.dtype)


def attn_inputs(zq, zk, zv, qn_g, kn_g, rope):
    B_, T, _ = zq.shape
    q = rms_norm(zq.reshape(B_, T, ATT_QH, ATT_DH), qn_g)
    k = rms_norm(zk.reshape(B_, T, ATT_KVH, ATT_DH), kn_g)
    v = zv.reshape(B_, T, ATT_KVH, ATT_DH)
    if rope is not None:
        q, k = apply_axial_rope(q, rope), apply_axial_rope(k, rope)
    return q, k, v


def blocked_attention(q, k, v):
    B_, Tq, _, _ = q.shape
    nb = Tq // ATT_BLOCK
    qb = q.reshape(B_, nb, ATT_BLOCK, ATT_KVH, ATT_GROUP, ATT_DH).transpose(1, 0, 2, 3, 4, 5)
    scale = ATT_DH ** -0.5

    def block(qi):
        s = jnp.einsum('bqhgd,bkhd->bhgqk', qi, k).astype(F32) * scale
        p = jax.nn.softmax(s, axis=-1).astype(v.dtype)
        return jnp.einsum('bhgqk,bkhd->bqhgd', p, v)

    o = lax.map(block, qb)
    return o.transpose(1, 0, 2, 3, 4, 5).reshape(B_, Tq, ATT_QH * ATT_DH)


def mixer_cd(h_l, h_c, w_in, gate_b, norm_g, qn_g, kn_g, w_out, rope, ctx_out):
    qm_l, km_l, vm_l, om_l, gt_l, qa_l, ka_l, va_l = jnp.split(h_l @ w_in, CD_CUTS, axis=-1)
    qm_c, km_c, vm_c, om_c, gt_c, qa_c, ka_c, va_c = jnp.split(h_c @ w_in, CD_CUTS, axis=-1)
    Qc, Kc, Vc, Gc = mlstm_inputs(qm_c, km_c, vm_c, gt_c, gate_b)
    Ql, Kl, Vl, Gl = mlstm_inputs(qm_l, km_l, vm_l, gt_l, gate_b)
    zero = mlstm_zero_state(h_c.shape[0])
    hcf, st_f = mlstm_direction(Qc, Kc, Vc, Gc[0], Gc[1], zero, False)
    hcb, st_b = mlstm_direction(Qc, Kc, Vc, Gc[2], Gc[3], zero, True)
    hlf, _ = mlstm_direction(Ql, Kl, Vl, Gl[0], Gl[1], st_f, False)
    hlb, _ = mlstm_direction(Ql, Kl, Vl, Gl[2], Gl[3], st_b, True)
    q_l, k_l, v_l = attn_inputs(qa_l, ka_l, va_l, qn_g, kn_g, rope)
    q_c, k_c, v_c = attn_inputs(qa_c, ka_c, va_c, qn_g, kn_g, None)
    y_la = blocked_attention(q_l, jnp.concatenate([k_c, k_l], 1), jnp.concatenate([v_c, v_l], 1))
    y_l = jnp.concatenate([mlstm_out(hlf + hlb, om_l, norm_g), y_la], axis=-1) @ w_out
    if ctx_out:
        y_ca = blocked_attention(q_c, k_c, v_c)
        y_c = jnp.concatenate([mlstm_out(hcf + hcb, om_c, norm_g), y_ca], axis=-1) @ w_out
    else:
        y_c = None
    return y_l, y_c


def peer_ffn(h, w_q, sub_keys, u_tab, v_tab):
    shape = h.shape
    tok = h.reshape(-1, PEER_BLOCK, D_MODEL)
    half = PEER_DKEY // 2
    kk = PEER_TOPK * PEER_TOPK

    def block(hb):
        q = (hb @ w_q).reshape(PEER_BLOCK, PEER_HEADS, 2, half)
        s = jnp.einsum('nhpd,pkd->nhpk', q, sub_keys).astype(F32)
        sv, si = lax.top_k(s, PEER_TOPK)
        cand = (sv[:, :, 0, :, None] + sv[:, :, 1, None, :]).reshape(PEER_BLOCK, PEER_HEADS, kk)
        cidx = (si[:, :, 0, :, None] * PEER_NKEYS + si[:, :, 1, None, :]).reshape(PEER_BLOCK, PEER_HEADS, kk)
        top_s, pos = lax.top_k(cand, PEER_TOPK)
        eidx = jnp.take_along_axis(cidx, pos, axis=-1)
        gate = jax.nn.softmax(top_s, axis=-1)
        act = jax.nn.gelu(jnp.einsum('nd,nhkd->nhk', hb, u_tab[eidx]).astype(F32), approximate=False)
        w = (gate * act).astype(hb.dtype)
        return jnp.einsum('nhk,nhkd->nd', w, v_tab[eidx])

    return lax.map(block, tok).reshape(shape)


def setup_inputs(seed: int = 0) -> dict:
    key = jax.random.key(seed)
    ks = jax.random.split(key, 32)

    def nrm(k, shape, s):
        return jax.random.normal(k, shape, F32) * s

    gate_i = nrm(ks[20], (N_ODD, 2, MLSTM_HEADS), 0.1)
    gate_f = 3.0 + 3.0 * jax.random.uniform(ks[21], (N_ODD, 2, MLSTM_HEADS), F32)
    mlstm_gate_b = jnp.stack([gate_i[:, 0], gate_f[:, 0], gate_i[:, 1], gate_f[:, 1]], axis=1)
    return {
        "x": nrm(ks[0], (BATCH, SEQ, D_MODEL), 1.0),
        "c": nrm(ks[1], (BATCH, D_MODEL), 1.0),
        "ctx": nrm(ks[2], (BATCH, CTX_LEN, D_MODEL), 1.0),
        "c_ctx": nrm(ks[3], (D_MODEL,), 1.0),
        "mod_w": nrm(ks[4], (DEPTH, D_MODEL, N_MOD * D_MODEL), 0.5 * D_MODEL ** -0.5),
        "mod_b": nrm(ks[5], (DEPTH, N_MOD * D_MODEL), 0.02),
        "ln_g": 1.0 + nrm(ks[6], (DEPTH, 2, D_MODEL), 0.02),
        "ln_b": nrm(ks[7], (DEPTH, 2, D_MODEL), 0.02),
        "ab_w_in": nrm(ks[8], (N_EVEN, D_MODEL, AB_IN), D_MODEL ** -0.5),
        "pool_w": nrm(ks[9], (N_EVEN, POOL_GROUPS, POOL_GW, POOL_GW), POOL_GW ** -0.5),
        "pool_ls": 1.0 + nrm(ks[10], (N_EVEN, D_POOL), 0.1),
        "conv_w": nrm(ks[11], (N_EVEN, CONV_W, D_CONV), CONV_W ** -0.5),
        "conv_b": nrm(ks[12], (N_EVEN, D_CONV), 0.02),
        "conv_ln_g": 1.0 + nrm(ks[13], (N_EVEN, D_CONV), 0.02),
        "conv_ln_b": nrm(ks[14], (N_EVEN, D_CONV), 0.02),
        "ab_w_out": nrm(ks[15], (N_EVEN, AB_MIX, D_MODEL), DN_BETA * AB_MIX ** -0.5),
        "cd_w_in": nrm(ks[16], (N_ODD, D_MODEL, CD_IN), D_MODEL ** -0.5),
        "mlstm_gate_b": mlstm_gate_b,
        "mlstm_norm_g": 1.0 + nrm(ks[17], (N_ODD, D_MLSTM), 0.02),
        "q_norm_g": 1.0 + nrm(ks[18], (N_ODD, ATT_DH), 0.02),
        "k_norm_g": 1.0 + nrm(ks[19], (N_ODD, ATT_DH), 0.02),
        "cd_w_out": nrm(ks[22], (N_ODD, CD_MIX, D_MODEL), DN_BETA * CD_MIX ** -0.5),
        "peer_w_q": nrm(ks[23], (DEPTH, D_MODEL, PEER_HEADS * PEER_DKEY), D_MODEL ** -0.5),
        "peer_keys": nrm(ks[24], (DEPTH, 2, PEER_NKEYS, PEER_DKEY // 2), (PEER_DKEY // 2) ** -0.5),
        "peer_u": nrm(ks[25], (DEPTH, PEER_N, D_MODEL), D_MODEL ** -0.5),
        "peer_v": nrm(ks[26], (DEPTH, PEER_N, D_MODEL), DN_BETA),
    }


def reference(x, c, ctx, c_ctx, mod_w, mod_b, ln_g, ln_b,
              ab_w_in, pool_w, pool_ls, conv_w, conv_b, conv_ln_g, conv_ln_b, ab_w_out,
              cd_w_in, mlstm_gate_b, mlstm_norm_g, q_norm_g, k_norm_g, cd_w_out,
              peer_w_q, peer_keys, peer_u, peer_v):
    n_lat = x.shape[1]
    ROWS = n_lat // GRID_W
    row = jnp.repeat(jnp.arange(ROWS), GRID_W)
    col = jnp.tile(jnp.arange(GRID_W), ROWS)
    rope = axial_rope_tables(row, col)
    x_l, x_c = x, ctx
    for l in range(DEPTH):
        ctx_out = l < DEPTH - 1
        j = l // 2
        mod_l = (jax.nn.silu(c) @ mod_w[l] + mod_b[l])[:, None, :]
        mod_c = (jax.nn.silu(c_ctx) @ mod_w[l] + mod_b[l])[None, None, :]
        sh1, sc1, g1, sh2, sc2, g2 = jnp.split(mod_l, N_MOD, axis=-1)
        csh1, csc1, cg1, csh2, csc2, cg2 = jnp.split(mod_c, N_MOD, axis=-1)
        h_l = x_l * (1 + sc1) + sh1
        if l % 2 == 0:
            ab = (ab_w_in[j], pool_w[j], pool_ls[j], conv_w[j], conv_b[j], conv_ln_g[j], conv_ln_b[j], ab_w_out[j])
            y_l = mixer_ab(h_l, *ab)
            y_c = mixer_ab(x_c * (1 + csc1) + csh1, *ab) if ctx_out else None
        else:
            y_l, y_c = mixer_cd(h_l, x_c * (1 + csc1) + csh1, cd_w_in[j], mlstm_gate_b[j], mlstm_norm_g[j],
                                q_norm_g[j], k_norm_g[j], cd_w_out[j], rope, ctx_out)
        x_l = layer_norm(DN_ALPHA * x_l + g1 * y_l, ln_g[l, 0], ln_b[l, 0])
        f_l = peer_ffn(x_l * (1 + sc2) + sh2, peer_w_q[l], peer_keys[l], peer_u[l], peer_v[l])
        x_l = layer_norm(DN_ALPHA * x_l + g2 * f_l, ln_g[l, 1], ln_b[l, 1])
        if ctx_out:
            x_c = layer_norm(DN_ALPHA * x_c + cg1 * y_c, ln_g[l, 0], ln_b[l, 0])
            f_c = peer_ffn(x_c * (1 + csc2) + csh2, peer_w_q[l], peer_keys[l], peer_u[l], peer_v[l])
            x_c = layer_norm(DN_ALPHA * x_c + cg2 * f_c, ln_g[l, 1], ln_b[l, 1])
    return x_l
```

```cpp
#include <hip/hip_runtime.h>
#include <stdint.h>
#include <stdio.h>

constexpr int D = 1024, NB = 4, SEQ = 8192, CTX = 256;
constexpr int ML = NB * SEQ;
constexpr int MC = NB * CTX;
constexpr int MT = ML + MC;
constexpr int TK = CTX + SEQ;
constexpr float DN_ALPHA = 1.4142135623730951f;
constexpr float LN_EPS = 1e-5f, RMS_EPS = 1e-6f;
constexpr int AB_IN = 1536, CD_IN = 2832;
constexpr int ZZP = 2816;

#define GAS __attribute__((address_space(1)))
#define LAS __attribute__((address_space(3)))
typedef unsigned short bf16_t;
__device__ __forceinline__ float bf2f(bf16_t v) { return __uint_as_float(((unsigned)v) << 16); }
__device__ __forceinline__ bf16_t f2bf(float f) { unsigned u = __float_as_uint(f); return (bf16_t)((u + 0x7fffu + ((u >> 16) & 1u)) >> 16); }

__device__ __forceinline__ int row_b(int r) { return r < ML ? (r >> 13) : ((r - ML) >> 8); }
__device__ __forceinline__ int row_t(int r) { return r < ML ? (r & 8191) : ((r - ML) & 255); }
__device__ __forceinline__ int row_T(int r) { return r < ML ? SEQ : CTX; }
__device__ __forceinline__ int row_mod(int r) { return r < ML ? (r >> 13) : 4; }


namespace pg8 {
#define PG8_LAS __attribute__((address_space(3)))
typedef unsigned short bf16_t;
typedef short bf16x8 __attribute__((ext_vector_type(8)));
typedef float f32x4 __attribute__((ext_vector_type(4)));
typedef int i32x4 __attribute__((ext_vector_type(4)));
template <bool I8> struct AccSel { typedef f32x4 T; };
template <> struct AccSel<true> { typedef i32x4 T; };
typedef unsigned u32x4 __attribute__((ext_vector_type(4)));
constexpr int BM = 256, BK = 64, HALF = 128, HTB = HALF * BK * 2  , STAGE_BYTES = 8 * HTB, NXCD = 8, WGM = 8;

__host__ __device__ __forceinline__ int lds_byte(int r, int c) { const int st = (r >> 4) * 2 + (c >> 5), rr = r & 15, cc = c & 31, ob = rr * 64 + cc * 2; return st * 1024 + (ob ^ (((ob >> 9) & 1) << 5)); }
__host__ __device__ __forceinline__ void stage_rc(int b, int& R, int& C) { const int st = b / 1024, sb = b % 1024, swz = sb ^ (((sb >> 9) & 1) << 5); R = (st >> 1) * 16 + swz / 64; C = (st & 1) * 32 + (swz % 64) / 2; }
__host__ __device__ __forceinline__ int perm32(int rho) { const int n = rho >> 4, i = rho & 15; return 8 * (i >> 2) + 4 * n + (i & 3); }

struct Unit { int pm, pn; };
struct Gemm { const bf16_t* A; const bf16_t* Bt; int M, N, K; };

struct StaticOrder {
    int nM, nN, nwg, G, c;
    __host__ __device__ void init(int M, int N, int G_, int c_) { nM = M / BM; nN = N / BM; nwg = nM * nN; G = G_; c = c_; }
    __host__ __device__ bool next(int i, Unit& u) const {
        const long L = (long)i * G + c; if (L >= nwg) return false;
        int wgid = (int)L; { const int q = nwg / NXCD, r = nwg % NXCD, xcd = wgid % NXCD, off = wgid / NXCD; wgid = (xcd < r ? xcd * (q + 1) : r * (q + 1) + (xcd - r) * q) + off; }
        const int nig = WGM * nN, gid = wgid / nig, fm = gid * WGM, gsz = (nM - fm) < WGM ? (nM - fm) : WGM;
        u.pm = fm + ((wgid % nig) % gsz); u.pn = (wgid % nig) / gsz; return true;
    }
    __device__ __forceinline__ void a_ready(const Unit&) const {}
    __device__ __forceinline__ void done(const Unit&) const {}
};
__device__ __forceinline__ unsigned cvt_pk_bf16(float lo, float hi) { unsigned r; asm volatile("v_cvt_pk_bf16_f32 %0, %1, %2" : "=v"(r) : "v"(lo), "v"(hi)); return r; }
typedef float f32x2 __attribute__((ext_vector_type(2)));
template <class Epi, class Sched, bool ALIGN_EPI = false, bool SP2 = false, bool I8 = false>
__device__ __forceinline__ void gemm_phase(PG8_LAS unsigned char* lds, const Gemm g, const Sched& S, const Epi& E) {
    const int tid = threadIdx.x, wid = __builtin_amdgcn_readfirstlane(tid >> 6), lane = tid & 63, wr = wid >> 2, wc = wid & 3, fr = lane & 15, fq = lane >> 4;
    const int K = g.K, nt = K / BK;
    unsigned voffA[2], voffB[2];
#pragma unroll
    for (int i = 0; i < 2; ++i) { int R, C; stage_rc(tid * 16 + i * 8192, R, C); const int Rb = Epi::PERM ? ((R & ~31) + perm32(R & 31)) : R;
        voffA[i] = (unsigned)(R * K + C) * 2u; voffB[i] = (unsigned)(Rb * K + C) * 2u; }
    const size_t kstep = (size_t)(BK * 2);
    const size_t hstep = (size_t)HALF * K * 2;
    const size_t tstep = 2 * hstep;
    const unsigned ldsw = (unsigned)wid * 1024u;
    const int aoff = lds_byte(wr * 64 + fr, fq * 8), boff = lds_byte(wc * 32 + fr, fq * 8);
#define PG8_SA(b, h) (((b) * 2 + (h)) * HTB)
#define PG8_SB(b, h) ((4 + (b) * 2 + (h)) * HTB)
#define PG8_STAGE(bufoff, gbase, voff) do { _Pragma("unroll") for (int _i = 0; _i < 2; ++_i) \
        __builtin_amdgcn_global_load_lds((const unsigned*)((const char*)(gbase) + (voff)[_i]), (PG8_LAS unsigned*)(lds + (bufoff) + ldsw + _i * 8192), 16, 0, 0); } while (0)
#define PG8_LDA(dst, b, h) do { _Pragma("unroll") for (int m = 0; m < 4; ++m) _Pragma("unroll") for (int k = 0; k < 2; ++k) dst[m][k] = *(const PG8_LAS bf16x8*)(lds + PG8_SA(b, h) + aoff + m * 2048 + k * 1024); } while (0)
#define PG8_LDB(dst, b, h) do { _Pragma("unroll") for (int n = 0; n < 2; ++n) _Pragma("unroll") for (int k = 0; k < 2; ++k) dst[n][k] = *(const PG8_LAS bf16x8*)(lds + PG8_SB(b, h) + boff + n * 2048 + k * 1024); } while (0)
#define PG8_MMA(ai, bj, At, Bt) do { __builtin_amdgcn_s_setprio(1); _Pragma("unroll") for (int m = 0; m < 4; ++m) _Pragma("unroll") for (int n = 0; n < 2; ++n) _Pragma("unroll") for (int k = 0; k < 2; ++k) \
        { if constexpr (I8) acc[ai][bj][m][n] = __builtin_amdgcn_mfma_i32_16x16x64_i8(__builtin_bit_cast(i32x4, Bt[n][k]), __builtin_bit_cast(i32x4, At[m][k]), acc[ai][bj][m][n], 0, 0, 0); \
          else acc[ai][bj][m][n] = __builtin_amdgcn_mfma_f32_16x16x32_bf16(Bt[n][k], At[m][k], acc[ai][bj][m][n], 0, 0, 0); } __builtin_amdgcn_s_setprio(0); } while (0)
#define PG8_WAIT_V(n) asm volatile("s_waitcnt vmcnt(" #n ")" ::: "memory")
#define PG8_WAIT_L(n) asm volatile("s_waitcnt lgkmcnt(" #n ")" ::: "memory")
#define PG8_BAR __builtin_amdgcn_s_barrier()
#define PG8_SCHED __builtin_amdgcn_sched_barrier(0)
    Unit cur, nxt; int ui = 0;
    if (!S.next(0, cur)) return;
    typedef typename AccSel<I8>::T AccT;
    AccT acc[2][2][4][2];
#pragma unroll
    for (int a = 0; a < 2; ++a)
#pragma unroll
        for (int b = 0; b < 2; ++b)
#pragma unroll
            for (int m = 0; m < 4; ++m)
#pragma unroll
                for (int n = 0; n < 2; ++n) acc[a][b][m][n] = AccT{};
    bf16x8 At[4][2], B0[2][2], B1[2][2];
    const char* cA = (const char*)g.A + (size_t)cur.pm * tstep; const char* cB = (const char*)g.Bt + (size_t)cur.pn * tstep;
    S.a_ready(cur);
    if constexpr (SP2) {
        PG8_STAGE(PG8_SB(0, 0), cB, voffB); PG8_STAGE(PG8_SB(0, 1), cB + hstep, voffB); PG8_STAGE(PG8_SA(0, 0), cA, voffA); PG8_STAGE(PG8_SA(0, 1), cA + hstep, voffA);
        if (wr == 1) PG8_BAR;
        PG8_WAIT_V(2); PG8_BAR;
        PG8_STAGE(PG8_SB(1, 0), cB + kstep, voffB); PG8_STAGE(PG8_SA(1, 0), cA + kstep, voffA); PG8_STAGE(PG8_SB(1, 1), cB + hstep + kstep, voffB);
        PG8_WAIT_V(6); PG8_BAR;
    } else {
        PG8_STAGE(PG8_SB(0, 0), cB, voffB); PG8_STAGE(PG8_SA(0, 0), cA, voffA); PG8_STAGE(PG8_SB(0, 1), cB + hstep, voffB); PG8_STAGE(PG8_SA(0, 1), cA + hstep, voffA);
        if (wr == 1) PG8_BAR;
        PG8_WAIT_V(4); PG8_BAR;
        PG8_STAGE(PG8_SB(1, 0), cB + kstep, voffB); PG8_STAGE(PG8_SA(1, 0), cA + kstep, voffA); PG8_STAGE(PG8_SB(1, 1), cB + hstep + kstep, voffB);
        PG8_WAIT_V(6); PG8_BAR;
    }
    for (;;) {
        const bool has_next = S.next(ui + 1, nxt);
        const char* nA = has_next ? (const char*)g.A + (size_t)nxt.pm * tstep : cA; const char* nB = has_next ? (const char*)g.Bt + (size_t)nxt.pn * tstep : cB;
        for (int t = 0; t < nt; t += 2) {
            const bool last = (t == nt - 2);
            const char* a1 = cA + (size_t)(t + 1) * kstep;
            const char* a2 = last ? nA : cA + (size_t)(t + 2) * kstep; const char* b2 = last ? nB : cB + (size_t)(t + 2) * kstep;
            const char* a3 = a2 + kstep; const char* b3 = b2 + kstep;
            if (last && has_next) S.a_ready(nxt);
            if constexpr (SP2) {
            PG8_LDB(B0, 0, 0); PG8_LDB(B1, 0, 1); PG8_SCHED; PG8_LDA(At, 0, 0); PG8_STAGE(PG8_SA(1, 1), a1 + hstep, voffA);
            PG8_WAIT_V(8); PG8_WAIT_L(0); PG8_BAR; PG8_MMA(0, 0, At, B0); PG8_MMA(0, 1, At, B1); PG8_BAR; PG8_SCHED;
            PG8_LDA(At, 0, 1); PG8_STAGE(PG8_SB(0, 0), b2, voffB); PG8_STAGE(PG8_SB(0, 1), b2 + hstep, voffB); PG8_STAGE(PG8_SA(0, 0), a2, voffA);
            PG8_WAIT_V(8); PG8_WAIT_L(0); PG8_BAR; PG8_MMA(1, 0, At, B0); PG8_MMA(1, 1, At, B1); PG8_BAR; PG8_SCHED;
            PG8_LDB(B0, 1, 0); PG8_LDB(B1, 1, 1); PG8_SCHED; PG8_LDA(At, 1, 0); PG8_STAGE(PG8_SA(0, 1), a2 + hstep, voffA);
            PG8_WAIT_V(8); PG8_WAIT_L(0); PG8_BAR; PG8_MMA(0, 0, At, B0); PG8_MMA(0, 1, At, B1); PG8_BAR; PG8_SCHED;
            PG8_LDA(At, 1, 1); PG8_STAGE(PG8_SB(1, 0), b3, voffB); PG8_STAGE(PG8_SB(1, 1), b3 + hstep, voffB); PG8_STAGE(PG8_SA(1, 0), a3, voffA);
            PG8_WAIT_V(8); PG8_WAIT_L(0); PG8_BAR; PG8_MMA(1, 0, At, B0); PG8_MMA(1, 1, At, B1); PG8_BAR; PG8_SCHED;
            } else {
            PG8_LDB(B0, 0, 0); PG8_SCHED; PG8_LDA(At, 0, 0); PG8_STAGE(PG8_SA(1, 1), a1 + hstep, voffA);
            PG8_WAIT_L(8); PG8_BAR; PG8_WAIT_L(0); PG8_MMA(0, 0, At, B0); PG8_BAR; PG8_SCHED;
            PG8_LDB(B1, 0, 1); PG8_STAGE(PG8_SB(0, 0), b2, voffB);
            PG8_BAR; PG8_WAIT_L(0); PG8_MMA(0, 1, At, B1); PG8_BAR;
            PG8_LDA(At, 0, 1); PG8_STAGE(PG8_SA(0, 0), a2, voffA);
            PG8_BAR; PG8_WAIT_L(0); PG8_MMA(1, 0, At, B0); PG8_BAR; PG8_SCHED;
            PG8_STAGE(PG8_SB(0, 1), b2 + hstep, voffB);
            PG8_WAIT_V(6); PG8_BAR; PG8_MMA(1, 1, At, B1); PG8_BAR;
            PG8_LDB(B0, 1, 0); PG8_SCHED; PG8_LDA(At, 1, 0); PG8_STAGE(PG8_SA(0, 1), a2 + hstep, voffA);
            PG8_WAIT_L(8); PG8_BAR; PG8_WAIT_L(0); PG8_MMA(0, 0, At, B0); PG8_BAR; PG8_SCHED;
            PG8_LDB(B1, 1, 1); PG8_STAGE(PG8_SB(1, 0), b3, voffB);
            PG8_BAR; PG8_WAIT_L(0); PG8_MMA(0, 1, At, B1); PG8_BAR;
            PG8_LDA(At, 1, 1); PG8_STAGE(PG8_SA(1, 0), a3, voffA);
            PG8_BAR; PG8_WAIT_L(0); PG8_MMA(1, 0, At, B0); PG8_BAR; PG8_SCHED;
            PG8_STAGE(PG8_SB(1, 1), b3 + hstep, voffB);
            PG8_WAIT_V(6); PG8_BAR; PG8_MMA(1, 1, At, B1); PG8_BAR;
            }
        }
        if constexpr (ALIGN_EPI) { if (wr == 0) PG8_BAR; }
        if constexpr (!Epi::AFTER_DRAIN) { E(acc, cur, wr, wc, fr, fq); S.done(cur); }
        if (!has_next) break;
#pragma unroll
        for (int a = 0; a < 2; ++a)
#pragma unroll
            for (int b = 0; b < 2; ++b)
#pragma unroll
                for (int m = 0; m < 4; ++m)
#pragma unroll
                    for (int n = 0; n < 2; ++n) acc[a][b][m][n] = AccT{};
        cur = nxt; cA = nA; cB = nB; ++ui;
        if constexpr (ALIGN_EPI) { if (wr == 1) PG8_BAR; }
    }
    PG8_WAIT_V(0);
    if constexpr (!ALIGN_EPI) { if (wr == 0) PG8_BAR; }
    PG8_BAR;
    if constexpr (Epi::AFTER_DRAIN) { E.fused(acc, cur, wr, wc, fr, fq, lds, wid, lane); S.done(cur); }
#undef PG8_SA
#undef PG8_SB
#undef PG8_STAGE
#undef PG8_LDA
#undef PG8_LDB
#undef PG8_MMA
#undef PG8_WAIT_V
#undef PG8_WAIT_L
#undef PG8_BAR
#undef PG8_SCHED
}
}

#include <hip/hip_bf16.h>
#include <cmath>
namespace attn_body {
using bf16=__hip_bfloat16;
using bf16x8=__attribute__((ext_vector_type(8)))short;
using s16x4=__attribute__((ext_vector_type(4)))short;
using f32x16=__attribute__((ext_vector_type(16)))float;
using u32x4=__attribute__((ext_vector_type(4)))unsigned;
constexpr int D=64, QP=512, KP=128, OP=1024, SEQ=8192, TKV=8448;
constexpr int NW=8,QBLK=32,QB=QBLK*NW,KVBLK=64,NQB=SEQ/QB;
constexpr int ATTN_UNIT_ROWS=QB;
__device__ __forceinline__ int crow(int r,int hi){return (r&3)+8*(r>>2)+4*hi;}
#define SBAR() __builtin_amdgcn_sched_barrier(0)
__device__ __forceinline__ void cmask(f32x16&p0,f32x16&p1,int jb,int qrel,int hi){
  const float NEG=-INFINITY; int kb=64*jb+4*hi;
  #pragma unroll
  for(int r=0;r<16;++r){int kv=kb+(r&3)+8*(r>>2); if(kv>qrel)p0[r]=NEG; if(kv+32>qrel)p1[r]=NEG;}
}

constexpr int NSLOT=3, SLOTB=8192;
constexpr int LDS_K=0, LDS_V=NSLOT*SLOTB, LDS_WS=2*NSLOT*SLOTB, LDS_OST=LDS_WS+NW*64*4, LDS_BYTES=LDS_OST+NW*4096;
constexpr float C2=0.125f*1.4426950408889634f;
__device__ __forceinline__ void glds16(const void*gsrc,unsigned lds_dst){unsigned keep;
  asm volatile("s_mov_b32 %0, m0\n\ts_mov_b32 m0, %2\n\ts_nop 0\n\tglobal_load_lds_dwordx4 %1, off\n\ts_mov_b32 m0, %0":"=&s"(keep):"v"(gsrc),"s"(lds_dst):"memory");}
__device__ __forceinline__ float max3f(float a,float b,float c){float r;asm("v_max3_f32 %0, %1, %2, %3":"=v"(r):"v"(a),"v"(b),"v"(c));return r;}
__device__ __forceinline__ float max2f(float a,float b){float r;asm("v_max_f32_e32 %0, %1, %2":"=v"(r):"v"(a),"v"(b));return r;}
__device__ __forceinline__ float fadd_s(float a,float b){float r;asm("v_add_f32_e32 %0, %1, %2":"=v"(r):"v"(a),"v"(b));return r;}
__device__ __forceinline__ float fsub_s(float a,float b){float r;asm("v_sub_f32_e32 %0, %1, %2":"=v"(r):"v"(a),"v"(b));return r;}
typedef float f32x2_t __attribute__((ext_vector_type(2))); typedef __bf16 bf16x2_t __attribute__((ext_vector_type(2)));
__device__ __forceinline__ unsigned cvtpk_s(float lo,float hi){f32x2_t v={lo,hi};bf16x2_t b=__builtin_convertvector(v,bf16x2_t);return __builtin_bit_cast(unsigned,b);}
#define WAIT_BAR(N) asm volatile("s_waitcnt vmcnt(" #N ") lgkmcnt(0)\n\ts_barrier":::"memory")

__device__ __forceinline__ void qkt(f32x16&p0,f32x16&p1,const char*Kslot,const bf16x8*qr,const f32x16&negm,int r32,int hi){
  const char*kb=Kslot+hi*1024+r32*16;
  #pragma unroll
  for(int d0=0;d0<4;++d0){
    const bf16x8 b0=*reinterpret_cast<const bf16x8*>(kb+d0*2048);
    const bf16x8 b1=*reinterpret_cast<const bf16x8*>(kb+d0*2048+512);
    if(d0==0){p0=__builtin_amdgcn_mfma_f32_32x32x16_bf16(b0,qr[0],negm,0,0,0);p1=__builtin_amdgcn_mfma_f32_32x32x16_bf16(b1,qr[0],negm,0,0,0);}
    else{p0=__builtin_amdgcn_mfma_f32_32x32x16_bf16(b0,qr[d0],p0,0,0,0);p1=__builtin_amdgcn_mfma_f32_32x32x16_bf16(b1,qr[d0],p1,0,0,0);}}
}
typedef __attribute__((address_space(3))) const char* lds_cptr;
typedef short v4i16_t __attribute__((ext_vector_type(4)));
__device__ __forceinline__ void kload8(bf16x8*kf,lds_cptr kp){
  kf[0]=*(const __attribute__((address_space(3))) bf16x8*)(kp);      kf[1]=*(const __attribute__((address_space(3))) bf16x8*)(kp+512);
  kf[2]=*(const __attribute__((address_space(3))) bf16x8*)(kp+2048); kf[3]=*(const __attribute__((address_space(3))) bf16x8*)(kp+2560);
  kf[4]=*(const __attribute__((address_space(3))) bf16x8*)(kp+4096); kf[5]=*(const __attribute__((address_space(3))) bf16x8*)(kp+4608);
  kf[6]=*(const __attribute__((address_space(3))) bf16x8*)(kp+6144); kf[7]=*(const __attribute__((address_space(3))) bf16x8*)(kp+6656);
}
__device__ __forceinline__ void kload2(bf16x8*kf,lds_cptr kp,int j){ kf[2*j]=*(const __attribute__((address_space(3))) bf16x8*)(kp+j*2048); kf[2*j+1]=*(const __attribute__((address_space(3))) bf16x8*)(kp+j*2048+512); }
__device__ __forceinline__ s16x4 vtr(lds_cptr p){ return __builtin_bit_cast(s16x4,__builtin_amdgcn_ds_read_tr16_b64_v4i16((__attribute__((address_space(3))) v4i16_t*)p)); }
__device__ __forceinline__ float rowmax(const f32x16&p0,const f32x16&p1){
  float a=max3f(p0[0],p0[1],p1[0]),b=max3f(p0[2],p0[3],p1[1]);a=max3f(a,p1[2],p1[3]);
  #pragma unroll
  for(int r=4;r<16;r+=4){a=max3f(a,p0[r],p0[r+1]);b=max3f(b,p0[r+2],p0[r+3]);a=max3f(a,p1[r],p1[r+1]);b=max3f(b,p1[r+2],p1[r+3]);}
  const float m=max2f(a,b);
  auto rr=__builtin_amdgcn_permlane32_swap(__float_as_uint(m),__float_as_uint(m),false,false);
  return max2f(__uint_as_float(rr[0]),__uint_as_float(rr[1]));
}
__device__ __forceinline__ void pv(f32x16*o,int vb,bf16x8 pa0,bf16x8 pa1,bf16x8 pa2,bf16x8 pa3){
  #pragma unroll
  for(int d0=0;d0<2;++d0){s16x4 lo[4],hi[4];
    #pragma unroll
    for(int ks=0;ks<4;++ks){
      asm volatile("ds_read_b64_tr_b16 %0,%1 offset:%c2":"=&v"(lo[ks]):"v"(vb),"i"(d0*4096+ks*1024):"memory");
      asm volatile("ds_read_b64_tr_b16 %0,%1 offset:%c2":"=&v"(hi[ks]):"v"(vb),"i"(d0*4096+ks*1024+512):"memory");}
    asm volatile("s_waitcnt lgkmcnt(0)":::"memory");SBAR();
    #define PK(k) (bf16x8){lo[k][0],lo[k][1],lo[k][2],lo[k][3],hi[k][0],hi[k][1],hi[k][2],hi[k][3]}
    o[d0]=__builtin_amdgcn_mfma_f32_32x32x16_bf16(pa0,PK(0),o[d0],0,0,0);
    o[d0]=__builtin_amdgcn_mfma_f32_32x32x16_bf16(pa1,PK(1),o[d0],0,0,0);
    o[d0]=__builtin_amdgcn_mfma_f32_32x32x16_bf16(pa2,PK(2),o[d0],0,0,0);
    o[d0]=__builtin_amdgcn_mfma_f32_32x32x16_bf16(pa3,PK(3),o[d0],0,0,0);
    #undef PK
  }
}

#ifndef ATTN_STORE16
#define ATTN_STORE16(p,v) (*(u32x4*)(p)=(v))
#endif
template<int THRL> __device__ __forceinline__ void attn_unit(int b,int h,int qb,const bf16*Q,const bf16*__restrict__ K,const bf16*__restrict__ V,bf16*O,char*shm){
  const int tid=threadIdx.x,lane=tid&63,r32=lane&31,hi=lane>>5; const int wid=__builtin_amdgcn_readfirstlane(tid>>6);
  const long rowbase=(long)b*SEQ, kvbase=(long)b*TKV; const int q0=qb*QB, kvh=h>>2;
  const bf16*Qw=Q+(rowbase+q0+wid*QBLK)*QP+h*D;
  const bf16*Kh=K+kvbase*KP+kvh*D,*Vh=V+kvbase*KP+kvh*D;
  const unsigned lds0=(unsigned)(uintptr_t)shm;
  float*wsf=(float*)(shm+LDS_WS)+wid*64;
  const bf16*ksrc=Kh+(long)lane*KP+wid*8;
  const bf16*vsrc=Vh+(long)(16*(wid&3)+(lane>>2))*KP+(wid>>2)*32+(lane&3)*8;
  const unsigned kdst=lds0+LDS_K+wid*1024, vdst=lds0+LDS_V+wid*1024;
  #define DMA_K(t,slot) glds16(ksrc+(long)(t)*KVBLK*KP,(unsigned)__builtin_amdgcn_readfirstlane(kdst+(slot)))
  #define DMA_V(t,slot) glds16(vsrc+(long)(t)*KVBLK*KP,(unsigned)__builtin_amdgcn_readfirstlane(vdst+(slot)))
  const int vb0=(int)(lds0+LDS_V)+((lane>>4)&1)*32+(lane&3)*8+(4*hi+((lane&15)>>2))*64;
  const char*Kbase=shm+LDS_K; bf16x8 kf[8];
  const lds_cptr shm3=(lds_cptr)shm; const lds_cptr kp0=shm3+LDS_K+hi*1024+r32*16; const lds_cptr vp0=shm3+LDS_V+((lane>>4)&1)*32+(lane&3)*8+(4*hi+((lane&15)>>2))*64;
  const int NT=TKV/KVBLK;
  DMA_K(0,0);DMA_V(0,0);DMA_K(1,SLOTB);
  bf16x8 qr[4];
  #pragma unroll
  for(int d0=0;d0<4;++d0)qr[d0]=*reinterpret_cast<const bf16x8*>(&Qw[(long)r32*QP+d0*16+hi*8]);
  float mhat=0.f,l_reg=0.f;f32x16 o[2];o[0]=f32x16{};o[1]=f32x16{};f32x16 negm=f32x16{};asm volatile("":"+v"(negm));
  const int qrel=wid*QBLK+r32;
  #define CMASK(P0,P1,t) do{}while(0)
  bool resc=false;
  #define START(P0,P1) do{ const float rm=rowmax(P0,P1); resc=false; \
    { const float dl=rm; mhat=fadd_s(mhat,dl); \
      _Pragma("unroll") for(int r=0;r<16;++r){P0[r]=fsub_s(P0[r],dl);P1[r]=fsub_s(P1[r],dl);} \
      _Pragma("unroll") for(int r=0;r<16;++r)negm[r]=-mhat; asm volatile("":"+v"(negm)); } \
    _Pragma("unroll") for(int r=0;r<16;++r)P0[r]=__builtin_amdgcn_exp2f(P0[r]); }while(0)
  #define RESC() do{ if(resc){ asm volatile("s_waitcnt lgkmcnt(0)":::"memory"); \
      _Pragma("unroll") for(int d_=0;d_<2;++d_) _Pragma("unroll") for(int r=0;r<16;++r)o[d_][r]*=wsf[crow(r,hi)]; } }while(0)
  f32x16 pA0,pA1,pB0,pB1;
  int sl_prev=0,sl_cur=0,sl_next=SLOTB;
  #define ROT() do{sl_prev=sl_cur;sl_cur=sl_next;sl_next=(sl_next==(NSLOT-1)*SLOTB)?0:sl_next+SLOTB;}while(0)
  DMA_K(2,2*SLOTB);
  WAIT_BAR(3);
  qkt(pA0,pA1,Kbase,qr,negm,r32,hi);asm volatile("s_nop 15\n\ts_nop 7":"+v"(pA0),"+v"(pA1));CMASK(pA0,pA1,0);
  START(pA0,pA1);
  _Pragma("unroll") for(int r=0;r<16;++r)pA1[r]=__builtin_amdgcn_exp2f(pA1[r]);
  WAIT_BAR(0);
  DMA_K(3,0);DMA_V(1,SLOTB);
  ROT();
  kload8(kf,kp0+sl_cur);
  WAIT_BAR(2);
  s16x4 vlo[8],vhi[8]; u32x4 pw0,pw1,pw2,pw3;
  #define PKW(P,B) cvtpk_s(P[B],P[B+1])
  #define PAF(k) __builtin_bit_cast(bf16x8,pw##k)
  #define VFR(i) (bf16x8){vlo[i][0],vlo[i][1],vlo[i][2],vlo[i][3],vhi[i][0],vhi[i][1],vhi[i][2],vhi[i][3]}
  #define PIN(x) asm volatile("":"+v"(x))
  #define MX3(a,b,c) __builtin_fmaxf(__builtin_fmaxf((a),(b)),(c))
  #define GAPA(MF,A0,A1,A2,A3,W0,W1,PW) do{ MF; sacc+=A0; sacc+=A1; sacc+=A2; sacc+=A3; PIN(sacc); W0; W1; PIN(PW); SBAR(); }while(0)
  #define EX(v) __builtin_amdgcn_exp2f(v)
  #define GAPB(MF,X,B) do{ MF; X[B]=EX(X[B]); X[B+1]=EX(X[B+1]); X[B+2]=EX(X[B+2]); X[B+3]=EX(X[B+3]); PIN(X); SBAR(); }while(0)
  #define VRD(i) do{ vlo[i]=vtr(vp_+(((i)>>2)*4096+((i)&3)*1024)); vhi[i]=vtr(vp_+(((i)>>2)*4096+((i)&3)*1024+512)); }while(0)
  #define KRD(G,j) do{ if(G){ kload2(kf,kp0+sl_next,j); SBAR(); } }while(0)
  #define STEP(C0,C1,P0,P1,t,GK,GV,GL) do{ SBAR(); \
    const lds_cptr vp_=vp0+sl_prev; \
    VRD(0); SBAR(); float sacc=(P0[0]+P0[1]); \
    GAPA(C0=__builtin_amdgcn_mfma_f32_32x32x16_bf16(kf[0],qr[0],negm,0,0,0), P0[2],P0[3],P0[4],P0[5],     pw0[0]=PKW(P0,0), pw0[1]=PKW(P0,2), pw0); \
    VRD(4); SBAR(); GAPA(C1=__builtin_amdgcn_mfma_f32_32x32x16_bf16(kf[1],qr[0],negm,0,0,0), P0[6],P0[7],P0[8],P0[9],     pw0[2]=PKW(P0,4), pw0[3]=PKW(P0,6), pw0); \
    VRD(1); SBAR(); GAPA(C0=__builtin_amdgcn_mfma_f32_32x32x16_bf16(kf[2],qr[1],C0,0,0,0),   P0[10],P0[11],P0[12],P0[13], pw1[0]=PKW(P0,8), pw1[1]=PKW(P0,10), pw1); \
    VRD(5); SBAR(); GAPA(C1=__builtin_amdgcn_mfma_f32_32x32x16_bf16(kf[3],qr[1],C1,0,0,0),   P0[14],P0[15],P1[0],P1[1],   pw1[2]=PKW(P0,12),pw1[3]=PKW(P0,14), pw1); \
    VRD(2); SBAR(); GAPA(C0=__builtin_amdgcn_mfma_f32_32x32x16_bf16(kf[4],qr[2],C0,0,0,0),   P1[2],P1[3],P1[4],P1[5],     pw2[0]=PKW(P1,0), pw2[1]=PKW(P1,2), pw2); \
    VRD(6); SBAR(); GAPA(C1=__builtin_amdgcn_mfma_f32_32x32x16_bf16(kf[5],qr[2],C1,0,0,0),   P1[6],P1[7],P1[8],P1[9],     pw2[2]=PKW(P1,4), pw2[3]=PKW(P1,6), pw2); \
    VRD(3); SBAR(); GAPA(C0=__builtin_amdgcn_mfma_f32_32x32x16_bf16(kf[6],qr[3],C0,0,0,0),   P1[10],P1[11],P1[12],P1[13], pw3[0]=PKW(P1,8), pw3[1]=PKW(P1,10), pw3); \
    VRD(7); SBAR(); GAPA(C1=__builtin_amdgcn_mfma_f32_32x32x16_bf16(kf[7],qr[3],C1,0,0,0),   P1[14],P1[15],0.f,0.f,       pw3[2]=PKW(P1,12),pw3[3]=PKW(P1,14), pw3); \
    l_reg+=sacc; \
    if(GK){DMA_K((t)+3,sl_cur);} if(GV){DMA_V((t)+1,sl_next);} \
    CMASK(C0,C1,t); \
    { float a=MX3(C0[0],C0[1],C1[0]),b=MX3(C0[2],C0[3],C1[1]); a=MX3(a,C1[2],C1[3]); \
      _Pragma("unroll") for(int r=4;r<16;r+=4){a=MX3(a,C0[r],C0[r+1]);b=MX3(b,C0[r+2],C0[r+3]);a=MX3(a,C1[r],C1[r+1]);b=MX3(b,C1[r+2],C1[r+3]);} \
      float rm=__builtin_fmaxf(a,b); { auto rr=__builtin_amdgcn_permlane32_swap(__float_as_uint(rm),__float_as_uint(rm),false,false); rm=__builtin_fmaxf(__uint_as_float(rr[0]),__uint_as_float(rr[1])); } \
      resc=false; \
      if(__builtin_expect(__any(rm>(float)THRL),0)){ const float dl=__builtin_fmaxf(rm,0.f); mhat+=dl; \
        _Pragma("unroll") for(int r=0;r<16;++r){C0[r]-=dl;C1[r]-=dl;} \
        _Pragma("unroll") for(int r=0;r<16;++r)negm[r]=-mhat; asm volatile("":"+v"(negm)); \
        const float f=__builtin_amdgcn_exp2f(-dl); l_reg*=f; if(hi==0)wsf[r32]=f; resc=true; } } \
    SBAR(); \
    GAPB(o[0]=__builtin_amdgcn_mfma_f32_32x32x16_bf16(PAF(0),VFR(0),o[0],0,0,0), C0,0); \
    GAPB(o[1]=__builtin_amdgcn_mfma_f32_32x32x16_bf16(PAF(0),VFR(4),o[1],0,0,0), C0,4); \
    KRD(GL,0); GAPB(o[0]=__builtin_amdgcn_mfma_f32_32x32x16_bf16(PAF(1),VFR(1),o[0],0,0,0), C0,8); \
    KRD(GL,1); GAPB(o[1]=__builtin_amdgcn_mfma_f32_32x32x16_bf16(PAF(1),VFR(5),o[1],0,0,0), C0,12); \
    KRD(GL,2); GAPB(o[0]=__builtin_amdgcn_mfma_f32_32x32x16_bf16(PAF(2),VFR(2),o[0],0,0,0), C1,0); \
    KRD(GL,3); GAPB(o[1]=__builtin_amdgcn_mfma_f32_32x32x16_bf16(PAF(2),VFR(6),o[1],0,0,0), C1,4); \
    GAPB(o[0]=__builtin_amdgcn_mfma_f32_32x32x16_bf16(PAF(3),VFR(3),o[0],0,0,0), C1,8); \
    GAPB(o[1]=__builtin_amdgcn_mfma_f32_32x32x16_bf16(PAF(3),VFR(7),o[1],0,0,0), C1,12); \
    }while(0)
  int t=1;
  #undef CMASK
  #define CMASK(P0,P1,t) do{}while(0)
  for(;t+5<NT;t+=2){
    STEP(pB0,pB1,pA0,pA1,t,true,true,true);     WAIT_BAR(2); RESC(); ROT();
    STEP(pA0,pA1,pB0,pB1,t+1,true,true,true);   WAIT_BAR(2); RESC(); ROT();
  }
  #undef CMASK
  #define CMASK(P0,P1,t) do{}while(0)
  #define ENDW(tt) do{ if((tt)+3<NT){WAIT_BAR(2);} else if((tt)+2<NT){WAIT_BAR(1);} else {WAIT_BAR(0);} }while(0)
  for(;t+1<NT;t+=2){
    STEP(pB0,pB1,pA0,pA1,t,(t+3<NT),(t+1<NT),(t+1<NT));       ENDW(t);   RESC(); ROT();
    STEP(pA0,pA1,pB0,pB1,t+1,(t+4<NT),(t+2<NT),(t+2<NT));     ENDW(t+1); RESC(); ROT();
  }
  STEP(pB0,pB1,pA0,pA1,NT-1,false,false,false); RESC();
  { float sacc=pB0[0]+pB0[1]; _Pragma("unroll") for(int r=2;r<16;++r)sacc+=pB0[r]; _Pragma("unroll") for(int r=0;r<16;++r)sacc+=pB1[r]; l_reg+=sacc;
    pw0=(u32x4){PKW(pB0,0),PKW(pB0,2),PKW(pB0,4),PKW(pB0,6)};pw1=(u32x4){PKW(pB0,8),PKW(pB0,10),PKW(pB0,12),PKW(pB0,14)};pw2=(u32x4){PKW(pB1,0),PKW(pB1,2),PKW(pB1,4),PKW(pB1,6)};pw3=(u32x4){PKW(pB1,8),PKW(pB1,10),PKW(pB1,12),PKW(pB1,14)};
    SBAR(); pv(o,vb0+sl_cur,PAF(0),PAF(1),PAF(2),PAF(3)); }
  #undef PKW
  #undef PAF
  #undef VFR
  #undef PIN
  #undef MX3
  #undef GAPA
  #undef GAPB
  #undef EX
  #undef VRD
  #undef KRD
  #undef STEP
  #undef ENDW
  {auto rr=__builtin_amdgcn_permlane32_swap(__float_as_uint(l_reg),__float_as_uint(l_reg),false,false);l_reg=__uint_as_float(rr[0])+__uint_as_float(rr[1]);}
  if(hi==0)wsf[32+r32]=l_reg;asm volatile("s_waitcnt lgkmcnt(0)":::"memory");
  float rli[16];
  #pragma unroll
  for(int r=0;r<16;++r)rli[r]=__builtin_amdgcn_rcpf(wsf[32+crow(r,hi)]);
  bf16*Ow=O+(rowbase+q0+wid*QBLK)*OP+h*D;
  { bf16*stg=(bf16*)(shm+LDS_OST)+wid*2048;
    #pragma unroll
    for(int r=0;r<16;++r){const int orow=crow(r,hi);
      #pragma unroll
      for(int d0=0;d0<2;++d0)stg[orow*64+d0*32+r32]=__float2bfloat16(o[d0][r]*rli[r]);}
    asm volatile("s_waitcnt lgkmcnt(0)":::"memory");
    #pragma unroll
    for(int i=0;i<4;++i){const int row=i*8+(lane>>3),ch=lane&7; const u32x4 v=*(const u32x4*)(stg+row*64+ch*8); ATTN_STORE16(Ow+(long)row*OP+ch*8,v);} }
  asm volatile("s_waitcnt lgkmcnt(0)\n\ts_barrier":::"memory");
  #undef DMA_K
  #undef DMA_V
  #undef CMASK
  #undef START
  #undef RESC
  #undef ROT
}
constexpr int ATTN_LDS_BYTES=LDS_BYTES;
struct AttnTensors { const bf16* Q; const bf16* K; const bf16* V; bf16* O; };
struct AttnUnit { int b; int h; int qb; };
struct StaticOrder {
  int vcu, G;
  __device__ __forceinline__ explicit StaticOrder(int grid,int block):vcu((grid%8==0)?(block%8)*(grid/8)+block/8:block),G(grid){}
  __device__ __forceinline__ bool next(int i,AttnUnit&u)const{
    if(G==256){ if(i>=4)return false; const int g=vcu>>5; u.b=g>>1; u.h=(g&1)*4+i; u.qb=vcu&31; return true; }
    const int id=i*G+vcu; if(id>=1024)return false; const int g=id>>7, r=id&127; u.b=g>>1; u.h=(g&1)*4+(r&3); u.qb=r>>2; return true; }
  __device__ __forceinline__ void a_ready(const AttnUnit&)const{}
  __device__ __forceinline__ void done(const AttnUnit&)const{}
};
template<class Sched,int THRL=8> __device__ __forceinline__ void attn_phase(char*lds,const AttnTensors&T,const Sched&S){
  AttnUnit u;
  for(int i=0;S.next(i,u);++i){ S.a_ready(u); attn_unit<THRL>(u.b,u.h,u.qb,T.Q,T.K,T.V,T.O,lds); S.done(u); }
}
#undef SBAR
#undef WAIT_BAR
}

#define XB_TMO      128
#define XB_XCNT(j)  (256  + 64 * (j))
#define XB_XSUB(j)  (1280 + 64 * (j))
#define XB_XGEN(j)  (2304 + 64 * (j))
#define XB_TOP      3328
#define XB_TOPGEN   3392
#define XCD_BAR_WORDS 3456
#define XB_SPIN_CAP (1u << 18)

__device__ __forceinline__ unsigned xb_ld(unsigned* p)              { return __hip_atomic_load(p, __ATOMIC_RELAXED, __HIP_MEMORY_SCOPE_AGENT); }
__device__ __forceinline__ unsigned xb_add(unsigned* p, unsigned v) { return __hip_atomic_fetch_add(p, v, __ATOMIC_RELAXED, __HIP_MEMORY_SCOPE_AGENT); }
__device__ __forceinline__ unsigned xb_xcc_id() { return (unsigned)__builtin_amdgcn_s_getreg((3 << 11) | 20) & 0xFu; }
#define XB_SPIN(cond, bar) do { unsigned _sp = 0; while (cond) { __builtin_amdgcn_s_sleep(1); \
    if ((++_sp & 255u) == 0u) { if (xb_ld(&(bar)[XB_TMO])) break; if (_sp > XB_SPIN_CAP) { atomicAdd(&(bar)[XB_TMO], 1u); break; } } } } while (0)

struct XcdBarrier {
    unsigned* bar; unsigned x;
    volatile LAS unsigned* st;
};

__device__ __forceinline__ XcdBarrier xcd_barrier_post(unsigned* bar, volatile LAS unsigned* st) {
    XcdBarrier b; b.bar = bar; b.x = xb_xcc_id(); b.st = st;
    if (threadIdx.x == 0) (void)xb_add(&bar[XB_XCNT(b.x)], 1u);
    return b;
}
__device__ __forceinline__ void xcd_barrier_complete(unsigned* bar, unsigned x, unsigned& nloc, unsigned& nx) {
    const unsigned G = gridDim.x * gridDim.y * gridDim.z;
    unsigned sum, cnt, mine, sp = 0u;
    for (;;) {
        sum = 0u; cnt = 0u; mine = 0u;
#pragma unroll
        for (unsigned j = 0; j < 16; ++j) { const unsigned c = xb_ld(&bar[XB_XCNT(j)]); sum += c; cnt += (c > 0u) ? 1u : 0u; mine = (j == x) ? c : mine; }
        if (sum == G) break;
        __builtin_amdgcn_s_sleep(1);
        if ((++sp & 255u) == 0u) { if (xb_ld(&bar[XB_TMO])) break; if (sp > XB_SPIN_CAP) { atomicAdd(&bar[XB_TMO], 1u); break; } }
    }
    nloc = mine > 0u ? mine : 1u; nx = cnt > 0u ? cnt : 1u;
}

__device__ __forceinline__ void xcd_barrier(const XcdBarrier& b) {
    asm volatile("s_waitcnt vmcnt(0)" ::: "memory");
    __syncthreads();
    if (threadIdx.x == 0) {
        unsigned* bar = b.bar;
        __builtin_amdgcn_s_waitcnt(0);
        unsigned nloc = b.st[0], nx = b.st[1];
        if (nloc == 0u) { xcd_barrier_complete(bar, b.x, nloc, nx); b.st[0] = nloc; b.st[1] = nx; }
        const unsigned old = xb_add(&bar[XB_XSUB(b.x)], 1u);
        const unsigned gen = old / nloc;
        if (old + 1u == (gen + 1u) * nloc) {
            __builtin_amdgcn_fence(__ATOMIC_RELEASE, "agent");
            asm volatile("s_waitcnt vmcnt(0)" ::: "memory");
            const unsigned og = xb_add(&bar[XB_TOP], 1u);
            const unsigned tg = og / nx;
            if (og + 1u == (tg + 1u) * nx) xb_add(&bar[XB_TOPGEN], 1u);
            else XB_SPIN(xb_ld(&bar[XB_TOPGEN]) == tg, bar);
            __builtin_amdgcn_fence(__ATOMIC_ACQUIRE, "agent");
            xb_add(&bar[XB_XGEN(b.x)], 1u);
            asm volatile("s_waitcnt vmcnt(0)" ::: "memory");
        } else {
            XB_SPIN(xb_ld(&bar[XB_XGEN(b.x)]) == gen, bar);
            __builtin_amdgcn_fence(__ATOMIC_ACQUIRE, "agent");
            asm volatile("s_waitcnt vmcnt(0)" ::: "memory");
        }
    }
    __syncthreads();
}

typedef unsigned v4u __attribute__((ext_vector_type(4)));
typedef unsigned v2u __attribute__((ext_vector_type(2)));
typedef float v4f __attribute__((ext_vector_type(4)));
constexpr int NWAVES = 8, NTHR = 512;
constexpr size_t MiB = 1u << 20;
constexpr int LDS_BYTES = 163840;
constexpr size_t WS_CTL = 0, CTL_ZERO_BYTES = 64 * 1024;
constexpr size_t WS_MOD = 1 * MiB;
constexpr size_t WS_W_IN = 2 * MiB, WS_W_OUT = 5 * MiB, WS_CD_IN = 7 * MiB, WS_CD_OUT = 13 * MiB, WS_WQ = 15 * MiB;
constexpr size_t WS_TAB = 24 * MiB;
constexpr size_t WS_XS = 88 * MiB;
constexpr size_t WS_HA = 220 * MiB;
constexpr size_t WS_ZB = 286 * MiB;
constexpr size_t WS_IDXG = 469 * MiB;
constexpr size_t WS_END = 486 * MiB;
constexpr int CD_PAD = ZZP;
constexpr int CW_CMAX = 6144, CM_WIN = 0, CM_CD = 1536, CM_GATE = 4352, CM_WOUT = 4416, CM_WQ1 = 5440, CM_WQ0 = 7488;
constexpr size_t WS_W_OUT8 = 4 * MiB;
constexpr size_t WS_SA = WS_MOD + 832 * 1024;

__device__ __forceinline__ unsigned pk2(float lo, float hi) { return (unsigned)f2bf(lo) | ((unsigned)f2bf(hi) << 16); }
__device__ __forceinline__ float bflo(unsigned d) { return __uint_as_float(d << 16); }
__device__ __forceinline__ float bfhi(unsigned d) { return __uint_as_float(d & 0xffff0000u); }
__device__ __forceinline__ void ld8(const float* p, v4f& a, v4f& b) { a = *(const v4f*)p; b = *(const v4f*)(p + 4); }
__device__ __forceinline__ void ld8(const bf16_t* p, v4f& a, v4f& b) { const v4u w = *(const v4u*)p; a = (v4f){bflo(w.x), bfhi(w.x), bflo(w.y), bfhi(w.y)}; b = (v4f){bflo(w.z), bfhi(w.z), bflo(w.w), bfhi(w.w)}; }
__device__ __forceinline__ void st8(float* p, const v4f& a, const v4f& b) { *(v4f*)p = a; *(v4f*)(p + 4) = b; }
__device__ __forceinline__ void st8(bf16_t* p, const v4f& a, const v4f& b) { v4u o; o.x = pk2(a[0], a[1]); o.y = pk2(a[2], a[3]); o.z = pk2(b[0], b[1]); o.w = pk2(b[2], b[3]); *(v4u*)p = o; }
__device__ __forceinline__ void st8nt(float* p, const v4f& a, const v4f& b) { __builtin_nontemporal_store(a, (v4f*)p); __builtin_nontemporal_store(b, (v4f*)(p + 4)); }
__device__ __forceinline__ void st8nt(bf16_t* p, const v4f& a, const v4f& b) { v4u o; o.x = pk2(a[0], a[1]); o.y = pk2(a[2], a[3]); o.z = pk2(b[0], b[1]); o.w = pk2(b[2], b[3]); __builtin_nontemporal_store(o, (v4u*)p); }
#define LDS_WAIT() asm volatile("s_waitcnt lgkmcnt(0)" ::: "memory")
#define VM_WAIT() asm volatile("s_waitcnt vmcnt(0)" ::: "memory")


struct EpiStore {
    static constexpr bool PERM = true, AFTER_DRAIN = false;
    bf16_t* O; int ldc; int nvalid;
    __device__ __forceinline__ void operator()(const pg8::f32x4 (&acc)[2][2][4][2], const pg8::Unit& u, int wr, int wc, int fr, int fq) const {
        const int row0 = u.pm * 256 + wr * 64 + fr, col0 = u.pn * 256 + wc * 32 + 8 * fq;
#pragma unroll
        for (int ai = 0; ai < 2; ++ai)
#pragma unroll
            for (int m = 0; m < 4; ++m) { bf16_t* rowp = O + (size_t)(row0 + ai * 128 + m * 16) * ldc + col0;
#pragma unroll
                for (int bj = 0; bj < 2; ++bj) if (col0 + bj * 128 < nvalid) {
                    const pg8::f32x4 v0 = acc[ai][bj][m][0], v1 = acc[ai][bj][m][1]; pg8::u32x4 w;
                    w.x = pg8::cvt_pk_bf16(v0[0], v0[1]); w.y = pg8::cvt_pk_bf16(v0[2], v0[3]); w.z = pg8::cvt_pk_bf16(v1[0], v1[1]); w.w = pg8::cvt_pk_bf16(v1[2], v1[3]);
                    *(pg8::u32x4*)(rowp + bj * 128) = w; } }
    }
};

struct EpiStoreI8 {
    static constexpr bool PERM = true, AFTER_DRAIN = false;
    bf16_t* O; int ldc; int nvalid; const float* sa; const unsigned* cmax;
    __device__ __forceinline__ void operator()(const pg8::i32x4 (&acc)[2][2][4][2], const pg8::Unit& u, int wr, int wc, int fr, int fq) const {
        const int row0 = u.pm * 256 + wr * 64 + fr, col0 = u.pn * 256 + wc * 32 + 8 * fq;
        float sb[2][8];
#pragma unroll
        for (int bj = 0; bj < 2; ++bj)
#pragma unroll
            for (int c = 0; c < 8; ++c) sb[bj][c] = (col0 + bj * 128 < nvalid) ? __uint_as_float(cmax[col0 + bj * 128 + c]) * (1.f / 127.f) : 0.f;
#pragma unroll
        for (int ai = 0; ai < 2; ++ai)
#pragma unroll
            for (int m = 0; m < 4; ++m) { const int r = row0 + ai * 128 + m * 16; const float s = sa[r]; bf16_t* rowp = O + (size_t)r * ldc + col0;
#pragma unroll
                for (int bj = 0; bj < 2; ++bj) if (col0 + bj * 128 < nvalid) {
                    const pg8::i32x4 a0 = acc[ai][bj][m][0], a1 = acc[ai][bj][m][1]; pg8::u32x4 w;
                    w.x = pg8::cvt_pk_bf16((float)a0[0] * s * sb[bj][0], (float)a0[1] * s * sb[bj][1]); w.y = pg8::cvt_pk_bf16((float)a0[2] * s * sb[bj][2], (float)a0[3] * s * sb[bj][3]);
                    w.z = pg8::cvt_pk_bf16((float)a1[0] * s * sb[bj][4], (float)a1[1] * s * sb[bj][5]); w.w = pg8::cvt_pk_bf16((float)a1[2] * s * sb[bj][6], (float)a1[3] * s * sb[bj][7]);
                    *(pg8::u32x4*)(rowp + bj * 128) = w; } }
    }
};

__device__ __forceinline__ void transpose_item(const float* W, int K, int N, int Npad, bf16_t* WT, LAS float* scr, int item, int lane, int ldo = 0, int ldw = 0) {
    if (ldo == 0) ldo = K;
    if (ldw == 0) ldw = N;
    const int nblk = Npad / 32, kb = item / nblk, nb = item % nblk, k0 = 64 * kb, n0 = 32 * nb;
    const int nn = n0 + (lane & 31);
#pragma unroll 8
    for (int i = 0; i < 32; ++i) { const int kk = 2 * i + (lane >> 5); scr[kk * 33 + (lane & 31)] = nn < N ? W[(size_t)(k0 + kk) * ldw + nn] : 0.f; }
    LDS_WAIT(); asm volatile("" ::: "memory");
    const int c = lane & 7;
#pragma unroll
    for (int j = 0; j < 4; ++j) { const int n = (lane >> 3) + 8 * j; const LAS float* s = scr + (8 * c) * 33 + n;
        v4u o; o.x = pk2(s[0 * 33], s[1 * 33]); o.y = pk2(s[2 * 33], s[3 * 33]); o.z = pk2(s[4 * 33], s[5 * 33]); o.w = pk2(s[6 * 33], s[7 * 33]);
        *(v4u*)(WT + (size_t)(n0 + n) * ldo + k0 + 8 * c) = o; }
    LDS_WAIT(); asm volatile("" ::: "memory");
}
__device__ __forceinline__ void fold_item(const float* pool_w, const float* pool_ls, const float* w_out, bf16_t* WT, int item, int lane) {
    const int k = item & 511, n = (item >> 9) * 64 + lane, g = k >> 7;
    const float* pw = pool_w + ((size_t)g * 128 + (k & 127)) * 128;
    float acc = 0.f;
#pragma unroll 8
    for (int j = 0; j < 128; ++j) acc += pw[j] * pool_ls[g * 128 + j] * w_out[(size_t)(g * 128 + j) * 1024 + n];
    WT[(size_t)n * 1024 + k] = f2bf(acc);
}
__device__ __forceinline__ unsigned q8pack4(float a, float b, float c, float d, float inv) {
    int q0 = __float2int_rn(a * inv), q1 = __float2int_rn(b * inv), q2 = __float2int_rn(c * inv), q3 = __float2int_rn(d * inv);
    q0 = q0 > 127 ? 127 : (q0 < -127 ? -127 : q0); q1 = q1 > 127 ? 127 : (q1 < -127 ? -127 : q1); q2 = q2 > 127 ? 127 : (q2 < -127 ? -127 : q2); q3 = q3 > 127 ? 127 : (q3 < -127 ? -127 : q3);
    return (unsigned)(q0 & 255) | ((unsigned)(q1 & 255) << 8) | ((unsigned)(q2 & 255) << 16) | ((unsigned)(q3 & 255) << 24);
}
__device__ __forceinline__ void colmax_item(const float* W  , int ldw, int ncols, unsigned* cmax, int item, int lane) {
    const int kq = item & 3, n = (item >> 2) * 64 + lane;
    if (n < ncols) { const float* w = W + (size_t)(kq * 256) * ldw + n; float mx = 0.f;
#pragma unroll 16
        for (int k = 0; k < 256; ++k) mx = fmaxf(mx, fabsf(w[(size_t)k * ldw]));
        atomicMax(&cmax[n], __float_as_uint(mx)); }
}
__device__ __forceinline__ void transpose8_item(const float* W, int ldw, int ncols, const unsigned* cmax, signed char* WT, LAS float* scr, int item, int lane) {
    const int nblk = ncols / 32, kb = item / nblk, nb = item % nblk, k0 = 64 * kb, n0 = 32 * nb;
#pragma unroll 8
    for (int i = 0; i < 32; ++i) { const int kk = 2 * i + (lane >> 5); scr[kk * 33 + (lane & 31)] = W[(size_t)(k0 + kk) * ldw + n0 + (lane & 31)]; }
    LDS_WAIT(); asm volatile("" ::: "memory");
    const int c = lane & 3;
#pragma unroll
    for (int j = 0; j < 2; ++j) { const int n = (lane >> 2) + 16 * j; const LAS float* s = scr + (16 * c) * 33 + n;
        const float inv = 127.f / fmaxf(__uint_as_float(cmax[n0 + n]), 1e-30f);
        v4u o;
#pragma unroll
        for (int q = 0; q < 4; ++q) o[q] = q8pack4(s[(4 * q) * 33], s[(4 * q + 1) * 33], s[(4 * q + 2) * 33], s[(4 * q + 3) * 33], inv);
        *(v4u*)(WT + (size_t)(n0 + n) * 1024 + k0 + 16 * c) = o; }
    LDS_WAIT(); asm volatile("" ::: "memory");
}
__device__ __forceinline__ void ph_w8(const float* const* in, unsigned char* ws, LAS unsigned char* lds, int lane, int wave, int gw, int NGW) {
    LAS float* scr = (LAS float*)(lds + 24576 + wave * 8704);
    const unsigned* cm = (const unsigned*)(ws + WS_CTL) + CW_CMAX;
    constexpr int I_WIN = 16 * (AB_IN / 32), I_CDA = 16 * 64, I_CDB = 16 * 24;
    constexpr int I_WQ8 = 16 * 64;
    for (int it = gw; it < I_WIN + I_CDA + I_CDB + 1024 + 2 * I_WQ8; it += NGW) {
        int r = it;
        if (r >= I_WIN + I_CDA + I_CDB + 1024 + I_WQ8) { transpose8_item(in[22], 2048, 2048, cm + CM_WQ0, (signed char*)(ws + WS_WQ), scr, r - (I_WIN + I_CDA + I_CDB + 1024 + I_WQ8), lane); continue; }
        if (r >= I_WIN + I_CDA + I_CDB + 1024) { transpose8_item(in[22] + (size_t)1024 * 2048, 2048, 2048, cm + CM_WQ1, (signed char*)(ws + WS_WQ) + (size_t)4 * MiB, scr, r - (I_WIN + I_CDA + I_CDB + 1024), lane); continue; }
        if (r >= I_WIN + I_CDA + I_CDB) {
            const int n = r - (I_WIN + I_CDA + I_CDB); const bf16_t* wr = (const bf16_t*)(ws + WS_W_OUT) + (size_t)n * 1024 + lane * 16;
            const v4u a0 = *(const v4u*)wr, a1 = *(const v4u*)(wr + 8); float f[16]; float mx = 0.f;
#pragma unroll
            for (int e = 0; e < 4; ++e) { f[2 * e] = bflo(a0[e]); f[2 * e + 1] = bfhi(a0[e]); f[8 + 2 * e] = bflo(a1[e]); f[9 + 2 * e] = bfhi(a1[e]); }
#pragma unroll
            for (int e = 0; e < 16; ++e) mx = fmaxf(mx, fabsf(f[e]));
#pragma unroll
            for (int o_ = 1; o_ < 64; o_ <<= 1) mx = fmaxf(mx, __shfl_xor(mx, o_));
            mx = fmaxf(mx, 1e-30f); const float inv = 127.f / mx;
            if (lane == 0) ((unsigned*)(ws + WS_CTL) + CW_CMAX)[CM_WOUT + n] = __float_as_uint(mx);
            v4u o;
#pragma unroll
            for (int q = 0; q < 4; ++q) o[q] = q8pack4(f[4 * q], f[4 * q + 1], f[4 * q + 2], f[4 * q + 3], inv);
            *(v4u*)(ws + WS_W_OUT8 + (size_t)n * 1024 + lane * 16) = o; continue; }
        if (r < I_WIN) { transpose8_item(in[8], AB_IN, AB_IN, cm + CM_WIN, (signed char*)(ws + WS_W_IN), scr, r, lane); continue; } r -= I_WIN;
        if (r < I_CDA) { transpose8_item(in[16], CD_IN, 2048, cm + CM_CD, (signed char*)(ws + WS_CD_IN), scr, r, lane); continue; } r -= I_CDA;
        transpose8_item(in[16] + 2064, CD_IN, 768, cm + CM_CD + 2048, (signed char*)(ws + WS_CD_IN) + (size_t)2048 * 1024, scr, r, lane);
    }
}
__device__ __forceinline__ void cvt_row_bf16(const float* src, bf16_t* dst, int lane) {
#pragma unroll
    for (int j = 0; j < 2; ++j) { const int e = (j * 64 + lane) * 8; const v4f a = *(const v4f*)(src + e), b = *(const v4f*)(src + e + 4);
        v4u o; o.x = pk2(a[0], a[1]); o.y = pk2(a[2], a[3]); o.z = pk2(b[0], b[1]); o.w = pk2(b[2], b[3]); *(v4u*)(dst + e) = o; }
}
typedef int v4i __attribute__((ext_vector_type(4)));
typedef float v2f __attribute__((ext_vector_type(2)));
constexpr size_t TAB_VQ = 16 * MiB, SLICE_B = (size_t)16384 * 128;
constexpr size_t WS_SU = WS_MOD + 512 * 1024;
__device__ __forceinline__ float wave_sum_early(float v) {
#pragma unroll
    for (int o = 1; o < 64; o <<= 1) v += __shfl_xor(v, o);
    return v;
}
__device__ __forceinline__ float wave_max(float v) {
#pragma unroll
    for (int o = 1; o < 64; o <<= 1) v = fmaxf(v, __shfl_xor(v, o));
    return v;
}
__device__ __forceinline__ void ph_tables(const float* const* in, unsigned char* ws, int layer, int gw, int NGW, int lane) {
    const float* U = in[24] + (size_t)layer * 16384 * 1024; const float* V = in[25] + (size_t)layer * 16384 * 1024;
    unsigned char* UQ = ws + WS_TAB; unsigned char* VQ = ws + WS_TAB + TAB_VQ; float* SU = (float*)(ws + WS_SU);
    const int s = lane >> 3, j = lane & 7;
    v4f nx[4];
    if (gw < 32768) { const float* src = (gw < 16384 ? U + (size_t)gw * 1024 : V + (size_t)(gw - 16384) * 1024) + s * 128 + j * 16;
#pragma unroll
        for (int c = 0; c < 4; ++c) nx[c] = *(const v4f*)(src + 4 * c); }
    for (int it = gw; it < 32768; it += NGW) {
        const bool isu = it < 16384; const int e = isu ? it : it - 16384;
        float x[16];
#pragma unroll
        for (int c = 0; c < 4; ++c) { x[4 * c] = nx[c][0]; x[4 * c + 1] = nx[c][1]; x[4 * c + 2] = nx[c][2]; x[4 * c + 3] = nx[c][3]; }
        if (it + NGW < 32768) { const int i2 = it + NGW; const float* src = (i2 < 16384 ? U + (size_t)i2 * 1024 : V + (size_t)(i2 - 16384) * 1024) + s * 128 + j * 16;
#pragma unroll
            for (int c = 0; c < 4; ++c) nx[c] = *(const v4f*)(src + 4 * c); }
        v4i o;
        if (isu) {
            float ss = 0.f;
#pragma unroll
            for (int c = 0; c < 16; ++c) ss += x[c] * x[c];
            const float stp = 0.3352f * sqrtf(wave_sum_early(ss) * (1.f / 1024.f)) + 1e-30f, istp = 1.f / stp;
            unsigned nb[16]; int qs = 0;
#pragma unroll
            for (int c = 0; c < 16; ++c) { int q = (int)floorf(x[c] * istp); q = q < -8 ? -8 : (q > 7 ? 7 : q); qs += q; nb[c] = (unsigned)(q & 15); }
            const float qsum = wave_sum_early((float)qs);
            if (lane == 0) { SU[2 * e] = stp; SU[2 * e + 1] = 8.f * qsum; }
            v2u ow;
#pragma unroll
            for (int w = 0; w < 2; ++w) { unsigned ww = 0;
#pragma unroll
                for (int b = 0; b < 4; ++b) ww |= (nb[8 * w + b] | (nb[8 * w + 4 + b] << 4)) << (8 * b);
                ow[w] = ww; }
            *(v2u*)(UQ + (size_t)(lane >> 4) * SLICE_B + (size_t)e * 128 + (lane & 15) * 8) = ow;
        } else {
#pragma unroll
            for (int c = 0; c < 4; ++c) { int w = __builtin_amdgcn_cvt_pk_fp8_f32(x[4 * c], x[4 * c + 1], 0, false); w = __builtin_amdgcn_cvt_pk_fp8_f32(x[4 * c + 2], x[4 * c + 3], w, true); o[c] = w; }
            *(v4i*)(VQ + (size_t)s * SLICE_B + (size_t)e * 128 + j * 16) = o;
        }
    }
}
__device__ __forceinline__ void ph_prologue(const float* const* in, unsigned char* ws, LAS unsigned char* lds, int tid, int lane, int wave, int gw, int NGW) {
    LAS float* sv = (LAS float*)lds;
    LAS float* scr = (LAS float*)(lds + 24576 + wave * 8704);
    for (int i = tid; i < 5120; i += NTHR) { const int r = i >> 10, k = i & 1023; const float v = r < 4 ? in[1][r * 1024 + k] : in[3][k]; sv[i] = v / (1.f + __expf(-v)); }
    __syncthreads();
    {
        LAS float* red = (LAS float*)(lds + 24576);
        const int vb = (int)blockIdx.x;
        for (int item = vb; item < 192; item += (int)gridDim.x) {
            const int l = item / 96, col = (item % 96) * 64 + lane;
            const float* w = in[4] + (size_t)l * 1024 * 6144 + (size_t)(wave * 128) * 6144 + col;
            float acc[5] = {0.f, 0.f, 0.f, 0.f, 0.f};
#pragma unroll 16
            for (int k = 0; k < 128; ++k) { const float wv = w[(size_t)k * 6144];
#pragma unroll
                for (int r = 0; r < 5; ++r) acc[r] += sv[r * 1024 + wave * 128 + k] * wv; }
#pragma unroll
            for (int r = 0; r < 5; ++r) red[(wave * 5 + r) * 64 + lane] = acc[r];
            __syncthreads();
            if (wave < 5) { float s = 0.f;
#pragma unroll
                for (int ww = 0; ww < 8; ++ww) s += red[(ww * 5 + wave) * 64 + lane];
                ((float*)(ws + WS_MOD))[(l * 5 + wave) * 6144 + col] = s + in[5][l * 6144 + col]; }
            __syncthreads();
        }
    }
    constexpr int N_MOD = 0;
    constexpr int I_WOUT = 8 * 32, I_FOLD = 16 * 512, I_CDOUT = 16 * 32;
    constexpr int C_WIN = 4 * (AB_IN / 64), C_CDA = 4 * 32, C_CDB = 4 * 12, C_GATE = 4, I_WQ = 16 * 64;
    constexpr int C_WQ = 4 * 32;
    constexpr int N_TR = I_WOUT + I_FOLD + I_CDOUT + C_WIN + C_CDA + C_CDB + C_GATE + 2 * C_WQ;
    unsigned* cm = (unsigned*)(ws + WS_CTL) + CW_CMAX;
    for (int it = gw; it < N_TR; it += NGW) {
        int r = it;
        if (r < C_WIN) { colmax_item(in[8], AB_IN, AB_IN, cm + CM_WIN, r, lane); continue; } r -= C_WIN;
        if (r < C_CDA) { colmax_item(in[16], CD_IN, 2048, cm + CM_CD, r, lane); continue; } r -= C_CDA;
        if (r < C_CDB) { colmax_item(in[16] + 2064, CD_IN, 768, cm + CM_CD + 2048, r, lane); continue; } r -= C_CDB;
        if (r < C_GATE) { colmax_item(in[16] + 2048, CD_IN, 16, cm + CM_GATE, r, lane); continue; } r -= C_GATE;
        if (r < C_WQ) { colmax_item(in[22], 2048, 2048, cm + CM_WQ0, r, lane); continue; } r -= C_WQ;
        if (r < C_WQ) { colmax_item(in[22] + (size_t)1024 * 2048, 2048, 2048, cm + CM_WQ1, r, lane); continue; } r -= C_WQ;
        if (r < I_WOUT) { transpose_item(in[15] + (size_t)512 * 1024, 512, 1024, 1024, (bf16_t*)(ws + WS_W_OUT) + 512, scr, r, lane, 1024); continue; } r -= I_WOUT;
        if (r < I_FOLD) { fold_item(in[9], in[10], in[15], (bf16_t*)(ws + WS_W_OUT), r, lane); continue; } r -= I_FOLD;
        transpose_item(in[21], 1024, 1024, 1024, (bf16_t*)(ws + WS_CD_OUT), scr, r, lane);
    }
}
__device__ __forceinline__ void ph_moda(const float* xl, const float* xc, const float* mod  , int sh_off, int sc_off, signed char* HA8, float* SA, int nrows, int lane, int wave, int vcu, int G) {
    const int per = nrows / G, r0 = vcu * per;
    v4f msc[4], msh[4], A[4], B[4]; int cur_mod = -1;
    auto ld = [&](v4f (&R)[4], int r) { const float* xr = r < ML ? xl + (size_t)r * D : xc + (size_t)(r - ML) * D;
#pragma unroll
        for (int i = 0; i < 2; ++i) { R[2 * i] = *(const v4f*)(xr + i * 512 + lane * 8); R[2 * i + 1] = *(const v4f*)(xr + i * 512 + lane * 8 + 4); } };
    if (wave < per) ld(A, r0 + wave);
    for (int t = wave; t < per; t += 8) {
        const int r = r0 + t;
        if (t + 8 < per) ld(B, r + 8);
        const int mr = row_mod(r);
        if (mr != cur_mod) { cur_mod = mr; const float* m = mod + mr * 6144;
#pragma unroll
            for (int i = 0; i < 2; ++i) { const int e0 = i * 512 + lane * 8; msc[2 * i] = *(const v4f*)(m + sc_off + e0); msc[2 * i + 1] = *(const v4f*)(m + sc_off + e0 + 4); msh[2 * i] = *(const v4f*)(m + sh_off + e0); msh[2 * i + 1] = *(const v4f*)(m + sh_off + e0 + 4); } }
        v4f y[4]; float mx = 0.f;
#pragma unroll
        for (int i = 0; i < 4; ++i) { y[i] = A[i] * (msc[i] + 1.f) + msh[i]; mx = fmaxf(mx, fmaxf(fmaxf(fabsf(y[i][0]), fabsf(y[i][1])), fmaxf(fabsf(y[i][2]), fabsf(y[i][3])))); }
        mx = fmaxf(wave_max(mx), 1e-30f);
        const float inv = 127.f / mx;
        if (lane == 0) SA[r] = mx * (1.f / 127.f);
#pragma unroll
        for (int i = 0; i < 2; ++i) { v2u o; o.x = q8pack4(y[2 * i][0], y[2 * i][1], y[2 * i][2], y[2 * i][3], inv); o.y = q8pack4(y[2 * i + 1][0], y[2 * i + 1][1], y[2 * i + 1][2], y[2 * i + 1][3], inv);
            *(v2u*)(HA8 + (size_t)r * D + i * 512 + lane * 8) = o; }
#pragma unroll
        for (int i = 0; i < 4; ++i) A[i] = B[i];
    }
}

__device__ __forceinline__ float wave_sum(float v) {
#pragma unroll
    for (int o = 1; o < 64; o <<= 1) v += __shfl_xor(v, o);
    return v;
}
__device__ __forceinline__ void ph_attn_prep(const bf16_t* ZZ, const float* qn_g, const float* kn_g, bf16_t* QA, bf16_t* KA, bf16_t* VA, int gw, int NGW, int lane) {
    const int hs = lane >> 3, j = lane & 7;
    const int half = j >> 2, second = (j >> 1) & 1;
    float qg[8], kg[8], freq[8];
#pragma unroll
    for (int e = 0; e < 8; ++e) { qg[e] = qn_g[j * 8 + e] * attn_body::C2; kg[e] = kn_g[j * 8 + e]; freq[e] = exp2f(-(float)((j & 1) * 8 + e) * (13.287712379549449f / 16.f)); }
    const int col0 = 2048 + hs * 64 + j * 8, col1 = (hs < 2 ? 2560 + hs * 64 : 2688 + (hs & 1) * 64) + j * 8;
    v4u A0, A1, B0 = {0u, 0u, 0u, 0u}, B1 = {0u, 0u, 0u, 0u};
    if (gw < MT) { const bf16_t* zr = ZZ + (size_t)gw * ZZP; A0 = *(const v4u*)(zr + col0); A1 = *(const v4u*)(zr + col1); }
    for (int r = gw; r < MT; r += NGW) {
        if (r + NGW < MT) { const bf16_t* zn = ZZ + (size_t)(r + NGW) * ZZP; B0 = *(const v4u*)(zn + col0); B1 = *(const v4u*)(zn + col1); }
        const bool lat = r < ML; const int b = row_b(r), t = row_t(r);
        const size_t krow = (size_t)b * TK + (lat ? CTX + t : t);
        const float pos = half == 0 ? (float)(t >> 6) : (float)(t & 63);
        float cs[8], sn[8];
#pragma unroll
        for (int e = 0; e < 8; ++e) { const float ang = pos * freq[e]; cs[e] = lat ? __cosf(ang) : 1.f; sn[e] = lat ? __sinf(ang) : 0.f; }
#pragma unroll
        for (int pass = 0; pass < 2; ++pass) {
            if (pass == 0 && !lat) continue;
            const v4u raw = pass == 0 ? A0 : A1;
            float v[8] = {bflo(raw.x), bfhi(raw.x), bflo(raw.y), bfhi(raw.y), bflo(raw.z), bfhi(raw.z), bflo(raw.w), bfhi(raw.w)};
            float ss = 0.f;
#pragma unroll
            for (int e = 0; e < 8; ++e) ss += v[e] * v[e];
            ss += __shfl_xor(ss, 1); ss += __shfl_xor(ss, 2); ss += __shfl_xor(ss, 4);
            const float rs = rsqrtf(ss * (1.f / 64.f) + RMS_EPS);
            v4u o;
            if (pass == 1 && hs >= 2) o = raw;
            else {
#pragma unroll
                for (int e = 0; e < 8; ++e) { v[e] *= rs * (pass == 0 ? qg[e] : kg[e]);
                    const float ot = __shfl_xor(v[e], 2);
                    v[e] = second ? (ot * sn[e] + v[e] * cs[e]) : (v[e] * cs[e] - ot * sn[e]); }
                o.x = pk2(v[0], v[1]); o.y = pk2(v[2], v[3]); o.z = pk2(v[4], v[5]); o.w = pk2(v[6], v[7]);
            }
            if (pass == 0) *(v4u*)(QA + (size_t)r * 512 + hs * 64 + j * 8) = o;
            else if (hs < 2) *(v4u*)(KA + krow * 128 + hs * 64 + j * 8) = o;
            else if (hs < 4) *(v4u*)(VA + krow * 128 + (hs & 1) * 64 + j * 8) = o;
        }
        A0 = B0; A1 = B1;
    }
}

typedef short s16x8 __attribute__((ext_vector_type(8)));
typedef __bf16 bf16x2_v __attribute__((ext_vector_type(2)));
__device__ __forceinline__ int fkey(float f) { const int b = __float_as_int(f); return b ^ ((b >> 31) & 0x7fffffff); }
__device__ __forceinline__ float keyf(int k) { return __int_as_float(k ^ ((k >> 31) & 0x7fffffff)); }
template <int N> __device__ __forceinline__ void bitonic_sort_desc(int (&a)[N]) {
#pragma unroll
    for (int k = 2; k <= N; k <<= 1) {
#pragma unroll
        for (int j = k >> 1; j > 0; j >>= 1) {
#pragma unroll
            for (int i = 0; i < N; ++i) { const int l = i ^ j; if (l > i) { const bool desc = ((i & k) == 0); const int hi = max(a[i], a[l]), lo = min(a[i], a[l]); a[i] = desc ? hi : lo; a[l] = desc ? lo : hi; } }
        }
    }
}
template <int N> __device__ __forceinline__ void oem_sort_desc(int (&a)[N]) {
#pragma unroll
    for (int p = 1; p < N; p <<= 1) {
#pragma unroll
        for (int k = p; k >= 1; k >>= 1) {
#pragma unroll
            for (int j = k % p; j <= N - 1 - k; j += 2 * k) {
#pragma unroll
                for (int i = 0; i <= (k - 1 < N - j - k - 1 ? k - 1 : N - j - k - 1); ++i) {
                    if ((i + j) / (2 * p) == (i + j + k) / (2 * p)) { const int x = i + j, y = i + j + k; const int hi = max(a[x], a[y]), lo = min(a[x], a[y]); a[x] = hi; a[y] = lo; } }
            }
        }
    }
}
template <int N> __device__ __forceinline__ void bitonic_clean_desc(int (&a)[N]) {
#pragma unroll
    for (int j = N >> 1; j > 0; j >>= 1) {
#pragma unroll
        for (int i = 0; i < N; ++i) { const int l = i ^ j; if (l > i) { const int hi = max(a[i], a[l]), lo = min(a[i], a[l]); a[i] = hi; a[l] = lo; } }
    }
}
__device__ __forceinline__ void merge_top16(int (&a)[16], const int (&b)[16]) {
#pragma unroll
    for (int i = 0; i < 16; ++i) a[i] = max(a[i], b[15 - i]);
    bitonic_clean_desc<16>(a);
}
__device__ __forceinline__ int ckey(float v, int pos) { return (fkey(v) & ~255) | (255 - pos); }

__device__ __forceinline__ void ph_route(const bf16_t* Q, const float* keys, unsigned* IDXG, int ntok, LAS unsigned char* lds, int tid, int lane, int wave, int vcu, int G) {
    LAS unsigned char* kl = lds;
    for (int i = tid; i < 4096; i += NTHR) { const int row = i >> 4, ch = i & 15; const float* src = keys + row * 128 + ch * 8;
        const v4f x0 = *(const v4f*)src, x1 = *(const v4f*)(src + 4);
        v4u o; o.x = pk2(x0[0], x0[1]); o.y = pk2(x0[2], x0[3]); o.z = pk2(x1[0], x1[1]); o.w = pk2(x1[2], x1[3]);
        *(LAS v4u*)(kl + row * 272 + ch * 16) = o; }
    __syncthreads();
    LAS int* rowscr = (LAS int*)(lds + 69632 + wave * 8192);
    const int n = lane & 15, q4 = lane >> 4;
    const int per = ntok / G, tok0 = vcu * per, ntile = per / 2;
    for (int tb = wave; tb < ntile; tb += 32) {
        int s0[16], s1[16];
#pragma unroll
        for (int i = 0; i < 16; ++i) { s0[i] = 0; s1[i] = 0; }
#pragma unroll 1
        for (int T = 0; T < 4; ++T) {
            const int tile = tb + 8 * T;
            if (tile < ntile) {
                const int tok = tok0 + tile * 2 + (n >> 3), head = n & 7;
                const bf16_t* qrow = Q + (size_t)tok * 2048 + head * 256;
#pragma unroll
                for (int p = 0; p < 2; ++p) {
                    s16x8 bq[4];
#pragma unroll
                    for (int ks = 0; ks < 4; ++ks) bq[ks] = *(const s16x8*)(qrow + p * 128 + ks * 32 + q4 * 8);
                    int v[32];
#pragma unroll
                    for (int kt = 0; kt < 8; ++kt) {
                        pg8::f32x4 acc = {0.f, 0.f, 0.f, 0.f};
#pragma unroll
                        for (int ks = 0; ks < 4; ++ks) { const s16x8 af = *(const LAS s16x8*)(kl + (p * 128 + kt * 16 + n) * 272 + ks * 64 + q4 * 16);
                            acc = __builtin_amdgcn_mfma_f32_16x16x32_bf16(af, bq[ks], acc, 0, 0, 0); }
#pragma unroll
                        for (int r = 0; r < 4; ++r) v[kt * 4 + r] = (fkey(acc[r]) & ~127) | (127 - (kt * 16 + q4 * 4 + r));
                    }
                    int a16[16], hi16[16];
#pragma unroll
                    for (int i = 0; i < 16; ++i) { a16[i] = v[i]; hi16[i] = v[16 + i]; }
                    oem_sort_desc<16>(a16); oem_sort_desc<16>(hi16); merge_top16(a16, hi16);
#pragma unroll
                    for (int xm = 16; xm <= 32; xm <<= 1) { int b[16];
#pragma unroll
                        for (int i = 0; i < 16; ++i) b[i] = __shfl_xor(a16[i], xm);
                        merge_top16(a16, b); }
                    const bool mine = (q4 == T);
#pragma unroll
                    for (int i = 0; i < 16; ++i) { if (p == 0) s0[i] = mine ? a16[i] : s0[i]; else s1[i] = mine ? a16[i] : s1[i]; }
                }
            }
        }
        const int mytile = tb + 8 * q4;
#pragma unroll
        for (int i = 0; i < 16; ++i) { rowscr[lane * 32 + i] = s0[i]; rowscr[lane * 32 + 16 + i] = s1[i]; }
        float f0[16], f1[16];
#pragma unroll
        for (int i = 0; i < 16; ++i) { f0[i] = keyf(s0[i] & ~127); f1[i] = keyf(s1[i] & ~127); }
        int g0[16], g1[16], g2[16], g3[16];
        constexpr int NEG = (int)0x80000000;
#pragma unroll
        for (int j = 0; j < 16; ++j) { g0[j] = ckey(f0[0] + f1[j], j); g1[j] = NEG; g2[j] = NEG; g3[j] = NEG; }
#pragma unroll
        for (int j = 0; j < 8; ++j) g1[j] = ckey(f0[1] + f1[j], 16 + j);
#pragma unroll
        for (int j = 0; j < 5; ++j) g1[8 + j] = ckey(f0[2] + f1[j], 32 + j);
#pragma unroll
        for (int j = 0; j < 4; ++j) g2[j] = ckey(f0[3] + f1[j], 48 + j);
#pragma unroll
        for (int j = 0; j < 3; ++j) g2[4 + j] = ckey(f0[4] + f1[j], 64 + j);
#pragma unroll
        for (int i = 5; i < 8; ++i) { g2[7 + (i - 5) * 2] = ckey(f0[i] + f1[0], i * 16); g2[8 + (i - 5) * 2] = ckey(f0[i] + f1[1], i * 16 + 1); }
#pragma unroll
        for (int i = 8; i < 16; ++i) g3[i - 8] = ckey(f0[i] + f1[0], i * 16);
        oem_sort_desc<16>(g1); oem_sort_desc<16>(g2); oem_sort_desc<16>(g3);
        merge_top16(g0, g1); merge_top16(g2, g3); merge_top16(g0, g2);
        float t[16]; float den = 0.f;
#pragma unroll
        for (int k = 0; k < 16; ++k) { t[k] = __expf(keyf(g0[k] & ~255) - keyf(g0[0] & ~255)); den += t[k]; }
        const float rden = __builtin_amdgcn_rcpf(den);
        if (mytile < ntile) {
            const int tok = tok0 + mytile * 2 + (n >> 3), head = n & 7;
            unsigned* op = IDXG + ((size_t)tok * 8 + head) * 16;
#pragma unroll
            for (int e4 = 0; e4 < 4; ++e4) { v4u ov;
#pragma unroll
                for (int e = 0; e < 4; ++e) { const int k = e4 * 4 + e; const int pos = 255 - (g0[k] & 255);
                    const int k0 = rowscr[lane * 32 + (pos >> 4)], k1 = rowscr[lane * 32 + 16 + (pos & 15)];
                    ov[e] = (unsigned)((127 - (k0 & 127)) * 128 + (127 - (k1 & 127))) | ((unsigned)f2bf(t[k] * rden) << 16); }
                *(v4u*)(op + e4 * 4) = ov; }
        }
    }
}

#ifndef GATHER_FUSE
#define GATHER_FUSE 1
#endif
template <class TO>
__device__ __forceinline__ void ph_gather(const bf16_t* X1, const signed char* H8, const float* HSC, const unsigned* IDXG, const unsigned char* UQ, const float* SU, const unsigned char* VQ, bf16_t* F,
                                          const float* modl, int g_off, const float* lng, const float* lnb, TO* XO, signed char* HAo, float* SA, const float* modn, int nsh_off, int nsc_off, const float* WG  , const unsigned* GCMp  , float* GT,
                                          int ntok, LAS unsigned char* lds, int tid, int lane, int wave, int vcu, int G) {
    const int per = ntok / G, tok0 = vcu * per;
    LAS unsigned* igl = (LAS unsigned*)lds;
    LAS float* act = (LAS float*)(lds + 67584);
    for (int i = tid; i < per * 128; i += NTHR) { igl[i] = IDXG[(size_t)tok0 * 128 + i]; act[i] = 0.f; }
    __syncthreads();
    {
        const int g = lane >> 3, j = lane & 7;
        const int ib = ((lane >> 2) & 1) * 8 + ((lane >> 1) & 1) * 4 + (lane & 1) * 2;
        for (int s = 0; s < 4; ++s) {
            const unsigned char* Us = UQ + (size_t)s * SLICE_B + j * 16;
            for (int t = wave; t < per; t += 8) {
                const signed char* hp = H8 + (size_t)(tok0 + t) * 1024 + (s * 32 + j * 4) * 4;
                const v4i hH = *(const v4i*)hp, hL = *(const v4i*)(hp + 512);
                v4i d[16];
#pragma unroll
                for (int i = 0; i < 16; ++i) { const unsigned e = igl[t * 128 + i * 8 + g] & 0xffffu; d[i] = *(const v4i*)(Us + (size_t)e * 128); }
                int pp[16];
#pragma unroll
                for (int i = 0; i < 16; ++i) { int a1 = 0, a2 = 0;
#pragma unroll
                    for (int w = 0; w < 4; ++w) { a1 = __builtin_amdgcn_sdot8(d[i][w], hH[w], a1, false); a2 = __builtin_amdgcn_sdot8(d[i][w], hL[w], a2, false); }
                    pp[i] = a1 * 16 + a2; }
                int q8[8], q4_[4], q2[2];
                { const bool up = (lane & 4) != 0;
#pragma unroll
                  for (int m = 0; m < 8; ++m) { const int snd = up ? pp[m] : pp[m + 8], kp = up ? pp[m + 8] : pp[m]; q8[m] = kp + __shfl_xor(snd, 4); } }
                { const bool up = (lane & 2) != 0;
#pragma unroll
                  for (int m = 0; m < 4; ++m) { const int snd = up ? q8[m] : q8[m + 4], kp = up ? q8[m + 4] : q8[m]; q4_[m] = kp + __shfl_xor(snd, 2); } }
                { const bool up = (lane & 1) != 0;
#pragma unroll
                  for (int m = 0; m < 2; ++m) { const int snd = up ? q4_[m] : q4_[m + 2], kp = up ? q4_[m + 2] : q4_[m]; q2[m] = kp + __shfl_xor(snd, 1); } }
                LAS float* ap = act + t * 128 + ib * 8 + g;
                ap[0] += (float)q2[0]; ap[8] += (float)q2[1];
            }
        }
    }
    __syncthreads();
    for (int i = tid; i < per * 128; i += NTHR) { const unsigned ig = igl[i]; const float* hc = HSC + 2 * (size_t)(tok0 + (i >> 7)); const float* su = SU + 2 * (ig & 0xffffu); const float av = su[0] * hc[0] * (act[i] + su[1] + hc[1]);
        act[i] = bfhi(ig) * 0.5f * av * (1.f + erff(av * 0.70710678118654752f)); }
    const unsigned* GCM = GCMp;
    LAS unsigned short* igl16 = (LAS unsigned short*)lds;
    LAS signed char* wg8 = (LAS signed char*)(lds + 33792);
    if (WG) {
        unsigned short tmp[33];
#pragma unroll
        for (int k = 0; k < 33; ++k) { const int i = tid + k * NTHR; tmp[k] = (unsigned short)(i < per * 128 ? (igl[i] & 0xffffu) : 0u); }
        __syncthreads();
#pragma unroll
        for (int k = 0; k < 33; ++k) { const int i = tid + k * NTHR; if (i < per * 128) igl16[i] = tmp[k]; }
        for (int k = tid; k < 1024; k += NTHR) { const float* src = WG + (size_t)k * CD_IN;
#pragma unroll
            for (int c = 0; c < 4; ++c) { const v4f x = *(const v4f*)(src + 4 * c);
#pragma unroll
                for (int m = 0; m < 4; ++m) { const float inv = 127.f / fmaxf(__uint_as_float(GCM[4 * c + m]), 1e-30f); int q = __float2int_rn(x[m] * inv); q = q > 127 ? 127 : (q < -127 ? -127 : q); wg8[(4 * c + m) * 1024 + k] = (signed char)q; } } }
    }
    const bool fuse = (GATHER_FUSE != 0);
    LAS float* pga = (LAS float*)(lds + 135168); LAS float* pba = pga + 1024; LAS float* pmg = pba + 1024;
    LAS bf16_t* pset = (LAS bf16_t*)(lds + 135168 + 8192);
    LAS unsigned* fscr = (LAS unsigned*)(lds + 135168 + 20480) + wave * 64;
    const int mrA = row_mod(tok0), mrB = row_mod(tok0 + per - 1);
    if (fuse) {
        for (int i = tid; i < 1024; i += NTHR) { pga[i] = lng[i]; pba[i] = lnb[i]; }
        if (HAo) { for (int i = tid; i < 2048; i += NTHR) { const int sI = i >> 10, e = i & 1023, mr = sI ? mrB : mrA;
                       pset[sI * 3072 + e] = f2bf(modl[mr * 6144 + g_off + e]); pset[sI * 3072 + 1024 + e] = f2bf(modn[mr * 6144 + nsc_off + e]); pset[sI * 3072 + 2048 + e] = f2bf(modn[mr * 6144 + nsh_off + e]); } }
        else { const float* m = modl + mrA * 6144 + g_off; for (int i = tid; i < 1024; i += NTHR) pmg[i] = m[i]; }
    }
    __syncthreads();
    {
        const int g = lane >> 3, j = lane & 7;
        const int ebase = ((lane >> 5) & 1) * 8 + ((lane >> 4) & 1) * 4 + ((lane >> 3) & 1) * 2;
#ifndef GATHER_VREP
#define GATHER_VREP 1
#endif
        auto vissue = [&](int t, const unsigned char* Vs, v4i (&d)[16], float (&wv)[16]) {
#pragma unroll
                for (int i = 0; i < 16; ++i) { const int k = i * 8 + g; const unsigned e = WG ? (unsigned)igl16[t * 128 + k] : (igl[t * 128 + k] & 0xffffu); wv[i] = act[t * 128 + k]; d[i] = *(const v4i*)(Vs + (size_t)e * 128); } };
        auto vreduce = [&](const v4i (&d)[16], const float (&wv)[16]) -> v2f {
                v2f acc[8];
#pragma unroll
                for (int m = 0; m < 8; ++m) acc[m] = (v2f){0.f, 0.f};
#pragma unroll
                for (int i = 0; i < 16; ++i) { const v2f w2 = {wv[i], wv[i]};
#pragma unroll
                    for (int c = 0; c < 4; ++c) { acc[2 * c] += w2 * __builtin_amdgcn_cvt_pk_f32_fp8(d[i][c], false); acc[2 * c + 1] += w2 * __builtin_amdgcn_cvt_pk_f32_fp8(d[i][c], true); } }
                v2f b4[4], b2[2], b1;
                { const bool up = (lane & 32) != 0;
#pragma unroll
                  for (int m = 0; m < 4; ++m) { const v2f snd = up ? acc[m] : acc[m + 4], kp = up ? acc[m + 4] : acc[m]; b4[m] = (v2f){kp.x + __shfl_xor(snd.x, 32), kp.y + __shfl_xor(snd.y, 32)}; } }
                { const bool up = (lane & 16) != 0;
#pragma unroll
                  for (int m = 0; m < 2; ++m) { const v2f snd = up ? b4[m] : b4[m + 2], kp = up ? b4[m + 2] : b4[m]; b2[m] = (v2f){kp.x + __shfl_xor(snd.x, 16), kp.y + __shfl_xor(snd.y, 16)}; } }
                { const bool up = (lane & 8) != 0; const v2f snd = up ? b2[0] : b2[1], kp = up ? b2[1] : b2[0]; b1 = (v2f){kp.x + __shfl_xor(snd.x, 8), kp.y + __shfl_xor(snd.y, 8)}; }
                return b1; };
        const int nplain = fuse ? 7 : 8;
        for (int s = 0; s < nplain; ++s) {
            const unsigned char* Vs = VQ + (size_t)s * SLICE_B + j * 16;
            for (int t = wave; t < per; t += 8) {
                v4i d[16]; float wv[16]; vissue(t, Vs, d, wv);
                const v2f b1 = vreduce(d, wv);
                __builtin_nontemporal_store(pk2(b1.x, b1.y), (unsigned*)(F + (size_t)(tok0 + t) * 1024 + s * 128 + j * 16 + ebase));
            }
        }
        if (fuse) {
            const unsigned char* Vs = VQ + (size_t)7 * SLICE_B + j * 16;
            auto rowload = [&](int t, v4u (&xw)[2], v4u (&fw)[2]) { const int tok = tok0 + t;
                const bf16_t* xr = X1 + (size_t)tok * 1024 + lane * 8; const bf16_t* fr = F + (size_t)tok * 1024 + lane * 8;
                xw[0] = __builtin_nontemporal_load((const v4u*)xr); xw[1] = __builtin_nontemporal_load((const v4u*)(xr + 512)); fw[0] = __builtin_nontemporal_load((const v4u*)fr); fw[1] = __builtin_nontemporal_load((const v4u*)(fr + (lane < 48 ? 512 : 0))); };
            v4u xw[2], fw[2];
            auto finish = [&](int tok) {
                unsigned yq[4] = {0u, 0u, 0u, 0u}; float ysc = 0.f;
                if (lane >= 48) fw[1] = *(const LAS v4u*)(fscr + (lane - 48) * 4);
                const LAS bf16_t* psel = pset + (row_mod(tok) != mrA ? 3072 : 0);
                float v[16]; float sm = 0.f;
#pragma unroll
                for (int i = 0; i < 2; ++i) {
                    const v4f x0 = {bflo(xw[i].x), bfhi(xw[i].x), bflo(xw[i].y), bfhi(xw[i].y)}, x1 = {bflo(xw[i].z), bfhi(xw[i].z), bflo(xw[i].w), bfhi(xw[i].w)};
                    const v4f f0 = {bflo(fw[i].x), bfhi(fw[i].x), bflo(fw[i].y), bfhi(fw[i].y)}, f1 = {bflo(fw[i].z), bfhi(fw[i].z), bflo(fw[i].w), bfhi(fw[i].w)};
                    v4f g0, g1;
                    if (HAo) { const v4u gw = *(const LAS v4u*)(psel + i * 512 + lane * 8); g0 = (v4f){bflo(gw.x), bfhi(gw.x), bflo(gw.y), bfhi(gw.y)}; g1 = (v4f){bflo(gw.z), bfhi(gw.z), bflo(gw.w), bfhi(gw.w)}; }
                    else { g0 = *(const LAS v4f*)(pmg + i * 512 + lane * 8); g1 = *(const LAS v4f*)(pmg + i * 512 + lane * 8 + 4); }
#pragma unroll
                    for (int c = 0; c < 4; ++c) { v[i * 8 + c] = DN_ALPHA * x0[c] + g0[c] * f0[c]; v[i * 8 + 4 + c] = DN_ALPHA * x1[c] + g1[c] * f1[c]; } }
#pragma unroll
                for (int c = 0; c < 16; ++c) sm += v[c];
                const float mu = wave_sum(sm) * (1.f / 1024.f);
                float qq = 0.f;
#pragma unroll
                for (int c = 0; c < 16; ++c) { v[c] -= mu; qq += v[c] * v[c]; }
                const float rstd = rsqrtf(wave_sum(qq) * (1.f / 1024.f) + LN_EPS);
                TO* xo = XO + (size_t)tok * 1024 + lane * 8;
#pragma unroll
                for (int i = 0; i < 2; ++i) {
                    const v4f a0 = *(const LAS v4f*)(pga + i * 512 + lane * 8), a1 = *(const LAS v4f*)(pga + i * 512 + lane * 8 + 4), c0 = *(const LAS v4f*)(pba + i * 512 + lane * 8), c1 = *(const LAS v4f*)(pba + i * 512 + lane * 8 + 4);
                    v4f o0, o1;
#pragma unroll
                    for (int c = 0; c < 4; ++c) { o0[c] = v[i * 8 + c] * rstd * a0[c] + c0[c]; o1[c] = v[i * 8 + 4 + c] * rstd * a1[c] + c1[c]; }
                    st8nt(xo + i * 512, o0, o1);
                    if (HAo) { const v4u sw = *(const LAS v4u*)(psel + 1024 + i * 512 + lane * 8), hw = *(const LAS v4u*)(psel + 2048 + i * 512 + lane * 8);
                        const v4f s0 = {bflo(sw.x), bfhi(sw.x), bflo(sw.y), bfhi(sw.y)}, s1 = {bflo(sw.z), bfhi(sw.z), bflo(sw.w), bfhi(sw.w)}, h0 = {bflo(hw.x), bfhi(hw.x), bflo(hw.y), bfhi(hw.y)}, h1 = {bflo(hw.z), bfhi(hw.z), bflo(hw.w), bfhi(hw.w)};
                        const v4f y0 = o0 * (s0 + 1.f) + h0, y1 = o1 * (s1 + 1.f) + h1;
#pragma unroll
                        for (int c = 0; c < 4; ++c) { v[i * 8 + c] = y0[c]; v[i * 8 + 4 + c] = y1[c]; } }
                }
                if (HAo) {
                    float mx = 0.f;
#pragma unroll
                    for (int c = 0; c < 16; ++c) mx = fmaxf(mx, fabsf(v[c]));
                    mx = fmaxf(wave_max(mx), 1e-30f);
                    const float inv = 127.f / mx;
                    if (lane == 0) SA[tok] = mx * (1.f / 127.f);
                    ysc = mx * (1.f / 127.f);
#pragma unroll
                    for (int i = 0; i < 2; ++i) { v2u o; o.x = q8pack4(v[i * 8], v[i * 8 + 1], v[i * 8 + 2], v[i * 8 + 3], inv); o.y = q8pack4(v[i * 8 + 4], v[i * 8 + 5], v[i * 8 + 6], v[i * 8 + 7], inv);
                        yq[2 * i] = o.x; yq[2 * i + 1] = o.y;
                        *(v2u*)(HAo + (size_t)tok * 1024 + i * 512 + lane * 8) = o; }
                }
                if (WG) {
                    float pq[16];
#pragma unroll
                    for (int gi = 0; gi < 16; ++gi) { const v2u wl = *(const LAS v2u*)(wg8 + gi * 1024 + lane * 8), wh = *(const LAS v2u*)(wg8 + gi * 1024 + 512 + lane * 8);
                        int a = __builtin_amdgcn_sdot4((int)wl.x, (int)yq[0], 0, false); a = __builtin_amdgcn_sdot4((int)wl.y, (int)yq[1], a, false);
                        a = __builtin_amdgcn_sdot4((int)wh.x, (int)yq[2], a, false); a = __builtin_amdgcn_sdot4((int)wh.y, (int)yq[3], a, false);
                        pq[gi] = (float)a; }
                    float p8[8], p4[4], p2[2], p1;
                    { const bool up = (lane & 32) != 0;
#pragma unroll
                      for (int m = 0; m < 8; ++m) { const float snd = up ? pq[m] : pq[m + 8], kp = up ? pq[m + 8] : pq[m]; p8[m] = kp + __shfl_xor(snd, 32); } }
                    { const bool up = (lane & 16) != 0;
#pragma unroll
                      for (int m = 0; m < 4; ++m) { const float snd = up ? p8[m] : p8[m + 4], kp = up ? p8[m + 4] : p8[m]; p4[m] = kp + __shfl_xor(snd, 16); } }
                    { const bool up = (lane & 8) != 0;
#pragma unroll
                      for (int m = 0; m < 2; ++m) { const float snd = up ? p4[m] : p4[m + 2], kp = up ? p4[m + 2] : p4[m]; p2[m] = kp + __shfl_xor(snd, 8); } }
                    { const bool up = (lane & 4) != 0; const float snd = up ? p2[0] : p2[1], kp = up ? p2[1] : p2[0]; p1 = kp + __shfl_xor(snd, 4); }
                    p1 += __shfl_xor(p1, 2); p1 += __shfl_xor(p1, 1);
                    if ((lane & 3) == 0) GT[(size_t)tok * 16 + (lane >> 2)] = p1 * ysc * (__uint_as_float(GCM[lane >> 2]) * (1.f / 127.f));
                }
            };
            int prev = -1;
            for (int t = wave; t < per; t += 8) {
                v4i d[16]; float wv[16]; vissue(t, Vs, d, wv);
                asm volatile("" ::: "memory"); __builtin_amdgcn_sched_barrier(0);
                if (prev >= 0) finish(tok0 + prev);
                asm volatile("" ::: "memory"); __builtin_amdgcn_sched_barrier(0);
                rowload(t, xw, fw);
                asm volatile("" ::: "memory"); __builtin_amdgcn_sched_barrier(0);
                const v2f b1 = vreduce(d, wv);
                fscr[(j * 16 + ebase) >> 1] = pk2(b1.x, b1.y);
                prev = t;
            }
            if (prev >= 0) finish(tok0 + prev);
            return;
        }
    }
    asm volatile("s_waitcnt vmcnt(0)" ::: "memory");
    __syncthreads();
    LAS float* wgT = (LAS float*)lds;
    if (WG) { for (int k = tid; k < 1024; k += NTHR) { const float* src = WG + (size_t)k * CD_IN;
#pragma unroll
            for (int c = 0; c < 4; ++c) { const v4f x = *(const v4f*)(src + 4 * c); wgT[(4 * c) * 1024 + k] = x[0]; wgT[(4 * c + 1) * 1024 + k] = x[1]; wgT[(4 * c + 2) * 1024 + k] = x[2]; wgT[(4 * c + 3) * 1024 + k] = x[3]; } }
        __syncthreads(); }
    v4f ga[4], ba[4], mg[4], msc[4], msh[4];
#pragma unroll
    for (int i = 0; i < 2; ++i) { const int e0 = i * 512 + lane * 8; ga[2 * i] = *(const v4f*)(lng + e0); ga[2 * i + 1] = *(const v4f*)(lng + e0 + 4); ba[2 * i] = *(const v4f*)(lnb + e0); ba[2 * i + 1] = *(const v4f*)(lnb + e0 + 4);
        msc[2 * i] = msc[2 * i + 1] = msh[2 * i] = msh[2 * i + 1] = (v4f){0.f, 0.f, 0.f, 0.f}; }
    int cur_mod = -1;
    for (int t = wave; t < per; t += 8) {
        const int tok = tok0 + t;
        const int mr = row_mod(tok);
        if (mr != cur_mod) { cur_mod = mr; const float* m = modl + mr * 6144 + g_off;
#pragma unroll
            for (int i = 0; i < 2; ++i) { const int e0 = i * 512 + lane * 8; mg[2 * i] = *(const v4f*)(m + e0); mg[2 * i + 1] = *(const v4f*)(m + e0 + 4); }
            if (HAo) { const float* mn = modn + mr * 6144;
#pragma unroll
                for (int i = 0; i < 2; ++i) { const int e0 = i * 512 + lane * 8; msc[2 * i] = *(const v4f*)(mn + nsc_off + e0); msc[2 * i + 1] = *(const v4f*)(mn + nsc_off + e0 + 4); msh[2 * i] = *(const v4f*)(mn + nsh_off + e0); msh[2 * i + 1] = *(const v4f*)(mn + nsh_off + e0 + 4); } } }
        const bf16_t* xr = X1 + (size_t)tok * 1024 + lane * 8; const bf16_t* fr = F + (size_t)tok * 1024 + lane * 8;
        float v[16]; float s = 0.f;
#pragma unroll
        for (int i = 0; i < 2; ++i) {
            v4f x0, x1; ld8(xr + i * 512, x0, x1); const v4u fw = *(const v4u*)(fr + i * 512);
            const v4f f0 = {bflo(fw.x), bfhi(fw.x), bflo(fw.y), bfhi(fw.y)}, f1 = {bflo(fw.z), bfhi(fw.z), bflo(fw.w), bfhi(fw.w)};
#pragma unroll
            for (int c = 0; c < 4; ++c) { v[i * 8 + c] = DN_ALPHA * x0[c] + mg[2 * i][c] * f0[c]; v[i * 8 + 4 + c] = DN_ALPHA * x1[c] + mg[2 * i + 1][c] * f1[c]; } }
#pragma unroll
        for (int c = 0; c < 16; ++c) s += v[c];
        const float mu = wave_sum(s) * (1.f / 1024.f);
        float qq = 0.f;
#pragma unroll
        for (int c = 0; c < 16; ++c) { v[c] -= mu; qq += v[c] * v[c]; }
        const float rstd = rsqrtf(wave_sum(qq) * (1.f / 1024.f) + LN_EPS);
        TO* xo = XO + (size_t)tok * 1024 + lane * 8;
#pragma unroll
        for (int i = 0; i < 2; ++i) {
            v4f o0, o1;
#pragma unroll
            for (int c = 0; c < 4; ++c) { o0[c] = v[i * 8 + c] * rstd * ga[2 * i][c] + ba[2 * i][c]; o1[c] = v[i * 8 + 4 + c] * rstd * ga[2 * i + 1][c] + ba[2 * i + 1][c]; }
            st8(xo + i * 512, o0, o1);
            if (HAo) {
                const v4f y0 = o0 * (msc[2 * i] + 1.f) + msh[2 * i], y1 = o1 * (msc[2 * i + 1] + 1.f) + msh[2 * i + 1];
#pragma unroll
                for (int c = 0; c < 4; ++c) { v[i * 8 + c] = y0[c]; v[i * 8 + 4 + c] = y1[c]; } }
        }
        if (HAo) {
            float mx = 0.f;
#pragma unroll
            for (int c = 0; c < 16; ++c) mx = fmaxf(mx, fabsf(v[c]));
            mx = fmaxf(wave_max(mx), 1e-30f);
            const float inv = 127.f / mx;
            if (lane == 0) SA[tok] = mx * (1.f / 127.f);
#pragma unroll
            for (int i = 0; i < 2; ++i) { v2u o; o.x = q8pack4(v[i * 8], v[i * 8 + 1], v[i * 8 + 2], v[i * 8 + 3], inv); o.y = q8pack4(v[i * 8 + 4], v[i * 8 + 5], v[i * 8 + 6], v[i * 8 + 7], inv);
                *(v2u*)(HAo + (size_t)tok * 1024 + i * 512 + lane * 8) = o; }
        }
        if (WG) {
#pragma unroll 1
            for (int gq = 0; gq < 4; ++gq) {
                float gp[4];
#pragma unroll
                for (int m = 0; m < 4; ++m) { const LAS float* wr = wgT + (gq * 4 + m) * 1024 + lane * 8; float a = 0.f;
#pragma unroll
                    for (int i = 0; i < 2; ++i) { const v4f w0 = *(const LAS v4f*)(wr + i * 512), w1 = *(const LAS v4f*)(wr + i * 512 + 4);
#pragma unroll
                        for (int c = 0; c < 4; ++c) a += v[i * 8 + c] * w0[c] + v[i * 8 + 4 + c] * w1[c]; }
                    gp[m] = a; }
                float g2[2], g1;
                { const bool up = (lane & 32) != 0;
#pragma unroll
                  for (int m = 0; m < 2; ++m) { const float snd = up ? gp[m] : gp[m + 2], kp = up ? gp[m + 2] : gp[m]; g2[m] = kp + __shfl_xor(snd, 32); } }
                { const bool up = (lane & 16) != 0; const float snd = up ? g2[0] : g2[1], kp = up ? g2[1] : g2[0]; g1 = kp + __shfl_xor(snd, 16); }
                g1 += __shfl_xor(g1, 8); g1 += __shfl_xor(g1, 4); g1 += __shfl_xor(g1, 2); g1 += __shfl_xor(g1, 1);
                if ((lane & 15) == 0) GT[(size_t)tok * 16 + gq * 4 + ((lane >> 5) & 1) * 2 + ((lane >> 4) & 1)] = g1;
            }
        }
    }
}


__device__ __forceinline__ void ph_mixab(const bf16_t* Z, const float* conv_w, const float* conv_b, const float* cln_g, const float* cln_b, signed char* MIX8, float* SA,
                                         LAS unsigned char* lds, int tid, int lane, int wave, int vcu, int G) {
    LAS float* ybuf = (LAS float*)lds;
    LAS bf16_t* ul = (LAS bf16_t*)(lds + 32768);
    LAS bf16_t* zl = (LAS bf16_t*)(lds + 32768 + 47104);
    LAS float* pdl = (LAS float*)(lds + 32768 + 47104 + 32768);
    const int c = tid;
    float w[31];
#pragma unroll
    for (int k = 0; k < 31; ++k) w[k] = conv_w[k * 512 + c];
    const float cb = conv_b[c];
    const int pw = 1 << (c >> 7);
    for (int unit = vcu; unit < MT / 16; unit += G) {
        const int r0 = unit * 16, t0 = row_t(r0), T = row_T(r0);
        __syncthreads();
        for (int it = tid; it < 46 * 64; it += NTHR) { const int i = it >> 6, ch = it & 63, t = t0 - 15 + i; v4u o = {0u, 0u, 0u, 0u};
            if (t >= 0 && t < T) { const bf16_t* zr = Z + (size_t)(r0 - 15 + i) * AB_IN + 512 + ch * 8; const v4u av = *(const v4u*)zr, gv = *(const v4u*)(zr + 512);
#pragma unroll
                for (int e = 0; e < 4; ++e) o[e] = pk2(bflo(av[e]) * __builtin_amdgcn_rcpf(1.f + __expf(-bflo(gv[e]))), bfhi(av[e]) * __builtin_amdgcn_rcpf(1.f + __expf(-bfhi(gv[e])))); }
            *(LAS v4u*)(ul + i * 512 + ch * 8) = o; }
        for (int it = tid; it < 32 * 64; it += NTHR) { const int i = it >> 6, ch = it & 63, t = t0 - 8 + i; v4u o = {0u, 0u, 0u, 0u};
            if (t >= 0 && t < T) o = *(const v4u*)(Z + (size_t)(r0 - 8 + i) * AB_IN + ch * 8);
            *(LAS v4u*)(zl + i * 512 + ch * 8) = o; }
        __syncthreads();
        {
            float s = 0.f;
            for (int jj = 8 - pw; jj < 8 + pw; ++jj) s += bf2f(zl[jj * 512 + c]);
#pragma unroll
            for (int o = 0; o < 16; ++o) {
                const int t = t0 + o; const int lo = t - pw < 0 ? 0 : t - pw, hi = t + pw > T ? T : t + pw;
                pdl[o * 512 + c] = s * __builtin_amdgcn_rcpf((float)(hi - lo)) - bf2f(zl[(o + 8) * 512 + c]);
                s += bf2f(zl[(o + 8 + pw) * 512 + c]) - bf2f(zl[(o + 8 - pw) * 512 + c]);
            }
        }
        float win[31];
#pragma unroll
        for (int i = 0; i < 46; ++i) {
            win[i % 31] = bf2f(ul[i * 512 + c]);
            if (i >= 30) { const int o = i - 30; float y = cb;
#pragma unroll
                for (int k = 0; k < 31; ++k) y += w[k] * win[(o + k) % 31];
                ybuf[o * 512 + c] = y; }
        }
        __syncthreads();
#pragma unroll
        for (int rr = 0; rr < 2; ++rr) { const int o = wave * 2 + rr;
            const v4f y0 = *(const LAS v4f*)(ybuf + o * 512 + lane * 8), y1 = *(const LAS v4f*)(ybuf + o * 512 + lane * 8 + 4);
            float s = (y0[0] + y0[1]) + (y0[2] + y0[3]) + (y1[0] + y1[1]) + (y1[2] + y1[3]);
            const float mu = wave_sum(s) * (1.f / 512.f);
            const v4f d0 = y0 - mu, d1 = y1 - mu;
            float q = (d0[0] * d0[0] + d0[1] * d0[1]) + (d0[2] * d0[2] + d0[3] * d0[3]) + (d1[0] * d1[0] + d1[1] * d1[1]) + (d1[2] * d1[2] + d1[3] * d1[3]);
            const float rstd = rsqrtf(wave_sum(q) * (1.f / 512.f) + LN_EPS);
            const v4f g0 = *(const v4f*)(cln_g + lane * 8), g1 = *(const v4f*)(cln_g + lane * 8 + 4), b0 = *(const v4f*)(cln_b + lane * 8), b1 = *(const v4f*)(cln_b + lane * 8 + 4);
            float yn[8];
#pragma unroll
            for (int i = 0; i < 4; ++i) { yn[i] = d0[i] * rstd * g0[i] + b0[i]; yn[4 + i] = d1[i] * rstd * g1[i] + b1[i]; }
#pragma unroll
            for (int i = 0; i < 8; ++i) yn[i] = yn[i] * __builtin_amdgcn_rcpf(1.f + __expf(-yn[i]));
            const v4f p0 = *(const LAS v4f*)(pdl + o * 512 + lane * 8), p1 = *(const LAS v4f*)(pdl + o * 512 + lane * 8 + 4);
            float mx = fmaxf(fmaxf(fmaxf(fabsf(p0[0]), fabsf(p0[1])), fmaxf(fabsf(p0[2]), fabsf(p0[3]))), fmaxf(fmaxf(fabsf(p1[0]), fabsf(p1[1])), fmaxf(fabsf(p1[2]), fabsf(p1[3]))));
#pragma unroll
            for (int i = 0; i < 8; ++i) mx = fmaxf(mx, fabsf(yn[i]));
            mx = fmaxf(wave_max(mx), 1e-30f);
            const float inv = 127.f / mx;
            if (lane == 0) SA[r0 + o] = mx * (1.f / 127.f);
            v2u op, oy; op.x = q8pack4(p0[0], p0[1], p0[2], p0[3], inv); op.y = q8pack4(p1[0], p1[1], p1[2], p1[3], inv);
            oy.x = q8pack4(yn[0], yn[1], yn[2], yn[3], inv); oy.y = q8pack4(yn[4], yn[5], yn[6], yn[7], inv);
            *(v2u*)(MIX8 + (size_t)(r0 + o) * 1024 + lane * 8) = op; *(v2u*)(MIX8 + (size_t)(r0 + o) * 1024 + 512 + lane * 8) = oy; }
    }
}
struct LnRow { v4f x[4]; v4u y[2]; };
template <class TX>
__device__ __forceinline__ void ln1_load(LnRow& R, const TX* xl, const TX* xc, const bf16_t* Y, int r, int lane) {
    const TX* xr = r < ML ? xl + (size_t)r * D : xc + (size_t)(r - ML) * D;
#pragma unroll
    for (int i = 0; i < 2; ++i) { const int e0 = i * 512 + lane * 8; ld8(xr + e0, R.x[2 * i], R.x[2 * i + 1]); R.y[i] = *(const v4u*)(Y + (size_t)r * D + e0); }
}
template <class TX, class TO>
__device__ __forceinline__ void ph_ln1(const TX* xl, const TX* xc, const bf16_t* Y, const float* modl, int gate_off, const float* lng, const float* lnb,
                                       TO* XO, bf16_t* HAo, signed char* H8, float* HSC, int sh_off, int sc_off, int nrows, int lane, int wave, int vcu, int G, signed char* HA8o = nullptr, float* SAo = nullptr) {
    const int per = nrows / G, r0 = vcu * per;
    v4f ga[4], ba[4], mg[4], msc[4], msh[4];
#pragma unroll
    for (int i = 0; i < 2; ++i) { const int e0 = i * 512 + lane * 8; ga[2 * i] = *(const v4f*)(lng + e0); ga[2 * i + 1] = *(const v4f*)(lng + e0 + 4); ba[2 * i] = *(const v4f*)(lnb + e0); ba[2 * i + 1] = *(const v4f*)(lnb + e0 + 4); }
    int cur_mod = -1;
    LnRow A, B;
    if (wave < per) ln1_load(A, xl, xc, Y, r0 + wave, lane);
    for (int t = wave; t < per; t += 8) {
        const int r = r0 + t;
        if (t + 8 < per) ln1_load(B, xl, xc, Y, r + 8, lane);
        const int mr = row_mod(r);
        if (mr != cur_mod) { cur_mod = mr; const float* m = modl + mr * 6144;
#pragma unroll
            for (int i = 0; i < 2; ++i) { const int e0 = i * 512 + lane * 8;
                mg[2 * i] = *(const v4f*)(m + gate_off + e0); mg[2 * i + 1] = *(const v4f*)(m + gate_off + e0 + 4);
                msc[2 * i] = *(const v4f*)(m + sc_off + e0); msc[2 * i + 1] = *(const v4f*)(m + sc_off + e0 + 4);
                msh[2 * i] = *(const v4f*)(m + sh_off + e0); msh[2 * i + 1] = *(const v4f*)(m + sh_off + e0 + 4); } }
        float v[16], hq[16]; float s = 0.f;
#pragma unroll
        for (int i = 0; i < 2; ++i) { const v4u yy = A.y[i];
            const float yf[8] = {bflo(yy.x), bfhi(yy.x), bflo(yy.y), bfhi(yy.y), bflo(yy.z), bfhi(yy.z), bflo(yy.w), bfhi(yy.w)};
#pragma unroll
            for (int c = 0; c < 4; ++c) { v[i * 8 + c] = DN_ALPHA * A.x[2 * i][c] + mg[2 * i][c] * yf[c]; v[i * 8 + 4 + c] = DN_ALPHA * A.x[2 * i + 1][c] + mg[2 * i + 1][c] * yf[4 + c]; } }
#pragma unroll
        for (int c = 0; c < 16; ++c) s += v[c];
        const float mu = wave_sum(s) * (1.f / 1024.f);
        float qq = 0.f;
#pragma unroll
        for (int c = 0; c < 16; ++c) { v[c] -= mu; qq += v[c] * v[c]; }
        const float rstd = rsqrtf(wave_sum(qq) * (1.f / 1024.f) + LN_EPS);
#pragma unroll
        for (int i = 0; i < 2; ++i) { const int e0 = i * 512 + lane * 8;
            v4f o0, o1;
#pragma unroll
            for (int c = 0; c < 4; ++c) { o0[c] = v[i * 8 + c] * rstd * ga[2 * i][c] + ba[2 * i][c]; o1[c] = v[i * 8 + 4 + c] * rstd * ga[2 * i + 1][c] + ba[2 * i + 1][c]; }
            st8(XO + (size_t)r * 1024 + e0, o0, o1);
            const v4f y0 = o0 * (msc[2 * i] + 1.f) + msh[2 * i], y1 = o1 * (msc[2 * i + 1] + 1.f) + msh[2 * i + 1];
            if (!HA8o) st8(HAo + (size_t)r * 1024 + e0, y0, y1);
#pragma unroll
            for (int c = 0; c < 4; ++c) { hq[i * 8 + c] = y0[c]; hq[i * 8 + 4 + c] = y1[c]; } }
        float mx = 0.f;
#pragma unroll
        for (int c = 0; c < 16; ++c) mx = fmaxf(mx, fabsf(hq[c]));
        mx = fmaxf(wave_max(mx), 1e-30f);
        const float inv = 127.f / mx;
        int isum = 0;
#pragma unroll
        for (int i = 0; i < 2; ++i) { unsigned wh = 0u, wl = 0u; v2u wb = {0u, 0u};
#pragma unroll
            for (int c = 0; c < 8; ++c) { int qv = __float2int_rn(hq[i * 8 + c] * inv); qv = qv > 127 ? 127 : (qv < -127 ? -127 : qv); isum += qv;
                wb[c >> 2] |= (unsigned)(qv & 255) << (8 * (c & 3));
                const unsigned u = (unsigned)(qv + 128); const unsigned nh = ((u >> 4) - 8u) & 15u, nl = ((u & 15u) - 8u) & 15u;
                const int sh = (c & 3) * 8 + (c >> 2) * 4;
                wh |= nh << sh; wl |= nl << sh; }
            *(unsigned*)(H8 + (size_t)r * 1024 + (i * 64 + lane) * 4) = wh;
            if (HA8o) *(v2u*)(HA8o + (size_t)r * 1024 + i * 512 + lane * 8) = wb;
            *(unsigned*)(H8 + (size_t)r * 1024 + 512 + (i * 64 + lane) * 4) = wl; }
        const float hsum = wave_sum((float)isum), hsc = mx * (1.f / 127.f);
        if (lane == 0) { HSC[2 * r] = hsc; HSC[2 * r + 1] = 0.5f * hsum; if (SAo) SAo[r] = hsc; }
        A = B;
    }
}

namespace ml {
constexpr int LP = 272;
constexpr float KS = 0.08838834764831845f;
__device__ __forceinline__ int chunk_row0(int b, int c) { return c < 2 ? ML + b * CTX + c * 128 : b * SEQ + (c - 2) * 128; }
__device__ __forceinline__ float logsig(float x) { return fminf(x, 0.f) - log1pf(__expf(-fabsf(x))); }
__device__ __forceinline__ void load_T(const bf16_t* src  , LAS unsigned char* dst, int tid) {
    const int j0 = tid & 63, part = tid >> 6;
#pragma unroll
    for (int jj = 0; jj < 2; ++jj)
#pragma unroll
        for (int cc = 0; cc < 2; ++cc) { const int j = j0 + 64 * jj, ch = part * 2 + cc;
            const v4u d = *(const v4u*)(src + (size_t)j * ZZP + ch * 8);
#pragma unroll
            for (int e = 0; e < 4; ++e) { *(LAS bf16_t*)(dst + (ch * 8 + 2 * e) * LP + j * 2) = (bf16_t)(d[e] & 0xffffu); *(LAS bf16_t*)(dst + (ch * 8 + 2 * e + 1) * LP + j * 2) = (bf16_t)(d[e] >> 16); } }
}
__device__ __forceinline__ void load_R(const bf16_t* src, int ld, LAS unsigned char* dst, int tid) {
#pragma unroll
    for (int it = 0; it < 4; ++it) { const int i = tid + it * NTHR, r = i >> 4, ch = i & 15; *(LAS v4u*)(dst + r * LP + ch * 16) = *(const v4u*)(src + (size_t)r * ld + ch * 8); }
}
__device__ __forceinline__ void gate_scan(const float* GT, int row0, int h, int dir, const float* gate_b, int lane, LAS float* bvec, LAS float* avec, LAS float* Avec, float& Btot, float& Alast) {
    const float bi = gate_b[(dir * 2) * 4 + h], bfg = gate_b[(dir * 2 + 1) * 4 + h];
    const int p0 = dir ? 127 - 2 * lane : 2 * lane, p1 = dir ? 126 - 2 * lane : 2 * lane + 1;
    const float* z0 = GT + (size_t)(row0 + p0) * 16 + h; const float* z1 = GT + (size_t)(row0 + p1) * 16 + h;
    const float ig0 = z0[(dir * 2) * 4] + bi, ig1 = z1[(dir * 2) * 4] + bi;
    const float l0 = logsig(z0[(dir * 2 + 1) * 4] + bfg), l1 = logsig(z1[(dir * 2 + 1) * 4] + bfg);
    float inc = l0 + l1;
#pragma unroll
    for (int d = 1; d < 64; d <<= 1) { const float t = __shfl_up(inc, d); if (lane >= d) inc += t; }
    const float b1 = inc, b0 = inc - l1;
    const float a0 = ig0 - b0, a1 = ig1 - b1;
    float mx = fmaxf(a0, a1);
#pragma unroll
    for (int d = 1; d < 64; d <<= 1) { const float t = __shfl_up(mx, d); if (lane >= d) mx = fmaxf(mx, t); }
    float ex = __shfl_up(mx, 1); if (lane == 0) ex = -3.0e38f;
    const float A0 = fmaxf(ex, a0), A1 = mx;
    bvec[p0] = b0; bvec[p1] = b1; avec[p0] = a0; avec[p1] = a1; Avec[p0] = A0; Avec[p1] = A1;
    Btot = __shfl(b1, 63); Alast = __shfl(A1, 63);
}
}

__device__ __forceinline__ void ph_mla(const bf16_t* ZZ, const float* GT, const float* gate_b, bf16_t* DCT, float* DN, float* STAT, LAS unsigned char* lds, int tid, int lane, int wave, int vcu, int G) {
    LAS unsigned char* KT = lds; LAS unsigned char* VT = lds + 128 * ml::LP;
    LAS float* vec = (LAS float*)(lds + 272 * ml::LP);
    for (int i = tid; i < 16 * ml::LP / 4; i += NTHR) ((LAS unsigned*)(VT + 128 * ml::LP))[i] = (i < ml::LP / 4) ? 0x3F803F80u : 0u;
    const int n = lane & 15, q4 = lane >> 4;
    for (int unit = vcu; unit < NB * 4 * 66; unit += G) {
        const int c = unit % 66, h = (unit / 66) & 3, b = unit / (66 * 4);
        const int row0 = ml::chunk_row0(b, c);
        __syncthreads();
        ml::load_T(ZZ + (size_t)row0 * ZZP + 512 + h * 128, KT, tid);
        ml::load_T(ZZ + (size_t)row0 * ZZP + 1024 + h * 128, VT, tid);
        if (wave < 2) { const int dir = wave; LAS float* v = vec + dir * 512; float Bt, Al;
            ml::gate_scan(GT, row0, h, dir, gate_b, lane, v, v + 128, v + 256, Bt, Al);
            v[384 + 2 * lane] = __expf(v[128 + 2 * lane] - Al) * ml::KS; v[385 + 2 * lane] = __expf(v[129 + 2 * lane] - Al) * ml::KS;
            const int chain = (b * 4 + h) * 2 + dir; if (lane == 0) { STAT[(chain * 66 + c) * 2] = Bt; STAT[(chain * 66 + c) * 2 + 1] = Al; } }
        __syncthreads();
#pragma unroll
        for (int dir = 0; dir < 2; ++dir) {
            const LAS float* wk = vec + dir * 512 + 384;
            s16x8 bk[4];
#pragma unroll
            for (int ks = 0; ks < 4; ++ks) { const v4u d = *(const LAS v4u*)(KT + (wave * 16 + n) * ml::LP + ks * 64 + q4 * 16);
                const v4f w0 = *(const LAS v4f*)(wk + ks * 32 + q4 * 8), w1 = *(const LAS v4f*)(wk + ks * 32 + q4 * 8 + 4);
                v4u o; o.x = pk2(bflo(d.x) * w0[0], bfhi(d.x) * w0[1]); o.y = pk2(bflo(d.y) * w0[2], bfhi(d.y) * w0[3]); o.z = pk2(bflo(d.z) * w1[0], bfhi(d.z) * w1[1]); o.w = pk2(bflo(d.w) * w1[2], bfhi(d.w) * w1[3]);
                bk[ks] = __builtin_bit_cast(s16x8, o); }
            const int chain = (b * 4 + h) * 2 + dir;
            bf16_t* dct = DCT + (size_t)(chain * 66 + c) * 16384;
#pragma unroll
            for (int t = 0; t < 9; ++t) {
                pg8::f32x4 acc = {0.f, 0.f, 0.f, 0.f};
#pragma unroll
                for (int ks = 0; ks < 4; ++ks) { const s16x8 av = *(const LAS s16x8*)(VT + (t * 16 + n) * ml::LP + ks * 64 + q4 * 16); acc = __builtin_amdgcn_mfma_f32_16x16x32_bf16(av, bk[ks], acc, 0, 0, 0); }
                if (t < 8) {
#pragma unroll
                    for (int r = 0; r < 4; ++r) dct[(size_t)(t * 16 + q4 * 4 + r) * 128 + wave * 16 + n] = f2bf(acc[r]);
                } else if (q4 == 0) DN[(size_t)(chain * 66 + c) * 128 + wave * 16 + n] = acc[0];
            }
        }
    }
}

__device__ __forceinline__ void ph_mls(const bf16_t* DCT, const float* DN, const float* STAT, bf16_t* CTS, float* NS, float* MPREV, int gtid, int NGT) {
    for (int item = gtid; item < 32 * 2048 + 32 * 16; item += NGT) {
        const bool isn = item >= 32 * 2048;
        const int chain = isn ? (item - 32 * 2048) >> 4 : item >> 11, off = isn ? ((item - 32 * 2048) & 15) * 8 : (item & 2047) * 8, dir = chain & 1;
        float acc[8];
#pragma unroll
        for (int e = 0; e < 8; ++e) acc[e] = 0.f;
        float m = 0.f;
        for (int s = 0; s < 66; ++s) {
            const int c = dir ? (s < 2 ? 1 - s : 67 - s) : s;
            if (c >= 2) {
                const size_t ci = (size_t)chain * 64 + (c - 2);
                if (isn) { *(v4f*)(NS + ci * 128 + off) = (v4f){acc[0], acc[1], acc[2], acc[3]}; *(v4f*)(NS + ci * 128 + off + 4) = (v4f){acc[4], acc[5], acc[6], acc[7]}; if (off == 0) MPREV[ci] = m; }
                else { v4u o; o.x = pk2(acc[0], acc[1]); o.y = pk2(acc[2], acc[3]); o.z = pk2(acc[4], acc[5]); o.w = pk2(acc[6], acc[7]); *(v4u*)(CTS + ci * 16384 + off) = o; }
            }
            const size_t di = (size_t)chain * 66 + c;
            const float Bt = STAT[di * 2], Al = STAT[di * 2 + 1];
            const float M = fmaxf(m, Al), decay = __expf(m - M), scale = __expf(Al - M);
            float d[8];
            if (isn) { const v4f x0 = *(const v4f*)(DN + di * 128 + off), x1 = *(const v4f*)(DN + di * 128 + off + 4);
#pragma unroll
                for (int e = 0; e < 4; ++e) { d[e] = x0[e]; d[4 + e] = x1[e]; } }
            else { const v4u x = *(const v4u*)(DCT + di * 16384 + off);
#pragma unroll
                for (int e = 0; e < 4; ++e) { d[2 * e] = bflo(x[e]); d[2 * e + 1] = bfhi(x[e]); } }
#pragma unroll
            for (int e = 0; e < 8; ++e) acc[e] = decay * acc[e] + scale * d[e];
            m = Bt + M;
        }
    }
}

__device__ __forceinline__ void ph_mlo(const bf16_t* ZZ, const float* GT, const float* gate_b, const float* norm_g, const bf16_t* CTS, const float* NS, const float* MPREV, bf16_t* MIX,
                                       LAS unsigned char* lds, int tid, int lane, int wave, int vcu, int G) {
    LAS unsigned char* QL = lds; LAS unsigned char* KL = lds + 128 * ml::LP; LAS unsigned char* VT = lds + 256 * ml::LP; LAS unsigned char* CT = lds + 400 * ml::LP;
    LAS float* vec0 = (LAS float*)(lds + 544 * ml::LP);
    for (int i = tid; i < 16 * ml::LP / 4; i += NTHR) { ((LAS unsigned*)(VT + 128 * ml::LP))[i] = (i < ml::LP / 4) ? 0x3F803F80u : 0u; ((LAS unsigned*)(CT + 128 * ml::LP))[i] = 0u; }
    const int n = lane & 15, q4 = lane >> 4;
    for (int unit = vcu; unit < NB * 4 * 64; unit += G) {
        const int cl = unit & 63, h = (unit >> 6) & 3, b = unit >> 8;
        const int row0 = b * SEQ + cl * 128;
        __syncthreads();
        ml::load_R(ZZ + (size_t)row0 * ZZP + h * 128, ZZP, QL, tid);
        ml::load_R(ZZ + (size_t)row0 * ZZP + 512 + h * 128, ZZP, KL, tid);
        ml::load_T(ZZ + (size_t)row0 * ZZP + 1024 + h * 128, VT, tid);
        if (wave < 2) { const int dir = wave; LAS float* v = vec0 + dir * 768; float Bt, Al;
            ml::gate_scan(GT, row0, h, dir, gate_b, lane, v, v + 128, v + 256, Bt, Al);
            const float mp = MPREV[(size_t)((b * 4 + h) * 2 + dir) * 64 + cl];
#pragma unroll
            for (int e = 0; e < 2; ++e) { const int p = 2 * lane + e; const float M = fmaxf(mp, v[256 + p]); v[384 + p] = M; v[512 + p] = __expf(mp - M); v[640 + p] = __expf(-v[p] - M); } }
        pg8::f32x4 hs[8];
#pragma unroll
        for (int t = 0; t < 8; ++t) hs[t] = (pg8::f32x4){0.f, 0.f, 0.f, 0.f};
        float ngv[8];
#pragma unroll
        for (int t = 0; t < 8; ++t) ngv[t] = norm_g[h * 128 + t * 16 + n];
        bf16_t omv[4][8];
#pragma unroll
        for (int r = 0; r < 4; ++r)
#pragma unroll
            for (int t = 0; t < 8; ++t) omv[r][t] = ZZ[(size_t)(row0 + wave * 16 + q4 * 4 + r) * ZZP + 1536 + h * 128 + t * 16 + n];
#pragma unroll
        for (int dir = 0; dir < 2; ++dir) {
            const int chain = (b * 4 + h) * 2 + dir; const size_t ci = (size_t)chain * 64 + cl;
            if (dir) __syncthreads();
            ml::load_R(CTS + ci * 16384, 128, CT, tid);
            if (tid < 128) *(LAS bf16_t*)(CT + 128 * ml::LP + tid * 2) = f2bf(NS[ci * 128 + tid]);
            __syncthreads();
            const LAS float* vec = vec0 + dir * 768;
            s16x8 qf[4];
#pragma unroll
            for (int ks = 0; ks < 4; ++ks) qf[ks] = *(const LAS s16x8*)(QL + (wave * 16 + n) * ml::LP + ks * 64 + q4 * 16);
            const int i_row = wave * 16 + n; const float Mi = vec[384 + i_row];
            s16x8 pf[4];
#pragma unroll
            for (int T2 = 0; T2 < 4; ++T2) { unsigned pk[4];
#pragma unroll
                for (int hh = 0; hh < 2; ++hh) { const int T = T2 * 2 + hh;
                    pg8::f32x4 acc = {0.f, 0.f, 0.f, 0.f};
#pragma unroll
                    for (int ks = 0; ks < 4; ++ks) { const s16x8 kf = *(const LAS s16x8*)(KL + (T * 16 + n) * ml::LP + ks * 64 + q4 * 16); acc = __builtin_amdgcn_mfma_f32_16x16x32_bf16(kf, qf[ks], acc, 0, 0, 0); }
                    const v4f aj = *(const LAS v4f*)(vec + 128 + T * 16 + q4 * 4);
                    float pv[4];
#pragma unroll
                    for (int r = 0; r < 4; ++r) { const int j = T * 16 + q4 * 4 + r; const bool ok = dir ? (j >= i_row) : (j <= i_row); pv[r] = ok ? acc[r] * ml::KS * __expf(aj[r] - Mi) : 0.f; }
                    pk[hh * 2] = pk2(pv[0], pv[1]); pk[hh * 2 + 1] = pk2(pv[2], pv[3]); }
                pf[T2] = __builtin_bit_cast(s16x8, (v4u){pk[0], pk[1], pk[2], pk[3]}); }
            const v4f wi = *(const LAS v4f*)(vec + 512 + wave * 16 + q4 * 4), bd = *(const LAS v4f*)(vec + 640 + wave * 16 + q4 * 4);
            pg8::f32x4 o[9];
#pragma unroll
            for (int t = 0; t < 9; ++t) {
                pg8::f32x4 acc = {0.f, 0.f, 0.f, 0.f};
#pragma unroll
                for (int ks = 0; ks < 4; ++ks) { const s16x8 cf = *(const LAS s16x8*)(CT + (t * 16 + n) * ml::LP + ks * 64 + q4 * 16); acc = __builtin_amdgcn_mfma_f32_16x16x32_bf16(qf[ks], cf, acc, 0, 0, 0); }
                acc = acc * wi;
#pragma unroll
                for (int T2 = 0; T2 < 4; ++T2) { const v2u lo = *(const LAS v2u*)(VT + (t * 16 + n) * ml::LP + T2 * 64 + q4 * 8), hi = *(const LAS v2u*)(VT + (t * 16 + n) * ml::LP + T2 * 64 + 32 + q4 * 8);
                    const s16x8 vf = __builtin_bit_cast(s16x8, (v4u){lo.x, lo.y, hi.x, hi.y});
                    acc = __builtin_amdgcn_mfma_f32_16x16x32_bf16(pf[T2], vf, acc, 0, 0, 0); }
                o[t] = acc;
            }
#pragma unroll
            for (int r = 0; r < 4; ++r) { const float den = __shfl(o[8][r], lane & 48); const float rd = 1.f / fmaxf(fabsf(den), bd[r]);
#pragma unroll
                for (int t = 0; t < 8; ++t) hs[t][r] += o[t][r] * rd; }
        }
#pragma unroll
        for (int r = 0; r < 4; ++r) {
            float s = 0.f;
#pragma unroll
            for (int t = 0; t < 8; ++t) s += hs[t][r];
            s += __shfl_xor(s, 1); s += __shfl_xor(s, 2); s += __shfl_xor(s, 4); s += __shfl_xor(s, 8);
            const float mu = s * (1.f / 128.f); float qv = 0.f;
#pragma unroll
            for (int t = 0; t < 8; ++t) { const float d = hs[t][r] - mu; qv += d * d; }
            qv += __shfl_xor(qv, 1); qv += __shfl_xor(qv, 2); qv += __shfl_xor(qv, 4); qv += __shfl_xor(qv, 8);
            const float rstd = rsqrtf(qv * (1.f / 128.f) + LN_EPS);
            const int row = row0 + wave * 16 + q4 * 4 + r;
#pragma unroll
            for (int t = 0; t < 8; ++t) { const int dv = t * 16 + n; const float om = bf2f(omv[r][t]);
                MIX[(size_t)row * 1024 + h * 128 + dv] = f2bf((hs[t][r] - mu) * rstd * ngv[t] / (1.f + __expf(-om))); }
        }
    }
}


constexpr int N_PHASES = 18;
constexpr int CW_BAR = 1024;
constexpr int MISC_OFF = LDS_BYTES - 64;

struct Args { const float* in[26]; float* out; unsigned char* ws; int ph_lo, ph_hi, pad0, pad1; };

__global__ void __launch_bounds__(NTHR, 2) mk(Args a) {
    extern __shared__ __attribute__((aligned(16))) unsigned char lds_raw[];
    LAS unsigned char* lds = (LAS unsigned char*)lds_raw;
    const int tid = threadIdx.x, lane = tid & 63, wave = __builtin_amdgcn_readfirstlane(tid >> 6);
    const int G = gridDim.x, bx = blockIdx.x;
    const int vcu = (G % 8 == 0) ? (bx % 8) * (G / 8) + bx / 8 : bx;
    const int gw = vcu * NWAVES + wave, NGW = G * NWAVES;
    unsigned char* ws = a.ws;
    const float* mod = (const float*)(ws + WS_MOD);
    bf16_t* XS = (bf16_t*)(ws + WS_XS);   bf16_t* HA = (bf16_t*)(ws + WS_HA); signed char* HA8 = (signed char*)(ws + WS_HA); float* SA = (float*)(ws + WS_SA); const unsigned* CMX = (const unsigned*)(ws + WS_CTL) + CW_CMAX; bf16_t* ZB = (bf16_t*)(ws + WS_ZB);
    bf16_t* MIX = (bf16_t*)a.out;
    unsigned* IDXG = (unsigned*)(ws + WS_IDXG);
    const unsigned char* UQ = ws + WS_TAB; const unsigned char* VQ = ws + WS_TAB + TAB_VQ; const float* SU = (const float*)(ws + WS_SU);
    signed char* H8 = (signed char*)(ws + WS_ZB + 133 * MiB); float* HSC = (float*)(ws + WS_ZB + 170 * MiB); bf16_t* FB = (bf16_t*)(ws + WS_ZB); float* GT = (float*)((unsigned char*)a.out + 116 * MiB);
    bf16_t* QA = (bf16_t*)((unsigned char*)a.out + 66 * MiB); bf16_t* KA = (bf16_t*)((unsigned char*)a.out + 98 * MiB); bf16_t* VA = (bf16_t*)((unsigned char*)a.out + 107 * MiB);
    bf16_t* DCT = HA; bf16_t* CTS = (bf16_t*)(ws + WS_TAB);
    float* DN = (float*)(ws + WS_IDXG); float* STAT = (float*)(ws + WS_IDXG + 2 * MiB); float* NS = (float*)(ws + WS_IDXG + 3 * MiB); float* MPREV = (float*)(ws + WS_IDXG + 5 * MiB);

    const int lo = a.ph_lo, hi = a.ph_hi;
    const bool multi = (hi - lo) > 1;
    XcdBarrier bar; bar.bar = (unsigned*)(ws + WS_CTL) + CW_BAR; bar.x = 0; bar.st = nullptr;
    if (multi) {
        if (tid < 16) ((LAS unsigned*)(lds + MISC_OFF))[tid] = 0u;
        __syncthreads();
        bar = xcd_barrier_post((unsigned*)(ws + WS_CTL) + CW_BAR, (volatile LAS unsigned*)(lds + MISC_OFF));
    }
#ifndef GEMM_ALIGN
#define GEMM_ALIGN true
#endif
#ifndef GEMM_SP2
#define GEMM_SP2 true
#endif
#define GEMM_PHASE(Aptr, Wptr, Mrows, Ncols, Optr, ldc_, nvalid_) do { \
        pg8::Gemm g{(Aptr), (const bf16_t*)(Wptr), (Mrows), (Ncols), 1024}; EpiStore E{(Optr), (ldc_), (nvalid_)}; \
        pg8::StaticOrder S; S.init((Mrows), (Ncols), G, bx); \
        pg8::gemm_phase<EpiStore, pg8::StaticOrder, GEMM_ALIGN, GEMM_SP2>(lds, g, S, E); } while (0)

#ifndef PROBE_MASK
#define PROBE_MASK 0
#endif
#define GEMM8_PHASE(A8ptr, Wptr, Mrows, Ncols, Optr, ldc_, cm_) do { \
        pg8::Gemm g{(const bf16_t*)(A8ptr), (const bf16_t*)(Wptr), (Mrows), (Ncols), 512}; EpiStoreI8 E{(Optr), (ldc_), (Ncols), SA, CMX + (cm_)}; \
        pg8::StaticOrder S; S.init((Mrows), (Ncols), G, bx); \
        pg8::gemm_phase<EpiStoreI8, pg8::StaticOrder, GEMM_ALIGN, GEMM_SP2, true>(lds, g, S, E); } while (0)
#define IN(k) (lo <= (k) && (k) < hi)
#define REP(k) for (int rep_ = 0; rep_ < (((PROBE_MASK >> (k)) & 1) ? 2 : 1); ++rep_)
#ifndef BAR_REP
#define BAR_REP 1
#endif
#define SEAM(k) do { if (IN(k) && IN((k) + 1)) { for (int br_ = 0; br_ < BAR_REP; ++br_) xcd_barrier(bar); } } while (0)
    if (IN(0)) REP(0) { ph_prologue(a.in, ws, lds, tid, lane, wave, gw, NGW); } SEAM(0);
    if (IN(1)) REP(1) { ph_moda(a.in[0], a.in[2], mod, 0, 1024, HA8, SA, MT, lane, wave, vcu, G);
                 ph_w8(a.in, ws, lds, lane, wave, gw, NGW);
                 ph_tables(a.in, ws, 0, gw, NGW, lane); } SEAM(1);
    if (IN(2)) REP(2) { GEMM8_PHASE(HA8, ws + WS_W_IN, MT, AB_IN, ZB, AB_IN, CM_WIN); } SEAM(2);
    if (IN(3)) REP(3) { ph_mixab(ZB, a.in[11], a.in[12], a.in[13], a.in[14], (signed char*)a.out, SA, lds, tid, lane, wave, vcu, G); } SEAM(3);
    if (IN(4)) REP(4) { GEMM8_PHASE(a.out, ws + WS_W_OUT8, MT, 1024, ZB, 1024, CM_WOUT); } SEAM(4);
    if (IN(5)) REP(5) { ph_ln1<float, bf16_t>(a.in[0], a.in[2], ZB, mod, 2048, a.in[6], a.in[7], XS, HA, H8, HSC, 3072, 4096, MT, lane, wave, vcu, G, HA8, SA); } SEAM(5);
    if (IN(6)) REP(6) { GEMM8_PHASE(HA8, ws + WS_WQ, MT, 2048, ZB, 2048, CM_WQ0); } SEAM(6);
    if (IN(7)) REP(7) { ph_route(ZB, a.in[23], IDXG, MT, lds, tid, lane, wave, vcu, G); }
    if (IN(7) && IN(8)) { asm volatile("s_waitcnt vmcnt(0)" ::: "memory"); __syncthreads(); }
    if (IN(8)) REP(8) { ph_gather<bf16_t>(XS, H8, HSC, IDXG, UQ, SU, VQ, FB, mod, 5120, a.in[6] + 1024, a.in[7] + 1024, XS, HA8, SA, mod + 5 * 6144, 0, 1024, a.in[16] + 2048, CMX + CM_GATE, GT, MT, lds, tid, lane, wave, vcu, G); } SEAM(8);
    if (IN(9)) REP(9) { GEMM8_PHASE(HA8, ws + WS_CD_IN, MT, ZZP, ZB, ZZP, CM_CD); } SEAM(9);
    if (IN(10)) REP(10) { REP(18) ph_mla(ZB, GT, a.in[17], DCT, DN, STAT, lds, tid, lane, wave, vcu, G);
                  REP(19) ph_attn_prep(ZB, a.in[19], a.in[20], QA, KA, VA, gw, NGW, lane); } SEAM(10);
    if (IN(11)) REP(11) { REP(20) ph_mls(DCT, DN, STAT, CTS, NS, MPREV, vcu * NTHR + tid, G * NTHR);
                  const attn_body::AttnTensors AT{(const attn_body::bf16*)QA, (const attn_body::bf16*)KA, (const attn_body::bf16*)VA, (attn_body::bf16*)(MIX + 512)};
                  const attn_body::StaticOrder S(G, bx);
                  attn_body::attn_phase<attn_body::StaticOrder>((char*)lds_raw, AT, S); } SEAM(11);
    if (IN(12)) REP(12) { ph_mlo(ZB, GT, a.in[17], a.in[18], CTS, NS, MPREV, MIX, lds, tid, lane, wave, vcu, G); } SEAM(12);
    if (IN(13)) REP(13) { GEMM_PHASE(MIX, ws + WS_CD_OUT, ML, 1024, ZB, 1024, 1024); } SEAM(13);
    if (IN(14)) REP(14) { REP(22) ph_tables(a.in, ws, 1, gw, NGW, lane);
                  ph_ln1<bf16_t, bf16_t>(XS, XS + (size_t)ML * D, ZB, mod + 5 * 6144, 2048, a.in[6] + 2048, a.in[7] + 2048, XS, HA, H8, HSC, 3072, 4096, ML, lane, wave, vcu, G, HA8, SA); } SEAM(14);
    if (IN(15)) REP(15) { GEMM8_PHASE(HA8, ws + WS_WQ + (size_t)4 * MiB, ML, 2048, ZB, 2048, CM_WQ1); } SEAM(15);
    if (IN(16)) REP(16) { ph_route(ZB, a.in[23] + 2 * 128 * 128, IDXG, ML, lds, tid, lane, wave, vcu, G); }
    if (IN(16) && IN(17)) { asm volatile("s_waitcnt vmcnt(0)" ::: "memory"); __syncthreads(); }
    if (IN(17)) REP(17) { ph_gather<float>(XS, H8, HSC, IDXG, UQ, SU, VQ, FB, mod + 5 * 6144, 5120, a.in[6] + 3072, a.in[7] + 3072, a.out, nullptr, nullptr, nullptr, 0, 0, nullptr, nullptr, nullptr, ML, lds, tid, lane, wave, vcu, G); }
#undef IN
#undef SEAM
#undef GEMM_PHASE
#undef GEMM8_PHASE
}

extern "C" void kernel_launch(void* const* d_in, const int* in_sizes, int n_in, void* d_out, int out_size, void* d_ws, size_t ws_size, hipStream_t stream) {
    static int grid = 0;
    if (grid == 0) {
        if (n_in != 26 || out_size != ML * D || ws_size < WS_END) { fprintf(stderr, "kernel_launch: unexpected sizes n_in %d out %d ws %zu\n", n_in, out_size, ws_size); grid = -1; return; }
        int dev = 0, cus = 0, per_cu = 0;
        (void)hipGetDevice(&dev); (void)hipDeviceGetAttribute(&cus, hipDeviceAttributeMultiprocessorCount, dev);
        if (hipFuncSetAttribute((const void*)mk, hipFuncAttributeMaxDynamicSharedMemorySize, LDS_BYTES) != hipSuccess) { fprintf(stderr, "kernel_launch: hipFuncSetAttribute failed\n"); grid = -1; return; }
        (void)hipOccupancyMaxActiveBlocksPerMultiprocessor(&per_cu, (const void*)mk, NTHR, LDS_BYTES);
        (void)hipGetLastError();
        if (cus != 256) { fprintf(stderr, "kernel_launch: built for a 256-CU device, found %d CUs; nothing launched\n", cus); grid = -1; return; }
        if (per_cu < 1) { fprintf(stderr, "kernel_launch: occupancy query says %d blocks per CU\n", per_cu); }
        grid = cus * (per_cu < 1 ? 1 : 1);
    }
    if (grid < 0) return;
    if (hipMemsetAsync((char*)d_ws + WS_CTL, 0, CTL_ZERO_BYTES, stream) != hipSuccess) { fprintf(stderr, "kernel_launch: memset failed\n"); return; }
    Args a{}; for (int i = 0; i < 26; ++i) a.in[i] = (const float*)d_in[i]; a.out = (float*)d_out; a.ws = (unsigned char*)d_ws;
#if defined(MK_PER_PHASE)
    for (int p = 0; p < N_PHASES; ++p) { a.ph_lo = p; a.ph_hi = p + 1; hipLaunchKernelGGL(mk, dim3(grid), dim3(NTHR), LDS_BYTES, stream, a); }
#else
    a.ph_lo = 0; a.ph_hi = N_PHASES;
    void* args[] = {&a};
    hipError_t e = hipLaunchCooperativeKernel((const void*)mk, dim3(grid), dim3(NTHR), args, LDS_BYTES, stream);
    if (e != hipSuccess) fprintf(stderr, "kernel_launch: cooperative launch failed: %s (grid %d)\n", hipGetErrorString(e), grid);
#endif
}
```

```cpp
#include <hip/hip_runtime.h>
#include <stdint.h>
#include <stdio.h>

constexpr int D = 1024, NB = 4, SEQ = 8192, CTX = 256;
constexpr int ML = NB * SEQ;
constexpr int MC = NB * CTX;
constexpr int MT = ML + MC;
constexpr int TK = CTX + SEQ;
constexpr float DN_ALPHA = 1.4142135623730951f;
constexpr float LN_EPS = 1e-5f, RMS_EPS = 1e-6f;
constexpr int AB_IN = 1536, CD_IN = 2832;
constexpr int ZZP = 2816;

#define GAS __attribute__((address_space(1)))
#define LAS __attribute__((address_space(3)))
typedef unsigned short bf16_t;
__device__ __forceinline__ float bf2f(bf16_t v) { return __uint_as_float(((unsigned)v) << 16); }
__device__ __forceinline__ bf16_t f2bf(float f) { unsigned u = __float_as_uint(f); return (bf16_t)((u + 0x7fffu + ((u >> 16) & 1u)) >> 16); }

__device__ __forceinline__ int row_b(int r) { return r < ML ? (r >> 13) : ((r - ML) >> 8); }
__device__ __forceinline__ int row_t(int r) { return r < ML ? (r & 8191) : ((r - ML) & 255); }
__device__ __forceinline__ int row_T(int r) { return r < ML ? SEQ : CTX; }
__device__ __forceinline__ int row_mod(int r) { return r < ML ? (r >> 13) : 4; }


namespace pg8 {
#define PG8_LAS __attribute__((address_space(3)))
typedef unsigned short bf16_t;
typedef short bf16x8 __attribute__((ext_vector_type(8)));
typedef float f32x4 __attribute__((ext_vector_type(4)));
typedef int i32x4 __attribute__((ext_vector_type(4)));
template <bool I8> struct AccSel { typedef f32x4 T; };
template <> struct AccSel<true> { typedef i32x4 T; };
typedef unsigned u32x4 __attribute__((ext_vector_type(4)));
constexpr int BM = 256, BK = 64, HALF = 128, HTB = HALF * BK * 2  , STAGE_BYTES = 8 * HTB, NXCD = 8, WGM = 8;

__host__ __device__ __forceinline__ int lds_byte(int r, int c) { const int st = (r >> 4) * 2 + (c >> 5), rr = r & 15, cc = c & 31, ob = rr * 64 + cc * 2; return st * 1024 + (ob ^ (((ob >> 9) & 1) << 5)); }
__host__ __device__ __forceinline__ void stage_rc(int b, int& R, int& C) { const int st = b / 1024, sb = b % 1024, swz = sb ^ (((sb >> 9) & 1) << 5); R = (st >> 1) * 16 + swz / 64; C = (st & 1) * 32 + (swz % 64) / 2; }
__host__ __device__ __forceinline__ int perm32(int rho) { const int n = rho >> 4, i = rho & 15; return 8 * (i >> 2) + 4 * n + (i & 3); }

struct Unit { int pm, pn; };
struct Gemm { const bf16_t* A; const bf16_t* Bt; int M, N, K; };

struct StaticOrder {
    int nM, nN, nwg, G, c;
    __host__ __device__ void init(int M, int N, int G_, int c_) { nM = M / BM; nN = N / BM; nwg = nM * nN; G = G_; c = c_; }
    __host__ __device__ bool next(int i, Unit& u) const {
        const long L = (long)i * G + c; if (L >= nwg) return false;
        int wgid = (int)L; { const int q = nwg / NXCD, r = nwg % NXCD, xcd = wgid % NXCD, off = wgid / NXCD; wgid = (xcd < r ? xcd * (q + 1) : r * (q + 1) + (xcd - r) * q) + off; }
        const int nig = WGM * nN, gid = wgid / nig, fm = gid * WGM, gsz = (nM - fm) < WGM ? (nM - fm) : WGM;
        u.pm = fm + ((wgid % nig) % gsz); u.pn = (wgid % nig) / gsz; return true;
    }
    __device__ __forceinline__ void a_ready(const Unit&) const {}
    __device__ __forceinline__ void done(const Unit&) const {}
};
__device__ __forceinline__ unsigned cvt_pk_bf16(float lo, float hi) { unsigned r; asm volatile("v_cvt_pk_bf16_f32 %0, %1, %2" : "=v"(r) : "v"(lo), "v"(hi)); return r; }
typedef float f32x2 __attribute__((ext_vector_type(2)));
template <class Epi, class Sched, bool ALIGN_EPI = false, bool SP2 = false, bool I8 = false>
__device__ __forceinline__ void gemm_phase(PG8_LAS unsigned char* lds, const Gemm g, const Sched& S, const Epi& E) {
    const int tid = threadIdx.x, wid = __builtin_amdgcn_readfirstlane(tid >> 6), lane = tid & 63, wr = wid >> 2, wc = wid & 3, fr = lane & 15, fq = lane >> 4;
    const int K = g.K, nt = K / BK;
    unsigned voffA[2], voffB[2];
#pragma unroll
    for (int i = 0; i < 2; ++i) { int R, C; stage_rc(tid * 16 + i * 8192, R, C); const int Rb = Epi::PERM ? ((R & ~31) + perm32(R & 31)) : R;
        voffA[i] = (unsigned)(R * K + C) * 2u; voffB[i] = (unsigned)(Rb * K + C) * 2u; }
    const size_t kstep = (size_t)(BK * 2);
    const size_t hstep = (size_t)HALF * K * 2;
    const size_t tstep = 2 * hstep;
    const unsigned ldsw = (unsigned)wid * 1024u;
    const int aoff = lds_byte(wr * 64 + fr, fq * 8), boff = lds_byte(wc * 32 + fr, fq * 8);
#define PG8_SA(b, h) (((b) * 2 + (h)) * HTB)
#define PG8_SB(b, h) ((4 + (b) * 2 + (h)) * HTB)
#define PG8_STAGE(bufoff, gbase, voff) do { _Pragma("unroll") for (int _i = 0; _i < 2; ++_i) \
        __builtin_amdgcn_global_load_lds((const unsigned*)((const char*)(gbase) + (voff)[_i]), (PG8_LAS unsigned*)(lds + (bufoff) + ldsw + _i * 8192), 16, 0, 0); } while (0)
#define PG8_LDA(dst, b, h) do { _Pragma("unroll") for (int m = 0; m < 4; ++m) _Pragma("unroll") for (int k = 0; k < 2; ++k) dst[m][k] = *(const PG8_LAS bf16x8*)(lds + PG8_SA(b, h) + aoff + m * 2048 + k * 1024); } while (0)
#define PG8_LDB(dst, b, h) do { _Pragma("unroll") for (int n = 0; n < 2; ++n) _Pragma("unroll") for (int k = 0; k < 2; ++k) dst[n][k] = *(const PG8_LAS bf16x8*)(lds + PG8_SB(b, h) + boff + n * 2048 + k * 1024); } while (0)
#define PG8_MMA(ai, bj, At, Bt) do { __builtin_amdgcn_s_setprio(1); _Pragma("unroll") for (int m = 0; m < 4; ++m) _Pragma("unroll") for (int n = 0; n < 2; ++n) _Pragma("unroll") for (int k = 0; k < 2; ++k) \
        { if constexpr (I8) acc[ai][bj][m][n] = __builtin_amdgcn_mfma_i32_16x16x64_i8(__builtin_bit_cast(i32x4, Bt[n][k]), __builtin_bit_cast(i32x4, At[m][k]), acc[ai][bj][m][n], 0, 0, 0); \
          else acc[ai][bj][m][n] = __builtin_amdgcn_mfma_f32_16x16x32_bf16(Bt[n][k], At[m][k], acc[ai][bj][m][n], 0, 0, 0); } __builtin_amdgcn_s_setprio(0); } while (0)
#define PG8_WAIT_V(n) asm volatile("s_waitcnt vmcnt(" #n ")" ::: "memory")
#define PG8_WAIT_L(n) asm volatile("s_waitcnt lgkmcnt(" #n ")" ::: "memory")
#define PG8_BAR __builtin_amdgcn_s_barrier()
#define PG8_SCHED __builtin_amdgcn_sched_barrier(0)
    Unit cur, nxt; int ui = 0;
    if (!S.next(0, cur)) return;
    typedef typename AccSel<I8>::T AccT;
    AccT acc[2][2][4][2];
#pragma unroll
    for (int a = 0; a < 2; ++a)
#pragma unroll
        for (int b = 0; b < 2; ++b)
#pragma unroll
            for (int m = 0; m < 4; ++m)
#pragma unroll
                for (int n = 0; n < 2; ++n) acc[a][b][m][n] = AccT{};
    bf16x8 At[4][2], B0[2][2], B1[2][2];
    const char* cA = (const char*)g.A + (size_t)cur.pm * tstep; const char* cB = (const char*)g.Bt + (size_t)cur.pn * tstep;
    S.a_ready(cur);
    if constexpr (SP2) {
        PG8_STAGE(PG8_SB(0, 0), cB, voffB); PG8_STAGE(PG8_SB(0, 1), cB + hstep, voffB); PG8_STAGE(PG8_SA(0, 0), cA, voffA); PG8_STAGE(PG8_SA(0, 1), cA + hstep, voffA);
        if (wr == 1) PG8_BAR;
        PG8_WAIT_V(2); PG8_BAR;
        PG8_STAGE(PG8_SB(1, 0), cB + kstep, voffB); PG8_STAGE(PG8_SA(1, 0), cA + kstep, voffA); PG8_STAGE(PG8_SB(1, 1), cB + hstep + kstep, voffB);
        PG8_WAIT_V(6); PG8_BAR;
    } else {
        PG8_STAGE(PG8_SB(0, 0), cB, voffB); PG8_STAGE(PG8_SA(0, 0), cA, voffA); PG8_STAGE(PG8_SB(0, 1), cB + hstep, voffB); PG8_STAGE(PG8_SA(0, 1), cA + hstep, voffA);
        if (wr == 1) PG8_BAR;
        PG8_WAIT_V(4); PG8_BAR;
        PG8_STAGE(PG8_SB(1, 0), cB + kstep, voffB); PG8_STAGE(PG8_SA(1, 0), cA + kstep, voffA); PG8_STAGE(PG8_SB(1, 1), cB + hstep + kstep, voffB);
        PG8_WAIT_V(6); PG8_BAR;
    }
    for (;;) {
        const bool has_next = S.next(ui + 1, nxt);
        const char* nA = has_next ? (const char*)g.A + (size_t)nxt.pm * tstep : cA; const char* nB = has_next ? (const char*)g.Bt + (size_t)nxt.pn * tstep : cB;
        for (int t = 0; t < nt; t += 2) {
            const bool last = (t == nt - 2);
            const char* a1 = cA + (size_t)(t + 1) * kstep;
            const char* a2 = last ? nA : cA + (size_t)(t + 2) * kstep; const char* b2 = last ? nB : cB + (size_t)(t + 2) * kstep;
            const char* a3 = a2 + kstep; const char* b3 = b2 + kstep;
            if (last && has_next) S.a_ready(nxt);
            if constexpr (SP2) {
            PG8_LDB(B0, 0, 0); PG8_LDB(B1, 0, 1); PG8_SCHED; PG8_LDA(At, 0, 0); PG8_STAGE(PG8_SA(1, 1), a1 + hstep, voffA);
            PG8_WAIT_V(8); PG8_WAIT_L(0); PG8_BAR; PG8_MMA(0, 0, At, B0); PG8_MMA(0, 1, At, B1); PG8_BAR; PG8_SCHED;
            PG8_LDA(At, 0, 1); PG8_STAGE(PG8_SB(0, 0), b2, voffB); PG8_STAGE(PG8_SB(0, 1), b2 + hstep, voffB); PG8_STAGE(PG8_SA(0, 0), a2, voffA);
            PG8_WAIT_V(8); PG8_WAIT_L(0); PG8_BAR; PG8_MMA(1, 0, At, B0); PG8_MMA(1, 1, At, B1); PG8_BAR; PG8_SCHED;
            PG8_LDB(B0, 1, 0); PG8_LDB(B1, 1, 1); PG8_SCHED; PG8_LDA(At, 1, 0); PG8_STAGE(PG8_SA(0, 1), a2 + hstep, voffA);
            PG8_WAIT_V(8); PG8_WAIT_L(0); PG8_BAR; PG8_MMA(0, 0, At, B0); PG8_MMA(0, 1, At, B1); PG8_BAR; PG8_SCHED;
            PG8_LDA(At, 1, 1); PG8_STAGE(PG8_SB(1, 0), b3, voffB); PG8_STAGE(PG8_SB(1, 1), b3 + hstep, voffB); PG8_STAGE(PG8_SA(1, 0), a3, voffA);
            PG8_WAIT_V(8); PG8_WAIT_L(0); PG8_BAR; PG8_MMA(1, 0, At, B0); PG8_MMA(1, 1, At, B1); PG8_BAR; PG8_SCHED;
            } else {
            PG8_LDB(B0, 0, 0); PG8_SCHED; PG8_LDA(At, 0, 0); PG8_STAGE(PG8_SA(1, 1), a1 + hstep, voffA);
            PG8_WAIT_L(8); PG8_BAR; PG8_WAIT_L(0); PG8_MMA(0, 0, At, B0); PG8_BAR; PG8_SCHED;
            PG8_LDB(B1, 0, 1); PG8_STAGE(PG8_SB(0, 0), b2, voffB);
            PG8_BAR; PG8_WAIT_L(0); PG8_MMA(0, 1, At, B1); PG8_BAR;
            PG8_LDA(At, 0, 1); PG8_STAGE(PG8_SA(0, 0), a2, voffA);
            PG8_BAR; PG8_WAIT_L(0); PG8_MMA(1, 0, At, B0); PG8_BAR; PG8_SCHED;
            PG8_STAGE(PG8_SB(0, 1), b2 + hstep, voffB);
            PG8_WAIT_V(6); PG8_BAR; PG8_MMA(1, 1, At, B1); PG8_BAR;
            PG8_LDB(B0, 1, 0); PG8_SCHED; PG8_LDA(At, 1, 0); PG8_STAGE(PG8_SA(0, 1), a2 + hstep, voffA);
            PG8_WAIT_L(8); PG8_BAR; PG8_WAIT_L(0); PG8_MMA(0, 0, At, B0); PG8_BAR; PG8_SCHED;
            PG8_LDB(B1, 1, 1); PG8_STAGE(PG8_SB(1, 0), b3, voffB);
            PG8_BAR; PG8_WAIT_L(0); PG8_MMA(0, 1, At, B1); PG8_BAR;
            PG8_LDA(At, 1, 1); PG8_STAGE(PG8_SA(1, 0), a3, voffA);
            PG8_BAR; PG8_WAIT_L(0); PG8_MMA(1, 0, At, B0); PG8_BAR; PG8_SCHED;
            PG8_STAGE(PG8_SB(1, 1), b3 + hstep, voffB);
            PG8_WAIT_V(6); PG8_BAR; PG8_MMA(1, 1, At, B1); PG8_BAR;
            }
        }
        if constexpr (ALIGN_EPI) { if (wr == 0) PG8_BAR; }
        if constexpr (!Epi::AFTER_DRAIN) { E(acc, cur, wr, wc, fr, fq); S.done(cur); }
        if (!has_next) break;
#pragma unroll
        for (int a = 0; a < 2; ++a)
#pragma unroll
            for (int b = 0; b < 2; ++b)
#pragma unroll
                for (int m = 0; m < 4; ++m)
#pragma unroll
                    for (int n = 0; n < 2; ++n) acc[a][b][m][n] = AccT{};
        cur = nxt; cA = nA; cB = nB; ++ui;
        if constexpr (ALIGN_EPI) { if (wr == 1) PG8_BAR; }
    }
    PG8_WAIT_V(0);
    if constexpr (!ALIGN_EPI) { if (wr == 0) PG8_BAR; }
    PG8_BAR;
    if constexpr (Epi::AFTER_DRAIN) { E.fused(acc, cur, wr, wc, fr, fq, lds, wid, lane); S.done(cur); }
#undef PG8_SA
#undef PG8_SB
#undef PG8_STAGE
#undef PG8_LDA
#undef PG8_LDB
#undef PG8_MMA
#undef PG8_WAIT_V
#undef PG8_WAIT_L
#undef PG8_BAR
#undef PG8_SCHED
}
}

#include <hip/hip_bf16.h>
#include <cmath>
namespace attn_body {
using bf16=__hip_bfloat16;
using bf16x8=__attribute__((ext_vector_type(8)))short;
using s16x4=__attribute__((ext_vector_type(4)))short;
using f32x16=__attribute__((ext_vector_type(16)))float;
using u32x4=__attribute__((ext_vector_type(4)))unsigned;
constexpr int D=64, QP=512, KP=128, OP=1024, SEQ=8192, TKV=8448;
constexpr int NW=8,QBLK=32,QB=QBLK*NW,KVBLK=64,NQB=SEQ/QB;
constexpr int ATTN_UNIT_ROWS=QB;
__device__ __forceinline__ int crow(int r,int hi){return (r&3)+8*(r>>2)+4*hi;}
#define SBAR() __builtin_amdgcn_sched_barrier(0)
__device__ __forceinline__ void cmask(f32x16&p0,f32x16&p1,int jb,int qrel,int hi){
  const float NEG=-INFINITY; int kb=64*jb+4*hi;
  #pragma unroll
  for(int r=0;r<16;++r){int kv=kb+(r&3)+8*(r>>2); if(kv>qrel)p0[r]=NEG; if(kv+32>qrel)p1[r]=NEG;}
}

constexpr int NSLOT=3, SLOTB=8192;
constexpr int LDS_K=0, LDS_V=NSLOT*SLOTB, LDS_WS=2*NSLOT*SLOTB, LDS_OST=LDS_WS+NW*64*4, LDS_BYTES=LDS_OST+NW*4096;
constexpr float C2=0.125f*1.4426950408889634f;
__device__ __forceinline__ void glds16(const void*gsrc,unsigned lds_dst){unsigned keep;
  asm volatile("s_mov_b32 %0, m0\n\ts_mov_b32 m0, %2\n\ts_nop 0\n\tglobal_load_lds_dwordx4 %1, off\n\ts_mov_b32 m0, %0":"=&s"(keep):"v"(gsrc),"s"(lds_dst):"memory");}
__device__ __forceinline__ float max3f(float a,float b,float c){float r;asm("v_max3_f32 %0, %1, %2, %3":"=v"(r):"v"(a),"v"(b),"v"(c));return r;}
__device__ __forceinline__ float max2f(float a,float b){float r;asm("v_max_f32_e32 %0, %1, %2":"=v"(r):"v"(a),"v"(b));return r;}
__device__ __forceinline__ float fadd_s(float a,float b){float r;asm("v_add_f32_e32 %0, %1, %2":"=v"(r):"v"(a),"v"(b));return r;}
__device__ __forceinline__ float fsub_s(float a,float b){float r;asm("v_sub_f32_e32 %0, %1, %2":"=v"(r):"v"(a),"v"(b));return r;}
typedef float f32x2_t __attribute__((ext_vector_type(2))); typedef __bf16 bf16x2_t __attribute__((ext_vector_type(2)));
__device__ __forceinline__ unsigned cvtpk_s(float lo,float hi){f32x2_t v={lo,hi};bf16x2_t b=__builtin_convertvector(v,bf16x2_t);return __builtin_bit_cast(unsigned,b);}
#define WAIT_BAR(N) asm volatile("s_waitcnt vmcnt(" #N ") lgkmcnt(0)\n\ts_barrier":::"memory")

__device__ __forceinline__ void qkt(f32x16&p0,f32x16&p1,const char*Kslot,const bf16x8*qr,const f32x16&negm,int r32,int hi){
  const char*kb=Kslot+hi*1024+r32*16;
  #pragma unroll
  for(int d0=0;d0<4;++d0){
    const bf16x8 b0=*reinterpret_cast<const bf16x8*>(kb+d0*2048);
    const bf16x8 b1=*reinterpret_cast<const bf16x8*>(kb+d0*2048+512);
    if(d0==0){p0=__builtin_amdgcn_mfma_f32_32x32x16_bf16(b0,qr[0],negm,0,0,0);p1=__builtin_amdgcn_mfma_f32_32x32x16_bf16(b1,qr[0],negm,0,0,0);}
    else{p0=__builtin_amdgcn_mfma_f32_32x32x16_bf16(b0,qr[d0],p0,0,0,0);p1=__builtin_amdgcn_mfma_f32_32x32x16_bf16(b1,qr[d0],p1,0,0,0);}}
}
typedef __attribute__((address_space(3))) const char* lds_cptr;
typedef short v4i16_t __attribute__((ext_vector_type(4)));
__device__ __forceinline__ void kload8(bf16x8*kf,lds_cptr kp){
  kf[0]=*(const __attribute__((address_space(3))) bf16x8*)(kp);      kf[1]=*(const __attribute__((address_space(3))) bf16x8*)(kp+512);
  kf[2]=*(const __attribute__((address_space(3))) bf16x8*)(kp+2048); kf[3]=*(const __attribute__((address_space(3))) bf16x8*)(kp+2560);
  kf[4]=*(const __attribute__((address_space(3))) bf16x8*)(kp+4096); kf[5]=*(const __attribute__((address_space(3))) bf16x8*)(kp+4608);
  kf[6]=*(const __attribute__((address_space(3))) bf16x8*)(kp+6144); kf[7]=*(const __attribute__((address_space(3))) bf16x8*)(kp+6656);
}
__device__ __forceinline__ void kload2(bf16x8*kf,lds_cptr kp,int j){ kf[2*j]=*(const __attribute__((address_space(3))) bf16x8*)(kp+j*2048); kf[2*j+1]=*(const __attribute__((address_space(3))) bf16x8*)(kp+j*2048+512); }
__device__ __forceinline__ s16x4 vtr(lds_cptr p){ return __builtin_bit_cast(s16x4,__builtin_amdgcn_ds_read_tr16_b64_v4i16((__attribute__((address_space(3))) v4i16_t*)p)); }
__device__ __forceinline__ float rowmax(const f32x16&p0,const f32x16&p1){
  float a=max3f(p0[0],p0[1],p1[0]),b=max3f(p0[2],p0[3],p1[1]);a=max3f(a,p1[2],p1[3]);
  #pragma unroll
  for(int r=4;r<16;r+=4){a=max3f(a,p0[r],p0[r+1]);b=max3f(b,p0[r+2],p0[r+3]);a=max3f(a,p1[r],p1[r+1]);b=max3f(b,p1[r+2],p1[r+3]);}
  const float m=max2f(a,b);
  auto rr=__builtin_amdgcn_permlane32_swap(__float_as_uint(m),__float_as_uint(m),false,false);
  return max2f(__uint_as_float(rr[0]),__uint_as_float(rr[1]));
}
__device__ __forceinline__ void pv(f32x16*o,int vb,bf16x8 pa0,bf16x8 pa1,bf16x8 pa2,bf16x8 pa3){
  #pragma unroll
  for(int d0=0;d0<2;++d0){s16x4 lo[4],hi[4];
    #pragma unroll
    for(int ks=0;ks<4;++ks){
      asm volatile("ds_read_b64_tr_b16 %0,%1 offset:%c2":"=&v"(lo[ks]):"v"(vb),"i"(d0*4096+ks*1024):"memory");
      asm volatile("ds_read_b64_tr_b16 %0,%1 offset:%c2":"=&v"(hi[ks]):"v"(vb),"i"(d0*4096+ks*1024+512):"memory");}
    asm volatile("s_waitcnt lgkmcnt(0)":::"memory");SBAR();
    #define PK(k) (bf16x8){lo[k][0],lo[k][1],lo[k][2],lo[k][3],hi[k][0],hi[k][1],hi[k][2],hi[k][3]}
    o[d0]=__builtin_amdgcn_mfma_f32_32x32x16_bf16(pa0,PK(0),o[d0],0,0,0);
    o[d0]=__builtin_amdgcn_mfma_f32_32x32x16_bf16(pa1,PK(1),o[d0],0,0,0);
    o[d0]=__builtin_amdgcn_mfma_f32_32x32x16_bf16(pa2,PK(2),o[d0],0,0,0);
    o[d0]=__builtin_amdgcn_mfma_f32_32x32x16_bf16(pa3,PK(3),o[d0],0,0,0);
    #undef PK
  }
}

#ifndef ATTN_STORE16
#define ATTN_STORE16(p,v) (*(u32x4*)(p)=(v))
#endif
template<int THRL> __device__ __forceinline__ void attn_unit(int b,int h,int qb,const bf16*Q,const bf16*__restrict__ K,const bf16*__restrict__ V,bf16*O,char*shm){
  const int tid=threadIdx.x,lane=tid&63,r32=lane&31,hi=lane>>5; const int wid=__builtin_amdgcn_readfirstlane(tid>>6);
  const long rowbase=(long)b*SEQ, kvbase=(long)b*TKV; const int q0=qb*QB, kvh=h>>2;
  const bf16*Qw=Q+(rowbase+q0+wid*QBLK)*QP+h*D;
  const bf16*Kh=K+kvbase*KP+kvh*D,*Vh=V+kvbase*KP+kvh*D;
  const unsigned lds0=(unsigned)(uintptr_t)shm;
  float*wsf=(float*)(shm+LDS_WS)+wid*64;
  const bf16*ksrc=Kh+(long)lane*KP+wid*8;
  const bf16*vsrc=Vh+(long)(16*(wid&3)+(lane>>2))*KP+(wid>>2)*32+(lane&3)*8;
  const unsigned kdst=lds0+LDS_K+wid*1024, vdst=lds0+LDS_V+wid*1024;
  #define DMA_K(t,slot) glds16(ksrc+(long)(t)*KVBLK*KP,(unsigned)__builtin_amdgcn_readfirstlane(kdst+(slot)))
  #define DMA_V(t,slot) glds16(vsrc+(long)(t)*KVBLK*KP,(unsigned)__builtin_amdgcn_readfirstlane(vdst+(slot)))
  const int vb0=(int)(lds0+LDS_V)+((lane>>4)&1)*32+(lane&3)*8+(4*hi+((lane&15)>>2))*64;
  const char*Kbase=shm+LDS_K; bf16x8 kf[8];
  const lds_cptr shm3=(lds_cptr)shm; const lds_cptr kp0=shm3+LDS_K+hi*1024+r32*16; const lds_cptr vp0=shm3+LDS_V+((lane>>4)&1)*32+(lane&3)*8+(4*hi+((lane&15)>>2))*64;
  const int NT=TKV/KVBLK;
  DMA_K(0,0);DMA_V(0,0);DMA_K(1,SLOTB);
  bf16x8 qr[4];
  #pragma unroll
  for(int d0=0;d0<4;++d0)qr[d0]=*reinterpret_cast<const bf16x8*>(&Qw[(long)r32*QP+d0*16+hi*8]);
  float mhat=0.f,l_reg=0.f;f32x16 o[2];o[0]=f32x16{};o[1]=f32x16{};f32x16 negm=f32x16{};asm volatile("":"+v"(negm));
  const int qrel=wid*QBLK+r32;
  #define CMASK(P0,P1,t) do{}while(0)
  bool resc=false;
  #define START(P0,P1) do{ const float rm=rowmax(P0,P1); resc=false; \
    { const float dl=rm; mhat=fadd_s(mhat,dl); \
      _Pragma("unroll") for(int r=0;r<16;++r){P0[r]=fsub_s(P0[r],dl);P1[r]=fsub_s(P1[r],dl);} \
      _Pragma("unroll") for(int r=0;r<16;++r)negm[r]=-mhat; asm volatile("":"+v"(negm)); } \
    _Pragma("unroll") for(int r=0;r<16;++r)P0[r]=__builtin_amdgcn_exp2f(P0[r]); }while(0)
  #define RESC() do{ if(resc){ asm volatile("s_waitcnt lgkmcnt(0)":::"memory"); \
      _Pragma("unroll") for(int d_=0;d_<2;++d_) _Pragma("unroll") for(int r=0;r<16;++r)o[d_][r]*=wsf[crow(r,hi)]; } }while(0)
  f32x16 pA0,pA1,pB0,pB1;
  int sl_prev=0,sl_cur=0,sl_next=SLOTB;
  #define ROT() do{sl_prev=sl_cur;sl_cur=sl_next;sl_next=(sl_next==(NSLOT-1)*SLOTB)?0:sl_next+SLOTB;}while(0)
  DMA_K(2,2*SLOTB);
  WAIT_BAR(3);
  qkt(pA0,pA1,Kbase,qr,negm,r32,hi);asm volatile("s_nop 15\n\ts_nop 7":"+v"(pA0),"+v"(pA1));CMASK(pA0,pA1,0);
  START(pA0,pA1);
  _Pragma("unroll") for(int r=0;r<16;++r)pA1[r]=__builtin_amdgcn_exp2f(pA1[r]);
  WAIT_BAR(0);
  DMA_K(3,0);DMA_V(1,SLOTB);
  ROT();
  kload8(kf,kp0+sl_cur);
  WAIT_BAR(2);
  s16x4 vlo[8],vhi[8]; u32x4 pw0,pw1,pw2,pw3;
  #define PKW(P,B) cvtpk_s(P[B],P[B+1])
  #define PAF(k) __builtin_bit_cast(bf16x8,pw##k)
  #define VFR(i) (bf16x8){vlo[i][0],vlo[i][1],vlo[i][2],vlo[i][3],vhi[i][0],vhi[i][1],vhi[i][2],vhi[i][3]}
  #define PIN(x) asm volatile("":"+v"(x))
  #define MX3(a,b,c) __builtin_fmaxf(__builtin_fmaxf((a),(b)),(c))
  #define GAPA(MF,A0,A1,A2,A3,W0,W1,PW) do{ MF; sacc+=A0; sacc+=A1; sacc+=A2; sacc+=A3; PIN(sacc); W0; W1; PIN(PW); SBAR(); }while(0)
  #define EX(v) __builtin_amdgcn_exp2f(v)
  #define GAPB(MF,X,B) do{ MF; X[B]=EX(X[B]); X[B+1]=EX(X[B+1]); X[B+2]=EX(X[B+2]); X[B+3]=EX(X[B+3]); PIN(X); SBAR(); }while(0)
  #define VRD(i) do{ vlo[i]=vtr(vp_+(((i)>>2)*4096+((i)&3)*1024)); vhi[i]=vtr(vp_+(((i)>>2)*4096+((i)&3)*1024+512)); }while(0)
  #define KRD(G,j) do{ if(G){ kload2(kf,kp0+sl_next,j); SBAR(); } }while(0)
  #define STEP(C0,C1,P0,P1,t,GK,GV,GL) do{ SBAR(); \
    const lds_cptr vp_=vp0+sl_prev; \
    VRD(0); SBAR(); float sacc=(P0[0]+P0[1]); \
    GAPA(C0=__builtin_amdgcn_mfma_f32_32x32x16_bf16(kf[0],qr[0],negm,0,0,0), P0[2],P0[3],P0[4],P0[5],     pw0[0]=PKW(P0,0), pw0[1]=PKW(P0,2), pw0); \
    VRD(4); SBAR(); GAPA(C1=__builtin_amdgcn_mfma_f32_32x32x16_bf16(kf[1],qr[0],negm,0,0,0), P0[6],P0[7],P0[8],P0[9],     pw0[2]=PKW(P0,4), pw0[3]=PKW(P0,6), pw0); \
    VRD(1); SBAR(); GAPA(C0=__builtin_amdgcn_mfma_f32_32x32x16_bf16(kf[2],qr[1],C0,0,0,0),   P0[10],P0[11],P0[12],P0[13], pw1[0]=PKW(P0,8), pw1[1]=PKW(P0,10), pw1); \
    VRD(5); SBAR(); GAPA(C1=__builtin_amdgcn_mfma_f32_32x32x16_bf16(kf[3],qr[1],C1,0,0,0),   P0[14],P0[15],P1[0],P1[1],   pw1[2]=PKW(P0,12),pw1[3]=PKW(P0,14), pw1); \
    VRD(2); SBAR(); GAPA(C0=__builtin_amdgcn_mfma_f32_32x32x16_bf16(kf[4],qr[2],C0,0,0,0),   P1[2],P1[3],P1[4],P1[5],     pw2[0]=PKW(P1,0), pw2[1]=PKW(P1,2), pw2); \
    VRD(6); SBAR(); GAPA(C1=__builtin_amdgcn_mfma_f32_32x32x16_bf16(kf[5],qr[2],C1,0,0,0),   P1[6],P1[7],P1[8],P1[9],     pw2[2]=PKW(P1,4), pw2[3]=PKW(P1,6), pw2); \
    VRD(3); SBAR(); GAPA(C0=__builtin_amdgcn_mfma_f32_32x32x16_bf16(kf[6],qr[3],C0,0,0,0),   P1[10],P1[11],P1[12],P1[13], pw3[0]=PKW(P1,8), pw3[1]=PKW(P1,10), pw3); \
    VRD(7); SBAR(); GAPA(C1=__builtin_amdgcn_mfma_f32_32x32x16_bf16(kf[7],qr[3],C1,0,0,0),   P1[14],P1[15],0.f,0.f,       pw3[2]=PKW(P1,12),pw3[3]=PKW(P1,14), pw3); \
    l_reg+=sacc; \
    if(GK){DMA_K((t)+3,sl_cur);} if(GV){DMA_V((t)+1,sl_next);} \
    CMASK(C0,C1,t); \
    { float a=MX3(C0[0],C0[1],C1[0]),b=MX3(C0[2],C0[3],C1[1]); a=MX3(a,C1[2],C1[3]); \
      _Pragma("unroll") for(int r=4;r<16;r+=4){a=MX3(a,C0[r],C0[r+1]);b=MX3(b,C0[r+2],C0[r+3]);a=MX3(a,C1[r],C1[r+1]);b=MX3(b,C1[r+2],C1[r+3]);} \
      float rm=__builtin_fmaxf(a,b); { auto rr=__builtin_amdgcn_permlane32_swap(__float_as_uint(rm),__float_as_uint(rm),false,false); rm=__builtin_fmaxf(__uint_as_float(rr[0]),__uint_as_float(rr[1])); } \
      resc=false; \
      if(__builtin_expect(__any(rm>(float)THRL),0)){ const float dl=__builtin_fmaxf(rm,0.f); mhat+=dl; \
        _Pragma("unroll") for(int r=0;r<16;++r){C0[r]-=dl;C1[r]-=dl;} \
        _Pragma("unroll") for(int r=0;r<16;++r)negm[r]=-mhat; asm volatile("":"+v"(negm)); \
        const float f=__builtin_amdgcn_exp2f(-dl); l_reg*=f; if(hi==0)wsf[r32]=f; resc=true; } } \
    SBAR(); \
    GAPB(o[0]=__builtin_amdgcn_mfma_f32_32x32x16_bf16(PAF(0),VFR(0),o[0],0,0,0), C0,0); \
    GAPB(o[1]=__builtin_amdgcn_mfma_f32_32x32x16_bf16(PAF(0),VFR(4),o[1],0,0,0), C0,4); \
    KRD(GL,0); GAPB(o[0]=__builtin_amdgcn_mfma_f32_32x32x16_bf16(PAF(1),VFR(1),o[0],0,0,0), C0,8); \
    KRD(GL,1); GAPB(o[1]=__builtin_amdgcn_mfma_f32_32x32x16_bf16(PAF(1),VFR(5),o[1],0,0,0), C0,12); \
    KRD(GL,2); GAPB(o[0]=__builtin_amdgcn_mfma_f32_32x32x16_bf16(PAF(2),VFR(2),o[0],0,0,0), C1,0); \
    KRD(GL,3); GAPB(o[1]=__builtin_amdgcn_mfma_f32_32x32x16_bf16(PAF(2),VFR(6),o[1],0,0,0), C1,4); \
    GAPB(o[0]=__builtin_amdgcn_mfma_f32_32x32x16_bf16(PAF(3),VFR(3),o[0],0,0,0), C1,8); \
    GAPB(o[1]=__builtin_amdgcn_mfma_f32_32x32x16_bf16(PAF(3),VFR(7),o[1],0,0,0), C1,12); \
    }while(0)
  int t=1;
  #undef CMASK
  #define CMASK(P0,P1,t) do{}while(0)
  for(;t+5<NT;t+=2){
    STEP(pB0,pB1,pA0,pA1,t,true,true,true);     WAIT_BAR(2); RESC(); ROT();
    STEP(pA0,pA1,pB0,pB1,t+1,true,true,true);   WAIT_BAR(2); RESC(); ROT();
  }
  #undef CMASK
  #define CMASK(P0,P1,t) do{}while(0)
  #define ENDW(tt) do{ if((tt)+3<NT){WAIT_BAR(2);} else if((tt)+2<NT){WAIT_BAR(1);} else {WAIT_BAR(0);} }while(0)
  for(;t+1<NT;t+=2){
    STEP(pB0,pB1,pA0,pA1,t,(t+3<NT),(t+1<NT),(t+1<NT));       ENDW(t);   RESC(); ROT();
    STEP(pA0,pA1,pB0,pB1,t+1,(t+4<NT),(t+2<NT),(t+2<NT));     ENDW(t+1); RESC(); ROT();
  }
  STEP(pB0,pB1,pA0,pA1,NT-1,false,false,false); RESC();
  { float sacc=pB0[0]+pB0[1]; _Pragma("unroll") for(int r=2;r<16;++r)sacc+=pB0[r]; _Pragma("unroll") for(int r=0;r<16;++r)sacc+=pB1[r]; l_reg+=sacc;
    pw0=(u32x4){PKW(pB0,0),PKW(pB0,2),PKW(pB0,4),PKW(pB0,6)};pw1=(u32x4){PKW(pB0,8),PKW(pB0,10),PKW(pB0,12),PKW(pB0,14)};pw2=(u32x4){PKW(pB1,0),PKW(pB1,2),PKW(pB1,4),PKW(pB1,6)};pw3=(u32x4){PKW(pB1,8),PKW(pB1,10),PKW(pB1,12),PKW(pB1,14)};
    SBAR(); pv(o,vb0+sl_cur,PAF(0),PAF(1),PAF(2),PAF(3)); }
  #undef PKW
  #undef PAF
  #undef VFR
  #undef PIN
  #undef MX3
  #undef GAPA
  #undef GAPB
  #undef EX
  #undef VRD
  #undef KRD
  #undef STEP
  #undef ENDW
  {auto rr=__builtin_amdgcn_permlane32_swap(__float_as_uint(l_reg),__float_as_uint(l_reg),false,false);l_reg=__uint_as_float(rr[0])+__uint_as_float(rr[1]);}
  if(hi==0)wsf[32+r32]=l_reg;asm volatile("s_waitcnt lgkmcnt(0)":::"memory");
  float rli[16];
  #pragma unroll
  for(int r=0;r<16;++r)rli[r]=__builtin_amdgcn_rcpf(wsf[32+crow(r,hi)]);
  bf16*Ow=O+(rowbase+q0+wid*QBLK)*OP+h*D;
  { bf16*stg=(bf16*)(shm+LDS_OST)+wid*2048;
    #pragma unroll
    for(int r=0;r<16;++r){const int orow=crow(r,hi);
      #pragma unroll
      for(int d0=0;d0<2;++d0)stg[orow*64+d0*32+r32]=__float2bfloat16(o[d0][r]*rli[r]);}
    asm volatile("s_waitcnt lgkmcnt(0)":::"memory");
    #pragma unroll
    for(int i=0;i<4;++i){const int row=i*8+(lane>>3),ch=lane&7; const u32x4 v=*(const u32x4*)(stg+row*64+ch*8); ATTN_STORE16(Ow+(long)row*OP+ch*8,v);} }
  asm volatile("s_waitcnt lgkmcnt(0)\n\ts_barrier":::"memory");
  #undef DMA_K
  #undef DMA_V
  #undef CMASK
  #undef START
  #undef RESC
  #undef ROT
}
constexpr int ATTN_LDS_BYTES=LDS_BYTES;
struct AttnTensors { const bf16* Q; const bf16* K; const bf16* V; bf16* O; };
struct AttnUnit { int b; int h; int qb; };
struct StaticOrder {
  int vcu, G;
  __device__ __forceinline__ explicit StaticOrder(int grid,int block):vcu((grid%8==0)?(block%8)*(grid/8)+block/8:block),G(grid){}
  __device__ __forceinline__ bool next(int i,AttnUnit&u)const{
    if(G==256){ if(i>=4)return false; const int g=vcu>>5; u.b=g>>1; u.h=(g&1)*4+i; u.qb=vcu&31; return true; }
    const int id=i*G+vcu; if(id>=1024)return false; const int g=id>>7, r=id&127; u.b=g>>1; u.h=(g&1)*4+(r&3); u.qb=r>>2; return true; }
  __device__ __forceinline__ void a_ready(const AttnUnit&)const{}
  __device__ __forceinline__ void done(const AttnUnit&)const{}
};
template<class Sched,int THRL=8> __device__ __forceinline__ void attn_phase(char*lds,const AttnTensors&T,const Sched&S){
  AttnUnit u;
  for(int i=0;S.next(i,u);++i){ S.a_ready(u); attn_unit<THRL>(u.b,u.h,u.qb,T.Q,T.K,T.V,T.O,lds); S.done(u); }
}
#undef SBAR
#undef WAIT_BAR
}

#define XB_TMO      128
#define XB_XCNT(j)  (256  + 64 * (j))
#define XB_XSUB(j)  (1280 + 64 * (j))
#define XB_XGEN(j)  (2304 + 64 * (j))
#define XB_TOP      3328
#define XB_TOPGEN   3392
#define XCD_BAR_WORDS 3456
#define XB_SPIN_CAP (1u << 18)

__device__ __forceinline__ unsigned xb_ld(unsigned* p)              { return __hip_atomic_load(p, __ATOMIC_RELAXED, __HIP_MEMORY_SCOPE_AGENT); }
__device__ __forceinline__ unsigned xb_add(unsigned* p, unsigned v) { return __hip_atomic_fetch_add(p, v, __ATOMIC_RELAXED, __HIP_MEMORY_SCOPE_AGENT); }
__device__ __forceinline__ unsigned xb_xcc_id() { return (unsigned)__builtin_amdgcn_s_getreg((3 << 11) | 20) & 0xFu; }
#define XB_SPIN(cond, bar) do { unsigned _sp = 0; while (cond) { __builtin_amdgcn_s_sleep(1); \
    if ((++_sp & 255u) == 0u) { if (xb_ld(&(bar)[XB_TMO])) break; if (_sp > XB_SPIN_CAP) { atomicAdd(&(bar)[XB_TMO], 1u); break; } } } } while (0)

struct XcdBarrier {
    unsigned* bar; unsigned x;
    volatile LAS unsigned* st;
};

__device__ __forceinline__ XcdBarrier xcd_barrier_post(unsigned* bar, volatile LAS unsigned* st) {
    XcdBarrier b; b.bar = bar; b.x = xb_xcc_id(); b.st = st;
    if (threadIdx.x == 0) (void)xb_add(&bar[XB_XCNT(b.x)], 1u);
    return b;
}
__device__ __forceinline__ void xcd_barrier_complete(unsigned* bar, unsigned x, unsigned& nloc, unsigned& nx) {
    const unsigned G = gridDim.x * gridDim.y * gridDim.z;
    unsigned sum, cnt, mine, sp = 0u;
    for (;;) {
        sum = 0u; cnt = 0u; mine = 0u;
#pragma unroll
        for (unsigned j = 0; j < 16; ++j) { const unsigned c = xb_ld(&bar[XB_XCNT(j)]); sum += c; cnt += (c > 0u) ? 1u : 0u; mine = (j == x) ? c : mine; }
        if (sum == G) break;
        __builtin_amdgcn_s_sleep(1);
        if ((++sp & 255u) == 0u) { if (xb_ld(&bar[XB_TMO])) break; if (sp > XB_SPIN_CAP) { atomicAdd(&bar[XB_TMO], 1u); break; } }
    }
    nloc = mine > 0u ? mine : 1u; nx = cnt > 0u ? cnt : 1u;
}

__device__ __forceinline__ void xcd_barrier(const XcdBarrier& b) {
    asm volatile("s_waitcnt vmcnt(0)" ::: "memory");
    __syncthreads();
    if (threadIdx.x == 0) {
        unsigned* bar = b.bar;
        __builtin_amdgcn_s_waitcnt(0);
        unsigned nloc = b.st[0], nx = b.st[1];
        if (nloc == 0u) { xcd_barrier_complete(bar, b.x, nloc, nx); b.st[0] = nloc; b.st[1] = nx; }
        const unsigned old = xb_add(&bar[XB_XSUB(b.x)], 1u);
        const unsigned gen = old / nloc;
        if (old + 1u == (gen + 1u) * nloc) {
            __builtin_amdgcn_fence(__ATOMIC_RELEASE, "agent");
            asm volatile("s_waitcnt vmcnt(0)" ::: "memory");
            const unsigned og = xb_add(&bar[XB_TOP], 1u);
            const unsigned tg = og / nx;
            if (og + 1u == (tg + 1u) * nx) xb_add(&bar[XB_TOPGEN], 1u);
            else XB_SPIN(xb_ld(&bar[XB_TOPGEN]) == tg, bar);
            __builtin_amdgcn_fence(__ATOMIC_ACQUIRE, "agent");
            xb_add(&bar[XB_XGEN(b.x)], 1u);
            asm volatile("s_waitcnt vmcnt(0)" ::: "memory");
        } else {
            XB_SPIN(xb_ld(&bar[XB_XGEN(b.x)]) == gen, bar);
            __builtin_amdgcn_fence(__ATOMIC_ACQUIRE, "agent");
            asm volatile("s_waitcnt vmcnt(0)" ::: "memory");
        }
    }
    __syncthreads();
}

typedef unsigned v4u __attribute__((ext_vector_type(4)));
typedef unsigned v2u __attribute__((ext_vector_type(2)));
typedef float v4f __attribute__((ext_vector_type(4)));
constexpr int NWAVES = 8, NTHR = 512;
constexpr size_t MiB = 1u << 20;
constexpr int LDS_BYTES = 163840;
constexpr size_t WS_CTL = 0, CTL_ZERO_BYTES = 64 * 1024;
constexpr size_t WS_MOD = 1 * MiB;
constexpr size_t WS_W_IN = 2 * MiB, WS_W_OUT = 5 * MiB, WS_CD_IN = 7 * MiB, WS_CD_OUT = 13 * MiB, WS_WQ = 15 * MiB;
constexpr size_t WS_TAB = 24 * MiB;
constexpr size_t WS_XS = 88 * MiB;
constexpr size_t WS_HA = 220 * MiB;
constexpr size_t WS_ZB = 286 * MiB;
constexpr size_t WS_IDXG = 469 * MiB;
constexpr size_t WS_END = 486 * MiB;
constexpr int CD_PAD = ZZP;
constexpr int CW_CMAX = 6144, CM_WIN = 0, CM_CD = 1536, CM_GATE = 4352, CM_WOUT = 4416, CM_WQ1 = 5440, CM_WQ0 = 7488;
constexpr size_t WS_W_OUT8 = 4 * MiB;
constexpr size_t WS_SA = WS_MOD + 832 * 1024;

__device__ __forceinline__ unsigned pk2(float lo, float hi) { return (unsigned)f2bf(lo) | ((unsigned)f2bf(hi) << 16); }
__device__ __forceinline__ float bflo(unsigned d) { return __uint_as_float(d << 16); }
__device__ __forceinline__ float bfhi(unsigned d) { return __uint_as_float(d & 0xffff0000u); }
__device__ __forceinline__ void ld8(const float* p, v4f& a, v4f& b) { a = *(const v4f*)p; b = *(const v4f*)(p + 4); }
__device__ __forceinline__ void ld8(const bf16_t* p, v4f& a, v4f& b) { const v4u w = *(const v4u*)p; a = (v4f){bflo(w.x), bfhi(w.x), bflo(w.y), bfhi(w.y)}; b = (v4f){bflo(w.z), bfhi(w.z), bflo(w.w), bfhi(w.w)}; }
__device__ __forceinline__ void st8(float* p, const v4f& a, const v4f& b) { *(v4f*)p = a; *(v4f*)(p + 4) = b; }
__device__ __forceinline__ void st8(bf16_t* p, const v4f& a, const v4f& b) { v4u o; o.x = pk2(a[0], a[1]); o.y = pk2(a[2], a[3]); o.z = pk2(b[0], b[1]); o.w = pk2(b[2], b[3]); *(v4u*)p = o; }
__device__ __forceinline__ void st8nt(float* p, const v4f& a, const v4f& b) { __builtin_nontemporal_store(a, (v4f*)p); __builtin_nontemporal_store(b, (v4f*)(p + 4)); }
__device__ __forceinline__ void st8nt(bf16_t* p, const v4f& a, const v4f& b) { v4u o; o.x = pk2(a[0], a[1]); o.y = pk2(a[2], a[3]); o.z = pk2(b[0], b[1]); o.w = pk2(b[2], b[3]); __builtin_nontemporal_store(o, (v4u*)p); }
#define LDS_WAIT() asm volatile("s_waitcnt lgkmcnt(0)" ::: "memory")
#define VM_WAIT() asm volatile("s_waitcnt vmcnt(0)" ::: "memory")


__device__ __forceinline__ int rowperm(int n) { return (n & ~255) | (((((n >> 5) & 1) << 2) | ((n >> 6) & 3)) << 5) | (n & 31); }
__device__ __forceinline__ int roworig(int p) { return (p & ~255) | (((((p >> 5) & 3) << 1) | ((p >> 7) & 1)) << 5) | (p & 31); }
struct EpiStore {
    static constexpr bool PERM = true, AFTER_DRAIN = false;
    bf16_t* O; int ldc; int nvalid;
    __device__ __forceinline__ void operator()(const pg8::f32x4 (&acc)[2][2][4][2], const pg8::Unit& u, int wr, int wc, int fr, int fq) const {
        const int row0 = u.pm * 256 + wr * 64 + fr, colw = u.pn * 256 + wc * 64 + 8 * fq; const bool up = fr >= 8;
#pragma unroll
        for (int ai = 0; ai < 2; ++ai)
#pragma unroll
            for (int m = 0; m < 4; ++m) { const int r = row0 + ai * 128 + m * 16; pg8::u32x4 w[2];
#pragma unroll
                for (int bj = 0; bj < 2; ++bj) { const pg8::f32x4 v0 = acc[ai][bj][m][0], v1 = acc[ai][bj][m][1];
                    w[bj].x = pg8::cvt_pk_bf16(v0[0], v0[1]); w[bj].y = pg8::cvt_pk_bf16(v0[2], v0[3]); w[bj].z = pg8::cvt_pk_bf16(v1[0], v1[1]); w[bj].w = pg8::cvt_pk_bf16(v1[2], v1[3]); }
                const pg8::u32x4 snd = up ? w[0] : w[1]; pg8::u32x4 rcv;
                rcv.x = __shfl_xor(snd.x, 8); rcv.y = __shfl_xor(snd.y, 8); rcv.z = __shfl_xor(snd.z, 8); rcv.w = __shfl_xor(snd.w, 8);
                bf16_t* p1 = O + (size_t)(up ? r - 8 : r) * ldc + colw + (up ? 32 : 0);
                *(pg8::u32x4*)p1 = up ? rcv : w[0]; *(pg8::u32x4*)(p1 + (size_t)8 * ldc) = up ? w[1] : rcv; }
    }
};

struct EpiStoreI8 {
    static constexpr bool PERM = true, AFTER_DRAIN = false;
    bf16_t* O; int ldc; int nvalid; const float* sa; const unsigned* cmax;
    __device__ __forceinline__ void operator()(const pg8::i32x4 (&acc)[2][2][4][2], const pg8::Unit& u, int wr, int wc, int fr, int fq) const {
        const int row0 = u.pm * 256 + wr * 64 + fr, colw = u.pn * 256 + wc * 64 + 8 * fq; const bool up = fr >= 8;
        float sb[2][8];
#pragma unroll
        for (int bj = 0; bj < 2; ++bj)
#pragma unroll
            for (int c = 0; c < 8; ++c) sb[bj][c] = __uint_as_float(cmax[colw + bj * 32 + c]) * (1.f / 127.f);
#pragma unroll
        for (int ai = 0; ai < 2; ++ai)
#pragma unroll
            for (int m = 0; m < 4; ++m) { const int r = row0 + ai * 128 + m * 16; const float s = sa[r]; pg8::u32x4 w[2];
#pragma unroll
                for (int bj = 0; bj < 2; ++bj) { const pg8::i32x4 a0 = acc[ai][bj][m][0], a1 = acc[ai][bj][m][1];
                    w[bj].x = pg8::cvt_pk_bf16((float)a0[0] * s * sb[bj][0], (float)a0[1] * s * sb[bj][1]); w[bj].y = pg8::cvt_pk_bf16((float)a0[2] * s * sb[bj][2], (float)a0[3] * s * sb[bj][3]);
                    w[bj].z = pg8::cvt_pk_bf16((float)a1[0] * s * sb[bj][4], (float)a1[1] * s * sb[bj][5]); w[bj].w = pg8::cvt_pk_bf16((float)a1[2] * s * sb[bj][6], (float)a1[3] * s * sb[bj][7]); }
                const pg8::u32x4 snd = up ? w[0] : w[1]; pg8::u32x4 rcv;
                rcv.x = __shfl_xor(snd.x, 8); rcv.y = __shfl_xor(snd.y, 8); rcv.z = __shfl_xor(snd.z, 8); rcv.w = __shfl_xor(snd.w, 8);
                bf16_t* p1 = O + (size_t)(up ? r - 8 : r) * ldc + colw + (up ? 32 : 0);
                *(pg8::u32x4*)p1 = up ? rcv : w[0]; *(pg8::u32x4*)(p1 + (size_t)8 * ldc) = up ? w[1] : rcv; }
    }
};

__device__ __forceinline__ void transpose_item(const float* W, int K, int N, int Npad, bf16_t* WT, LAS float* scr, int item, int lane, int ldo = 0, int ldw = 0) {
    if (ldo == 0) ldo = K;
    if (ldw == 0) ldw = N;
    const int nblk = Npad / 32, kb = item / nblk, nb = item % nblk, k0 = 64 * kb, n0 = 32 * nb;
    const int nn = n0 + (lane & 31);
#pragma unroll 8
    for (int i = 0; i < 32; ++i) { const int kk = 2 * i + (lane >> 5); scr[kk * 33 + (lane & 31)] = nn < N ? W[(size_t)(k0 + kk) * ldw + nn] : 0.f; }
    LDS_WAIT(); asm volatile("" ::: "memory");
    const int c = lane & 7;
#pragma unroll
    for (int j = 0; j < 4; ++j) { const int n = (lane >> 3) + 8 * j; const LAS float* s = scr + (8 * c) * 33 + n;
        v4u o; o.x = pk2(s[0 * 33], s[1 * 33]); o.y = pk2(s[2 * 33], s[3 * 33]); o.z = pk2(s[4 * 33], s[5 * 33]); o.w = pk2(s[6 * 33], s[7 * 33]);
        *(v4u*)(WT + (size_t)rowperm(n0 + n) * ldo + k0 + 8 * c) = o; }
    LDS_WAIT(); asm volatile("" ::: "memory");
}
__device__ __forceinline__ void fold_item(const float* pool_w, const float* pool_ls, const float* w_out, bf16_t* WT, int item, int lane) {
    const int k = item & 511, n = (item >> 9) * 64 + lane, g = k >> 7;
    const float* pw = pool_w + ((size_t)g * 128 + (k & 127)) * 128;
    float acc = 0.f;
#pragma unroll 8
    for (int j = 0; j < 128; ++j) acc += pw[j] * pool_ls[g * 128 + j] * w_out[(size_t)(g * 128 + j) * 1024 + n];
    WT[(size_t)rowperm(n) * 1024 + k] = f2bf(acc);
}
__device__ __forceinline__ unsigned q8pack4(float a, float b, float c, float d, float inv) {
    int q0 = __float2int_rn(a * inv), q1 = __float2int_rn(b * inv), q2 = __float2int_rn(c * inv), q3 = __float2int_rn(d * inv);
    q0 = q0 > 127 ? 127 : (q0 < -127 ? -127 : q0); q1 = q1 > 127 ? 127 : (q1 < -127 ? -127 : q1); q2 = q2 > 127 ? 127 : (q2 < -127 ? -127 : q2); q3 = q3 > 127 ? 127 : (q3 < -127 ? -127 : q3);
    return (unsigned)(q0 & 255) | ((unsigned)(q1 & 255) << 8) | ((unsigned)(q2 & 255) << 16) | ((unsigned)(q3 & 255) << 24);
}
__device__ __forceinline__ void colmax_item(const float* W  , int ldw, int ncols, unsigned* cmax, int item, int lane) {
    const int kq = item & 3, n = (item >> 2) * 64 + lane;
    if (n < ncols) { const float* w = W + (size_t)(kq * 256) * ldw + n; float mx = 0.f;
#pragma unroll 16
        for (int k = 0; k < 256; ++k) mx = fmaxf(mx, fabsf(w[(size_t)k * ldw]));
        atomicMax(&cmax[n], __float_as_uint(mx)); }
}
__device__ __forceinline__ void transpose8_item(const float* W, int ldw, int ncols, const unsigned* cmax, signed char* WT, LAS float* scr, int item, int lane) {
    const int nblk = ncols / 32, kb = item / nblk, nb = item % nblk, k0 = 64 * kb, n0 = 32 * nb;
#pragma unroll 8
    for (int i = 0; i < 32; ++i) { const int kk = 2 * i + (lane >> 5); scr[kk * 33 + (lane & 31)] = W[(size_t)(k0 + kk) * ldw + n0 + (lane & 31)]; }
    LDS_WAIT(); asm volatile("" ::: "memory");
    const int c = lane & 3;
#pragma unroll
    for (int j = 0; j < 2; ++j) { const int n = (lane >> 2) + 16 * j; const LAS float* s = scr + (16 * c) * 33 + n;
        const float inv = 127.f / fmaxf(__uint_as_float(cmax[n0 + n]), 1e-30f);
        v4u o;
#pragma unroll
        for (int q = 0; q < 4; ++q) o[q] = q8pack4(s[(4 * q) * 33], s[(4 * q + 1) * 33], s[(4 * q + 2) * 33], s[(4 * q + 3) * 33], inv);
        *(v4u*)(WT + (size_t)rowperm(n0 + n) * 1024 + k0 + 16 * c) = o; }
    LDS_WAIT(); asm volatile("" ::: "memory");
}
__device__ __forceinline__ void ph_w8(const float* const* in, unsigned char* ws, LAS unsigned char* lds, int lane, int wave, int gw, int NGW) {
    LAS float* scr = (LAS float*)(lds + 24576 + wave * 8704);
    const unsigned* cm = (const unsigned*)(ws + WS_CTL) + CW_CMAX;
    constexpr int I_WIN = 16 * (AB_IN / 32), I_CDA = 16 * 64, I_CDB = 16 * 24;
    constexpr int I_WQ8 = 16 * 64;
    for (int it = gw; it < I_WIN + I_CDA + I_CDB + 1024 + 2 * I_WQ8; it += NGW) {
        int r = it;
        if (r >= I_WIN + I_CDA + I_CDB + 1024 + I_WQ8) { transpose8_item(in[22], 2048, 2048, cm + CM_WQ0, (signed char*)(ws + WS_WQ), scr, r - (I_WIN + I_CDA + I_CDB + 1024 + I_WQ8), lane); continue; }
        if (r >= I_WIN + I_CDA + I_CDB + 1024) { transpose8_item(in[22] + (size_t)1024 * 2048, 2048, 2048, cm + CM_WQ1, (signed char*)(ws + WS_WQ) + (size_t)4 * MiB, scr, r - (I_WIN + I_CDA + I_CDB + 1024), lane); continue; }
        if (r >= I_WIN + I_CDA + I_CDB) {
            const int n = r - (I_WIN + I_CDA + I_CDB); const bf16_t* wr = (const bf16_t*)(ws + WS_W_OUT) + (size_t)n * 1024 + lane * 16;
            const v4u a0 = *(const v4u*)wr, a1 = *(const v4u*)(wr + 8); float f[16]; float mx = 0.f;
#pragma unroll
            for (int e = 0; e < 4; ++e) { f[2 * e] = bflo(a0[e]); f[2 * e + 1] = bfhi(a0[e]); f[8 + 2 * e] = bflo(a1[e]); f[9 + 2 * e] = bfhi(a1[e]); }
#pragma unroll
            for (int e = 0; e < 16; ++e) mx = fmaxf(mx, fabsf(f[e]));
#pragma unroll
            for (int o_ = 1; o_ < 64; o_ <<= 1) mx = fmaxf(mx, __shfl_xor(mx, o_));
            mx = fmaxf(mx, 1e-30f); const float inv = 127.f / mx;
            if (lane == 0) ((unsigned*)(ws + WS_CTL) + CW_CMAX)[CM_WOUT + roworig(n)] = __float_as_uint(mx);
            v4u o;
#pragma unroll
            for (int q = 0; q < 4; ++q) o[q] = q8pack4(f[4 * q], f[4 * q + 1], f[4 * q + 2], f[4 * q + 3], inv);
            *(v4u*)(ws + WS_W_OUT8 + (size_t)n * 1024 + lane * 16) = o; continue; }
        if (r < I_WIN) { transpose8_item(in[8], AB_IN, AB_IN, cm + CM_WIN, (signed char*)(ws + WS_W_IN), scr, r, lane); continue; } r -= I_WIN;
        if (r < I_CDA) { transpose8_item(in[16], CD_IN, 2048, cm + CM_CD, (signed char*)(ws + WS_CD_IN), scr, r, lane); continue; } r -= I_CDA;
        transpose8_item(in[16] + 2064, CD_IN, 768, cm + CM_CD + 2048, (signed char*)(ws + WS_CD_IN) + (size_t)2048 * 1024, scr, r, lane);
    }
}
__device__ __forceinline__ void cvt_row_bf16(const float* src, bf16_t* dst, int lane) {
#pragma unroll
    for (int j = 0; j < 2; ++j) { const int e = (j * 64 + lane) * 8; const v4f a = *(const v4f*)(src + e), b = *(const v4f*)(src + e + 4);
        v4u o; o.x = pk2(a[0], a[1]); o.y = pk2(a[2], a[3]); o.z = pk2(b[0], b[1]); o.w = pk2(b[2], b[3]); *(v4u*)(dst + e) = o; }
}
typedef int v4i __attribute__((ext_vector_type(4)));
typedef float v2f __attribute__((ext_vector_type(2)));
constexpr size_t TAB_VQ = 16 * MiB, SLICE_B = (size_t)16384 * 128;
constexpr size_t WS_SU = WS_MOD + 512 * 1024;
__device__ __forceinline__ float wave_sum_early(float v) {
#pragma unroll
    for (int o = 1; o < 64; o <<= 1) v += __shfl_xor(v, o);
    return v;
}
__device__ __forceinline__ float wave_max(float v) {
#pragma unroll
    for (int o = 1; o < 64; o <<= 1) v = fmaxf(v, __shfl_xor(v, o));
    return v;
}
__device__ __forceinline__ void ph_tables(const float* const* in, unsigned char* ws, int layer, int gw, int NGW, int lane) {
    const float* U = in[24] + (size_t)layer * 16384 * 1024; const float* V = in[25] + (size_t)layer * 16384 * 1024;
    unsigned char* UQ = ws + WS_TAB; unsigned char* VQ = ws + WS_TAB + TAB_VQ; float* SU = (float*)(ws + WS_SU);
    const int s = lane >> 3, j = lane & 7;
    v4f nx[4];
    if (gw < 32768) { const float* src = (gw < 16384 ? U + (size_t)gw * 1024 : V + (size_t)(gw - 16384) * 1024) + s * 128 + j * 16;
#pragma unroll
        for (int c = 0; c < 4; ++c) nx[c] = *(const v4f*)(src + 4 * c); }
    for (int it = gw; it < 32768; it += NGW) {
        const bool isu = it < 16384; const int e = isu ? it : it - 16384;
        float x[16];
#pragma unroll
        for (int c = 0; c < 4; ++c) { x[4 * c] = nx[c][0]; x[4 * c + 1] = nx[c][1]; x[4 * c + 2] = nx[c][2]; x[4 * c + 3] = nx[c][3]; }
        if (it + NGW < 32768) { const int i2 = it + NGW; const float* src = (i2 < 16384 ? U + (size_t)i2 * 1024 : V + (size_t)(i2 - 16384) * 1024) + s * 128 + j * 16;
#pragma unroll
            for (int c = 0; c < 4; ++c) nx[c] = *(const v4f*)(src + 4 * c); }
        v4i o;
        if (isu) {
            float ss = 0.f;
#pragma unroll
            for (int c = 0; c < 16; ++c) ss += x[c] * x[c];
            const float stp = 0.3352f * sqrtf(wave_sum_early(ss) * (1.f / 1024.f)) + 1e-30f, istp = 1.f / stp;
            unsigned nb[16]; int qs = 0;
#pragma unroll
            for (int c = 0; c < 16; ++c) { int q = (int)floorf(x[c] * istp); q = q < -8 ? -8 : (q > 7 ? 7 : q); qs += q; nb[c] = (unsigned)(q & 15); }
            const float qsum = wave_sum_early((float)qs);
            if (lane == 0) { SU[2 * e] = stp; SU[2 * e + 1] = 8.f * qsum; }
            v2u ow;
#pragma unroll
            for (int w = 0; w < 2; ++w) { unsigned ww = 0;
#pragma unroll
                for (int b = 0; b < 4; ++b) ww |= (nb[8 * w + b] | (nb[8 * w + 4 + b] << 4)) << (8 * b);
                ow[w] = ww; }
            *(v2u*)(UQ + (size_t)(lane >> 4) * SLICE_B + (size_t)e * 128 + (lane & 15) * 8) = ow;
        } else {
#pragma unroll
            for (int c = 0; c < 4; ++c) { int w = __builtin_amdgcn_cvt_pk_fp8_f32(x[4 * c], x[4 * c + 1], 0, false); w = __builtin_amdgcn_cvt_pk_fp8_f32(x[4 * c + 2], x[4 * c + 3], w, true); o[c] = w; }
            *(v4i*)(VQ + (size_t)s * SLICE_B + (size_t)e * 128 + j * 16) = o;
        }
    }
}
__device__ __forceinline__ void ph_prologue(const float* const* in, unsigned char* ws, LAS unsigned char* lds, int tid, int lane, int wave, int gw, int NGW) {
    LAS float* sv = (LAS float*)lds;
    LAS float* scr = (LAS float*)(lds + 24576 + wave * 8704);
    for (int i = tid; i < 5120; i += NTHR) { const int r = i >> 10, k = i & 1023; const float v = r < 4 ? in[1][r * 1024 + k] : in[3][k]; sv[i] = v / (1.f + __expf(-v)); }
    __syncthreads();
    {
        LAS float* red = (LAS float*)(lds + 24576);
        const int vb = (int)blockIdx.x;
        for (int item = vb; item < 192; item += (int)gridDim.x) {
            const int l = item / 96, col = (item % 96) * 64 + lane;
            const float* w = in[4] + (size_t)l * 1024 * 6144 + (size_t)(wave * 128) * 6144 + col;
            float acc[5] = {0.f, 0.f, 0.f, 0.f, 0.f};
#pragma unroll 16
            for (int k = 0; k < 128; ++k) { const float wv = w[(size_t)k * 6144];
#pragma unroll
                for (int r = 0; r < 5; ++r) acc[r] += sv[r * 1024 + wave * 128 + k] * wv; }
#pragma unroll
            for (int r = 0; r < 5; ++r) red[(wave * 5 + r) * 64 + lane] = acc[r];
            __syncthreads();
            if (wave < 5) { float s = 0.f;
#pragma unroll
                for (int ww = 0; ww < 8; ++ww) s += red[(ww * 5 + wave) * 64 + lane];
                ((float*)(ws + WS_MOD))[(l * 5 + wave) * 6144 + col] = s + in[5][l * 6144 + col]; }
            __syncthreads();
        }
    }
    constexpr int N_MOD = 0;
    constexpr int I_WOUT = 8 * 32, I_FOLD = 16 * 512, I_CDOUT = 16 * 32;
    constexpr int C_WIN = 4 * (AB_IN / 64), C_CDA = 4 * 32, C_CDB = 4 * 12, C_GATE = 4, I_WQ = 16 * 64;
    constexpr int C_WQ = 4 * 32;
    constexpr int N_TR = I_WOUT + I_FOLD + I_CDOUT + C_WIN + C_CDA + C_CDB + C_GATE + 2 * C_WQ;
    unsigned* cm = (unsigned*)(ws + WS_CTL) + CW_CMAX;
    for (int it = gw; it < N_TR; it += NGW) {
        int r = it;
        if (r < C_WIN) { colmax_item(in[8], AB_IN, AB_IN, cm + CM_WIN, r, lane); continue; } r -= C_WIN;
        if (r < C_CDA) { colmax_item(in[16], CD_IN, 2048, cm + CM_CD, r, lane); continue; } r -= C_CDA;
        if (r < C_CDB) { colmax_item(in[16] + 2064, CD_IN, 768, cm + CM_CD + 2048, r, lane); continue; } r -= C_CDB;
        if (r < C_GATE) { colmax_item(in[16] + 2048, CD_IN, 16, cm + CM_GATE, r, lane); continue; } r -= C_GATE;
        if (r < C_WQ) { colmax_item(in[22], 2048, 2048, cm + CM_WQ0, r, lane); continue; } r -= C_WQ;
        if (r < C_WQ) { colmax_item(in[22] + (size_t)1024 * 2048, 2048, 2048, cm + CM_WQ1, r, lane); continue; } r -= C_WQ;
        if (r < I_WOUT) { transpose_item(in[15] + (size_t)512 * 1024, 512, 1024, 1024, (bf16_t*)(ws + WS_W_OUT) + 512, scr, r, lane, 1024); continue; } r -= I_WOUT;
        if (r < I_FOLD) { fold_item(in[9], in[10], in[15], (bf16_t*)(ws + WS_W_OUT), r, lane); continue; } r -= I_FOLD;
        transpose_item(in[21], 1024, 1024, 1024, (bf16_t*)(ws + WS_CD_OUT), scr, r, lane);
    }
}
__device__ __forceinline__ void ph_moda(const float* xl, const float* xc, const float* mod  , int sh_off, int sc_off, signed char* HA8, float* SA, int nrows, int lane, int wave, int vcu, int G) {
    const int per = nrows / G, r0 = vcu * per;
    v4f msc[4], msh[4], A[4], B[4]; int cur_mod = -1;
    auto ld = [&](v4f (&R)[4], int r) { const float* xr = r < ML ? xl + (size_t)r * D : xc + (size_t)(r - ML) * D;
#pragma unroll
        for (int i = 0; i < 2; ++i) { R[2 * i] = *(const v4f*)(xr + i * 512 + lane * 8); R[2 * i + 1] = *(const v4f*)(xr + i * 512 + lane * 8 + 4); } };
    if (wave < per) ld(A, r0 + wave);
    for (int t = wave; t < per; t += 8) {
        const int r = r0 + t;
        if (t + 8 < per) ld(B, r + 8);
        const int mr = row_mod(r);
        if (mr != cur_mod) { cur_mod = mr; const float* m = mod + mr * 6144;
#pragma unroll
            for (int i = 0; i < 2; ++i) { const int e0 = i * 512 + lane * 8; msc[2 * i] = *(const v4f*)(m + sc_off + e0); msc[2 * i + 1] = *(const v4f*)(m + sc_off + e0 + 4); msh[2 * i] = *(const v4f*)(m + sh_off + e0); msh[2 * i + 1] = *(const v4f*)(m + sh_off + e0 + 4); } }
        v4f y[4]; float mx = 0.f;
#pragma unroll
        for (int i = 0; i < 4; ++i) { y[i] = A[i] * (msc[i] + 1.f) + msh[i]; mx = fmaxf(mx, fmaxf(fmaxf(fabsf(y[i][0]), fabsf(y[i][1])), fmaxf(fabsf(y[i][2]), fabsf(y[i][3])))); }
        mx = fmaxf(wave_max(mx), 1e-30f);
        const float inv = 127.f / mx;
        if (lane == 0) SA[r] = mx * (1.f / 127.f);
#pragma unroll
        for (int i = 0; i < 2; ++i) { v2u o; o.x = q8pack4(y[2 * i][0], y[2 * i][1], y[2 * i][2], y[2 * i][3], inv); o.y = q8pack4(y[2 * i + 1][0], y[2 * i + 1][1], y[2 * i + 1][2], y[2 * i + 1][3], inv);
            *(v2u*)(HA8 + (size_t)r * D + i * 512 + lane * 8) = o; }
#pragma unroll
        for (int i = 0; i < 4; ++i) A[i] = B[i];
    }
}

__device__ __forceinline__ float wave_sum(float v) {
#pragma unroll
    for (int o = 1; o < 64; o <<= 1) v += __shfl_xor(v, o);
    return v;
}
__device__ __forceinline__ void ph_attn_prep(const bf16_t* ZZ, const float* qn_g, const float* kn_g, bf16_t* QA, bf16_t* KA, bf16_t* VA, int gw, int NGW, int lane) {
    const int hs = lane >> 3, j = lane & 7;
    const int half = j >> 2, second = (j >> 1) & 1;
    float qg[8], kg[8], freq[8];
#pragma unroll
    for (int e = 0; e < 8; ++e) { qg[e] = qn_g[j * 8 + e] * attn_body::C2; kg[e] = kn_g[j * 8 + e]; freq[e] = exp2f(-(float)((j & 1) * 8 + e) * (13.287712379549449f / 16.f)); }
    const int col0 = 2048 + hs * 64 + j * 8, col1 = (hs < 2 ? 2560 + hs * 64 : 2688 + (hs & 1) * 64) + j * 8;
    v4u A0, A1, B0 = {0u, 0u, 0u, 0u}, B1 = {0u, 0u, 0u, 0u};
    if (gw < MT) { const bf16_t* zr = ZZ + (size_t)gw * ZZP; A0 = *(const v4u*)(zr + col0); A1 = *(const v4u*)(zr + col1); }
    for (int r = gw; r < MT; r += NGW) {
        if (r + NGW < MT) { const bf16_t* zn = ZZ + (size_t)(r + NGW) * ZZP; B0 = *(const v4u*)(zn + col0); B1 = *(const v4u*)(zn + col1); }
        const bool lat = r < ML; const int b = row_b(r), t = row_t(r);
        const size_t krow = (size_t)b * TK + (lat ? CTX + t : t);
        const float pos = half == 0 ? (float)(t >> 6) : (float)(t & 63);
        float cs[8], sn[8];
#pragma unroll
        for (int e = 0; e < 8; ++e) { const float ang = pos * freq[e]; cs[e] = lat ? __cosf(ang) : 1.f; sn[e] = lat ? __sinf(ang) : 0.f; }
#pragma unroll
        for (int pass = 0; pass < 2; ++pass) {
            if (pass == 0 && !lat) continue;
            const v4u raw = pass == 0 ? A0 : A1;
            float v[8] = {bflo(raw.x), bfhi(raw.x), bflo(raw.y), bfhi(raw.y), bflo(raw.z), bfhi(raw.z), bflo(raw.w), bfhi(raw.w)};
            float ss = 0.f;
#pragma unroll
            for (int e = 0; e < 8; ++e) ss += v[e] * v[e];
            ss += __shfl_xor(ss, 1); ss += __shfl_xor(ss, 2); ss += __shfl_xor(ss, 4);
            const float rs = rsqrtf(ss * (1.f / 64.f) + RMS_EPS);
            v4u o;
            if (pass == 1 && hs >= 2) o = raw;
            else {
#pragma unroll
                for (int e = 0; e < 8; ++e) { v[e] *= rs * (pass == 0 ? qg[e] : kg[e]);
                    const float ot = __shfl_xor(v[e], 2);
                    v[e] = second ? (ot * sn[e] + v[e] * cs[e]) : (v[e] * cs[e] - ot * sn[e]); }
                o.x = pk2(v[0], v[1]); o.y = pk2(v[2], v[3]); o.z = pk2(v[4], v[5]); o.w = pk2(v[6], v[7]);
            }
            if (pass == 0) *(v4u*)(QA + (size_t)r * 512 + hs * 64 + j * 8) = o;
            else if (hs < 2) *(v4u*)(KA + krow * 128 + hs * 64 + j * 8) = o;
            else if (hs < 4) *(v4u*)(VA + krow * 128 + (hs & 1) * 64 + j * 8) = o;
        }
        A0 = B0; A1 = B1;
    }
}

typedef short s16x8 __attribute__((ext_vector_type(8)));
typedef __bf16 bf16x2_v __attribute__((ext_vector_type(2)));
__device__ __forceinline__ int fkey(float f) { const int b = __float_as_int(f); return b ^ ((b >> 31) & 0x7fffffff); }
__device__ __forceinline__ float keyf(int k) { return __int_as_float(k ^ ((k >> 31) & 0x7fffffff)); }
template <int N> __device__ __forceinline__ void bitonic_sort_desc(int (&a)[N]) {
#pragma unroll
    for (int k = 2; k <= N; k <<= 1) {
#pragma unroll
        for (int j = k >> 1; j > 0; j >>= 1) {
#pragma unroll
            for (int i = 0; i < N; ++i) { const int l = i ^ j; if (l > i) { const bool desc = ((i & k) == 0); const int hi = max(a[i], a[l]), lo = min(a[i], a[l]); a[i] = desc ? hi : lo; a[l] = desc ? lo : hi; } }
        }
    }
}
template <int N> __device__ __forceinline__ void oem_sort_desc(int (&a)[N]) {
#pragma unroll
    for (int p = 1; p < N; p <<= 1) {
#pragma unroll
        for (int k = p; k >= 1; k >>= 1) {
#pragma unroll
            for (int j = k % p; j <= N - 1 - k; j += 2 * k) {
#pragma unroll
                for (int i = 0; i <= (k - 1 < N - j - k - 1 ? k - 1 : N - j - k - 1); ++i) {
                    if ((i + j) / (2 * p) == (i + j + k) / (2 * p)) { const int x = i + j, y = i + j + k; const int hi = max(a[x], a[y]), lo = min(a[x], a[y]); a[x] = hi; a[y] = lo; } }
            }
        }
    }
}
template <int N> __device__ __forceinline__ void bitonic_clean_desc(int (&a)[N]) {
#pragma unroll
    for (int j = N >> 1; j > 0; j >>= 1) {
#pragma unroll
        for (int i = 0; i < N; ++i) { const int l = i ^ j; if (l > i) { const int hi = max(a[i], a[l]), lo = min(a[i], a[l]); a[i] = hi; a[l] = lo; } }
    }
}
__device__ __forceinline__ void merge_top16(int (&a)[16], const int (&b)[16]) {
#pragma unroll
    for (int i = 0; i < 16; ++i) a[i] = max(a[i], b[15 - i]);
    bitonic_clean_desc<16>(a);
}
__device__ __forceinline__ int ckey(float v, int pos) { return (fkey(v) & ~255) | (255 - pos); }

__device__ __forceinline__ void ph_route(const bf16_t* Q, const float* keys, unsigned* IDXG, int ntok, LAS unsigned char* lds, int tid, int lane, int wave, int vcu, int G) {
    LAS unsigned char* kl = lds;
    for (int i = tid; i < 4096; i += NTHR) { const int row = i >> 4, ch = i & 15; const float* src = keys + row * 128 + ch * 8;
        const v4f x0 = *(const v4f*)src, x1 = *(const v4f*)(src + 4);
        v4u o; o.x = pk2(x0[0], x0[1]); o.y = pk2(x0[2], x0[3]); o.z = pk2(x1[0], x1[1]); o.w = pk2(x1[2], x1[3]);
        *(LAS v4u*)(kl + row * 272 + ch * 16) = o; }
    __syncthreads();
    LAS int* rowscr = (LAS int*)(lds + 69632 + wave * 8192);
    const int n = lane & 15, q4 = lane >> 4;
    const int per = ntok / G, tok0 = vcu * per, ntile = per / 2;
    for (int tb = wave; tb < ntile; tb += 32) {
        int s0[16], s1[16];
#pragma unroll
        for (int i = 0; i < 16; ++i) { s0[i] = 0; s1[i] = 0; }
#pragma unroll 1
        for (int T = 0; T < 4; ++T) {
            const int tile = tb + 8 * T;
            if (tile < ntile) {
                const int tok = tok0 + tile * 2 + (n >> 3), head = n & 7;
                const bf16_t* qrow = Q + (size_t)tok * 2048 + head * 256;
#pragma unroll
                for (int p = 0; p < 2; ++p) {
                    s16x8 bq[4];
#pragma unroll
                    for (int ks = 0; ks < 4; ++ks) bq[ks] = *(const s16x8*)(qrow + p * 128 + ks * 32 + q4 * 8);
                    int v[32];
#pragma unroll
                    for (int kt = 0; kt < 8; ++kt) {
                        pg8::f32x4 acc = {0.f, 0.f, 0.f, 0.f};
#pragma unroll
                        for (int ks = 0; ks < 4; ++ks) { const s16x8 af = *(const LAS s16x8*)(kl + (p * 128 + kt * 16 + n) * 272 + ks * 64 + q4 * 16);
                            acc = __builtin_amdgcn_mfma_f32_16x16x32_bf16(af, bq[ks], acc, 0, 0, 0); }
#pragma unroll
                        for (int r = 0; r < 4; ++r) v[kt * 4 + r] = (fkey(acc[r]) & ~127) | (127 - (kt * 16 + q4 * 4 + r));
                    }
                    int a16[16], hi16[16];
#pragma unroll
                    for (int i = 0; i < 16; ++i) { a16[i] = v[i]; hi16[i] = v[16 + i]; }
                    oem_sort_desc<16>(a16); oem_sort_desc<16>(hi16); merge_top16(a16, hi16);
#pragma unroll
                    for (int xm = 16; xm <= 32; xm <<= 1) { int b[16];
#pragma unroll
                        for (int i = 0; i < 16; ++i) b[i] = __shfl_xor(a16[i], xm);
                        merge_top16(a16, b); }
                    const bool mine = (q4 == T);
#pragma unroll
                    for (int i = 0; i < 16; ++i) { if (p == 0) s0[i] = mine ? a16[i] : s0[i]; else s1[i] = mine ? a16[i] : s1[i]; }
                }
            }
        }
        const int mytile = tb + 8 * q4;
#pragma unroll
        for (int i = 0; i < 16; ++i) { rowscr[lane * 32 + i] = s0[i]; rowscr[lane * 32 + 16 + i] = s1[i]; }
        float f0[16], f1[16];
#pragma unroll
        for (int i = 0; i < 16; ++i) { f0[i] = keyf(s0[i] & ~127); f1[i] = keyf(s1[i] & ~127); }
        int g0[16], g1[16], g2[16], g3[16];
        constexpr int NEG = (int)0x80000000;
#pragma unroll
        for (int j = 0; j < 16; ++j) { g0[j] = ckey(f0[0] + f1[j], j); g1[j] = NEG; g2[j] = NEG; g3[j] = NEG; }
#pragma unroll
        for (int j = 0; j < 8; ++j) g1[j] = ckey(f0[1] + f1[j], 16 + j);
#pragma unroll
        for (int j = 0; j < 5; ++j) g1[8 + j] = ckey(f0[2] + f1[j], 32 + j);
#pragma unroll
        for (int j = 0; j < 4; ++j) g2[j] = ckey(f0[3] + f1[j], 48 + j);
#pragma unroll
        for (int j = 0; j < 3; ++j) g2[4 + j] = ckey(f0[4] + f1[j], 64 + j);
#pragma unroll
        for (int i = 5; i < 8; ++i) { g2[7 + (i - 5) * 2] = ckey(f0[i] + f1[0], i * 16); g2[8 + (i - 5) * 2] = ckey(f0[i] + f1[1], i * 16 + 1); }
#pragma unroll
        for (int i = 8; i < 16; ++i) g3[i - 8] = ckey(f0[i] + f1[0], i * 16);
        oem_sort_desc<16>(g1); oem_sort_desc<16>(g2); oem_sort_desc<16>(g3);
        merge_top16(g0, g1); merge_top16(g2, g3); merge_top16(g0, g2);
        float t[16]; float den = 0.f;
#pragma unroll
        for (int k = 0; k < 16; ++k) { t[k] = __expf(keyf(g0[k] & ~255) - keyf(g0[0] & ~255)); den += t[k]; }
        const float rden = __builtin_amdgcn_rcpf(den);
        if (mytile < ntile) {
            const int tok = tok0 + mytile * 2 + (n >> 3), head = n & 7;
            unsigned* op = IDXG + ((size_t)tok * 8 + head) * 16;
#pragma unroll
            for (int e4 = 0; e4 < 4; ++e4) { v4u ov;
#pragma unroll
                for (int e = 0; e < 4; ++e) { const int k = e4 * 4 + e; const int pos = 255 - (g0[k] & 255);
                    const int k0 = rowscr[lane * 32 + (pos >> 4)], k1 = rowscr[lane * 32 + 16 + (pos & 15)];
                    ov[e] = (unsigned)((127 - (k0 & 127)) * 128 + (127 - (k1 & 127))) | ((unsigned)f2bf(t[k] * rden) << 16); }
                *(v4u*)(op + e4 * 4) = ov; }
        }
    }
}

#ifndef GATHER_FUSE
#define GATHER_FUSE 1
#endif
template <class TO>
__device__ __forceinline__ void ph_gather(const bf16_t* X1, const signed char* H8, const float* HSC, const unsigned* IDXG, const unsigned char* UQ, const float* SU, const unsigned char* VQ, bf16_t* F,
                                          const float* modl, int g_off, const float* lng, const float* lnb, TO* XO, signed char* HAo, float* SA, const float* modn, int nsh_off, int nsc_off, const float* WG  , const unsigned* GCMp  , float* GT,
                                          int ntok, LAS unsigned char* lds, int tid, int lane, int wave, int vcu, int G) {
    const int per = ntok / G, tok0 = vcu * per;
    LAS unsigned* igl = (LAS unsigned*)lds;
    LAS float* act = (LAS float*)(lds + 67584);
    for (int i = tid; i < per * 128; i += NTHR) { igl[i] = IDXG[(size_t)tok0 * 128 + i]; act[i] = 0.f; }
    __syncthreads();
    {
        const int g = lane >> 3, j = lane & 7;
        const int ib = ((lane >> 2) & 1) * 8 + ((lane >> 1) & 1) * 4 + (lane & 1) * 2;
        for (int s = 0; s < 4; ++s) {
            const unsigned char* Us = UQ + (size_t)s * SLICE_B + j * 16;
            for (int t = wave; t < per; t += 8) {
                const signed char* hp = H8 + (size_t)(tok0 + t) * 1024 + (s * 32 + j * 4) * 4;
                const v4i hH = *(const v4i*)hp, hL = *(const v4i*)(hp + 512);
                v4i d[16];
#pragma unroll
                for (int i = 0; i < 16; ++i) { const unsigned e = igl[t * 128 + i * 8 + g] & 0xffffu; d[i] = *(const v4i*)(Us + (size_t)e * 128); }
                int pp[16];
#pragma unroll
                for (int i = 0; i < 16; ++i) { int a1 = 0, a2 = 0;
#pragma unroll
                    for (int w = 0; w < 4; ++w) { a1 = __builtin_amdgcn_sdot8(d[i][w], hH[w], a1, false); a2 = __builtin_amdgcn_sdot8(d[i][w], hL[w], a2, false); }
                    pp[i] = a1 * 16 + a2; }
                int q8[8], q4_[4], q2[2];
                { const bool up = (lane & 4) != 0;
#pragma unroll
                  for (int m = 0; m < 8; ++m) { const int snd = up ? pp[m] : pp[m + 8], kp = up ? pp[m + 8] : pp[m]; q8[m] = kp + __shfl_xor(snd, 4); } }
                { const bool up = (lane & 2) != 0;
#pragma unroll
                  for (int m = 0; m < 4; ++m) { const int snd = up ? q8[m] : q8[m + 4], kp = up ? q8[m + 4] : q8[m]; q4_[m] = kp + __shfl_xor(snd, 2); } }
                { const bool up = (lane & 1) != 0;
#pragma unroll
                  for (int m = 0; m < 2; ++m) { const int snd = up ? q4_[m] : q4_[m + 2], kp = up ? q4_[m + 2] : q4_[m]; q2[m] = kp + __shfl_xor(snd, 1); } }
                LAS float* ap = act + t * 128 + ib * 8 + g;
                ap[0] += (float)q2[0]; ap[8] += (float)q2[1];
            }
        }
    }
    __syncthreads();
    for (int i = tid; i < per * 128; i += NTHR) { const unsigned ig = igl[i]; const float* hc = HSC + 2 * (size_t)(tok0 + (i >> 7)); const float* su = SU + 2 * (ig & 0xffffu); const float av = su[0] * hc[0] * (act[i] + su[1] + hc[1]);
        act[i] = bfhi(ig) * 0.5f * av * (1.f + erff(av * 0.70710678118654752f)); }
    const unsigned* GCM = GCMp;
    LAS unsigned short* igl16 = (LAS unsigned short*)lds;
    LAS signed char* wg8 = (LAS signed char*)(lds + 33792);
    if (WG) {
        unsigned short tmp[33];
#pragma unroll
        for (int k = 0; k < 33; ++k) { const int i = tid + k * NTHR; tmp[k] = (unsigned short)(i < per * 128 ? (igl[i] & 0xffffu) : 0u); }
        __syncthreads();
#pragma unroll
        for (int k = 0; k < 33; ++k) { const int i = tid + k * NTHR; if (i < per * 128) igl16[i] = tmp[k]; }
        for (int k = tid; k < 1024; k += NTHR) { const float* src = WG + (size_t)k * CD_IN;
#pragma unroll
            for (int c = 0; c < 4; ++c) { const v4f x = *(const v4f*)(src + 4 * c);
#pragma unroll
                for (int m = 0; m < 4; ++m) { const float inv = 127.f / fmaxf(__uint_as_float(GCM[4 * c + m]), 1e-30f); int q = __float2int_rn(x[m] * inv); q = q > 127 ? 127 : (q < -127 ? -127 : q); wg8[(4 * c + m) * 1024 + k] = (signed char)q; } } }
    }
    const bool fuse = (GATHER_FUSE != 0);
    LAS float* pga = (LAS float*)(lds + 135168); LAS float* pba = pga + 1024; LAS float* pmg = pba + 1024;
    LAS bf16_t* pset = (LAS bf16_t*)(lds + 135168 + 8192);
    LAS unsigned* fscr = (LAS unsigned*)(lds + 135168 + 20480) + wave * 64;
    const int mrA = row_mod(tok0), mrB = row_mod(tok0 + per - 1);
    if (fuse) {
        for (int i = tid; i < 1024; i += NTHR) { pga[i] = lng[i]; pba[i] = lnb[i]; }
        if (HAo) { for (int i = tid; i < 2048; i += NTHR) { const int sI = i >> 10, e = i & 1023, mr = sI ? mrB : mrA;
                       pset[sI * 3072 + e] = f2bf(modl[mr * 6144 + g_off + e]); pset[sI * 3072 + 1024 + e] = f2bf(modn[mr * 6144 + nsc_off + e]); pset[sI * 3072 + 2048 + e] = f2bf(modn[mr * 6144 + nsh_off + e]); } }
        else { const float* m = modl + mrA * 6144 + g_off; for (int i = tid; i < 1024; i += NTHR) pmg[i] = m[i]; }
    }
    __syncthreads();
    {
        const int g = lane >> 3, j = lane & 7;
        const int ebase = ((lane >> 5) & 1) * 8 + ((lane >> 4) & 1) * 4 + ((lane >> 3) & 1) * 2;
#ifndef GATHER_VREP
#define GATHER_VREP 1
#endif
        auto vissue = [&](int t, const unsigned char* Vs, v4i (&d)[16], float (&wv)[16]) {
#pragma unroll
                for (int i = 0; i < 16; ++i) { const int k = i * 8 + g; const unsigned e = WG ? (unsigned)igl16[t * 128 + k] : (igl[t * 128 + k] & 0xffffu); wv[i] = act[t * 128 + k]; d[i] = *(const v4i*)(Vs + (size_t)e * 128); } };
        auto vreduce = [&](const v4i (&d)[16], const float (&wv)[16]) -> v2f {
                v2f acc[8];
#pragma unroll
                for (int m = 0; m < 8; ++m) acc[m] = (v2f){0.f, 0.f};
#pragma unroll
                for (int i = 0; i < 16; ++i) { const v2f w2 = {wv[i], wv[i]};
#pragma unroll
                    for (int c = 0; c < 4; ++c) { acc[2 * c] += w2 * __builtin_amdgcn_cvt_pk_f32_fp8(d[i][c], false); acc[2 * c + 1] += w2 * __builtin_amdgcn_cvt_pk_f32_fp8(d[i][c], true); } }
                v2f b4[4], b2[2], b1;
                { const bool up = (lane & 32) != 0;
#pragma unroll
                  for (int m = 0; m < 4; ++m) { const v2f snd = up ? acc[m] : acc[m + 4], kp = up ? acc[m + 4] : acc[m]; b4[m] = (v2f){kp.x + __shfl_xor(snd.x, 32), kp.y + __shfl_xor(snd.y, 32)}; } }
                { const bool up = (lane & 16) != 0;
#pragma unroll
                  for (int m = 0; m < 2; ++m) { const v2f snd = up ? b4[m] : b4[m + 2], kp = up ? b4[m + 2] : b4[m]; b2[m] = (v2f){kp.x + __shfl_xor(snd.x, 16), kp.y + __shfl_xor(snd.y, 16)}; } }
                { const bool up = (lane & 8) != 0; const v2f snd = up ? b2[0] : b2[1], kp = up ? b2[1] : b2[0]; b1 = (v2f){kp.x + __shfl_xor(snd.x, 8), kp.y + __shfl_xor(snd.y, 8)}; }
                return b1; };
        const int nplain = fuse ? 7 : 8;
        for (int s = 0; s < nplain; ++s) {
            const unsigned char* Vs = VQ + (size_t)s * SLICE_B + j * 16;
            for (int t = wave; t < per; t += 8) {
                v4i d[16]; float wv[16]; vissue(t, Vs, d, wv);
                const v2f b1 = vreduce(d, wv);
                __builtin_nontemporal_store(pk2(b1.x, b1.y), (unsigned*)(F + (size_t)(tok0 + t) * 1024 + s * 128 + j * 16 + ebase));
            }
        }
        if (fuse) {
            const unsigned char* Vs = VQ + (size_t)7 * SLICE_B + j * 16;
            auto rowload = [&](int t, v4u (&xw)[2], v4u (&fw)[2]) { const int tok = tok0 + t;
                const bf16_t* xr = X1 + (size_t)tok * 1024 + lane * 8; const bf16_t* fr = F + (size_t)tok * 1024 + lane * 8;
                xw[0] = __builtin_nontemporal_load((const v4u*)xr); xw[1] = __builtin_nontemporal_load((const v4u*)(xr + 512)); fw[0] = __builtin_nontemporal_load((const v4u*)fr); fw[1] = __builtin_nontemporal_load((const v4u*)(fr + (lane < 48 ? 512 : 0))); };
            v4u xw[2], fw[2];
            auto finish = [&](int tok) {
                unsigned yq[4] = {0u, 0u, 0u, 0u}; float ysc = 0.f;
                if (lane >= 48) fw[1] = *(const LAS v4u*)(fscr + (lane - 48) * 4);
                const LAS bf16_t* psel = pset + (row_mod(tok) != mrA ? 3072 : 0);
                float v[16]; float sm = 0.f;
#pragma unroll
                for (int i = 0; i < 2; ++i) {
                    const v4f x0 = {bflo(xw[i].x), bfhi(xw[i].x), bflo(xw[i].y), bfhi(xw[i].y)}, x1 = {bflo(xw[i].z), bfhi(xw[i].z), bflo(xw[i].w), bfhi(xw[i].w)};
                    const v4f f0 = {bflo(fw[i].x), bfhi(fw[i].x), bflo(fw[i].y), bfhi(fw[i].y)}, f1 = {bflo(fw[i].z), bfhi(fw[i].z), bflo(fw[i].w), bfhi(fw[i].w)};
                    v4f g0, g1;
                    if (HAo) { const v4u gw = *(const LAS v4u*)(psel + i * 512 + lane * 8); g0 = (v4f){bflo(gw.x), bfhi(gw.x), bflo(gw.y), bfhi(gw.y)}; g1 = (v4f){bflo(gw.z), bfhi(gw.z), bflo(gw.w), bfhi(gw.w)}; }
                    else { g0 = *(const LAS v4f*)(pmg + i * 512 + lane * 8); g1 = *(const LAS v4f*)(pmg + i * 512 + lane * 8 + 4); }
#pragma unroll
                    for (int c = 0; c < 4; ++c) { v[i * 8 + c] = DN_ALPHA * x0[c] + g0[c] * f0[c]; v[i * 8 + 4 + c] = DN_ALPHA * x1[c] + g1[c] * f1[c]; } }
#pragma unroll
                for (int c = 0; c < 16; ++c) sm += v[c];
                const float mu = wave_sum(sm) * (1.f / 1024.f);
                float qq = 0.f;
#pragma unroll
                for (int c = 0; c < 16; ++c) { v[c] -= mu; qq += v[c] * v[c]; }
                const float rstd = rsqrtf(wave_sum(qq) * (1.f / 1024.f) + LN_EPS);
                TO* xo = XO + (size_t)tok * 1024 + lane * 8;
#pragma unroll
                for (int i = 0; i < 2; ++i) {
                    const v4f a0 = *(const LAS v4f*)(pga + i * 512 + lane * 8), a1 = *(const LAS v4f*)(pga + i * 512 + lane * 8 + 4), c0 = *(const LAS v4f*)(pba + i * 512 + lane * 8), c1 = *(const LAS v4f*)(pba + i * 512 + lane * 8 + 4);
                    v4f o0, o1;
#pragma unroll
                    for (int c = 0; c < 4; ++c) { o0[c] = v[i * 8 + c] * rstd * a0[c] + c0[c]; o1[c] = v[i * 8 + 4 + c] * rstd * a1[c] + c1[c]; }
                    st8nt(xo + i * 512, o0, o1);
                    if (HAo) { const v4u sw = *(const LAS v4u*)(psel + 1024 + i * 512 + lane * 8), hw = *(const LAS v4u*)(psel + 2048 + i * 512 + lane * 8);
                        const v4f s0 = {bflo(sw.x), bfhi(sw.x), bflo(sw.y), bfhi(sw.y)}, s1 = {bflo(sw.z), bfhi(sw.z), bflo(sw.w), bfhi(sw.w)}, h0 = {bflo(hw.x), bfhi(hw.x), bflo(hw.y), bfhi(hw.y)}, h1 = {bflo(hw.z), bfhi(hw.z), bflo(hw.w), bfhi(hw.w)};
                        const v4f y0 = o0 * (s0 + 1.f) + h0, y1 = o1 * (s1 + 1.f) + h1;
#pragma unroll
                        for (int c = 0; c < 4; ++c) { v[i * 8 + c] = y0[c]; v[i * 8 + 4 + c] = y1[c]; } }
                }
                if (HAo) {
                    float mx = 0.f;
#pragma unroll
                    for (int c = 0; c < 16; ++c) mx = fmaxf(mx, fabsf(v[c]));
                    mx = fmaxf(wave_max(mx), 1e-30f);
                    const float inv = 127.f / mx;
                    if (lane == 0) SA[tok] = mx * (1.f / 127.f);
                    ysc = mx * (1.f / 127.f);
#pragma unroll
                    for (int i = 0; i < 2; ++i) { v2u o; o.x = q8pack4(v[i * 8], v[i * 8 + 1], v[i * 8 + 2], v[i * 8 + 3], inv); o.y = q8pack4(v[i * 8 + 4], v[i * 8 + 5], v[i * 8 + 6], v[i * 8 + 7], inv);
                        yq[2 * i] = o.x; yq[2 * i + 1] = o.y;
                        *(v2u*)(HAo + (size_t)tok * 1024 + i * 512 + lane * 8) = o; }
                }
                if (WG) {
                    float pq[16];
#pragma unroll
                    for (int gi = 0; gi < 16; ++gi) { const v2u wl = *(const LAS v2u*)(wg8 + gi * 1024 + lane * 8), wh = *(const LAS v2u*)(wg8 + gi * 1024 + 512 + lane * 8);
                        int a = __builtin_amdgcn_sdot4((int)wl.x, (int)yq[0], 0, false); a = __builtin_amdgcn_sdot4((int)wl.y, (int)yq[1], a, false);
                        a = __builtin_amdgcn_sdot4((int)wh.x, (int)yq[2], a, false); a = __builtin_amdgcn_sdot4((int)wh.y, (int)yq[3], a, false);
                        pq[gi] = (float)a; }
                    float p8[8], p4[4], p2[2], p1;
                    { const bool up = (lane & 32) != 0;
#pragma unroll
                      for (int m = 0; m < 8; ++m) { const float snd = up ? pq[m] : pq[m + 8], kp = up ? pq[m + 8] : pq[m]; p8[m] = kp + __shfl_xor(snd, 32); } }
                    { const bool up = (lane & 16) != 0;
#pragma unroll
                      for (int m = 0; m < 4; ++m) { const float snd = up ? p8[m] : p8[m + 4], kp = up ? p8[m + 4] : p8[m]; p4[m] = kp + __shfl_xor(snd, 16); } }
                    { const bool up = (lane & 8) != 0;
#pragma unroll
                      for (int m = 0; m < 2; ++m) { const float snd = up ? p4[m] : p4[m + 2], kp = up ? p4[m + 2] : p4[m]; p2[m] = kp + __shfl_xor(snd, 8); } }
                    { const bool up = (lane & 4) != 0; const float snd = up ? p2[0] : p2[1], kp = up ? p2[1] : p2[0]; p1 = kp + __shfl_xor(snd, 4); }
                    p1 += __shfl_xor(p1, 2); p1 += __shfl_xor(p1, 1);
                    if ((lane & 3) == 0) GT[(size_t)tok * 16 + (lane >> 2)] = p1 * ysc * (__uint_as_float(GCM[lane >> 2]) * (1.f / 127.f));
                }
            };
            int prev = -1;
            for (int t = wave; t < per; t += 8) {
                v4i d[16]; float wv[16]; vissue(t, Vs, d, wv);
                asm volatile("" ::: "memory"); __builtin_amdgcn_sched_barrier(0);
                if (prev >= 0) finish(tok0 + prev);
                asm volatile("" ::: "memory"); __builtin_amdgcn_sched_barrier(0);
                rowload(t, xw, fw);
                asm volatile("" ::: "memory"); __builtin_amdgcn_sched_barrier(0);
                const v2f b1 = vreduce(d, wv);
                fscr[(j * 16 + ebase) >> 1] = pk2(b1.x, b1.y);
                prev = t;
            }
            if (prev >= 0) finish(tok0 + prev);
            return;
        }
    }
    asm volatile("s_waitcnt vmcnt(0)" ::: "memory");
    __syncthreads();
    LAS float* wgT = (LAS float*)lds;
    if (WG) { for (int k = tid; k < 1024; k += NTHR) { const float* src = WG + (size_t)k * CD_IN;
#pragma unroll
            for (int c = 0; c < 4; ++c) { const v4f x = *(const v4f*)(src + 4 * c); wgT[(4 * c) * 1024 + k] = x[0]; wgT[(4 * c + 1) * 1024 + k] = x[1]; wgT[(4 * c + 2) * 1024 + k] = x[2]; wgT[(4 * c + 3) * 1024 + k] = x[3]; } }
        __syncthreads(); }
    v4f ga[4], ba[4], mg[4], msc[4], msh[4];
#pragma unroll
    for (int i = 0; i < 2; ++i) { const int e0 = i * 512 + lane * 8; ga[2 * i] = *(const v4f*)(lng + e0); ga[2 * i + 1] = *(const v4f*)(lng + e0 + 4); ba[2 * i] = *(const v4f*)(lnb + e0); ba[2 * i + 1] = *(const v4f*)(lnb + e0 + 4);
        msc[2 * i] = msc[2 * i + 1] = msh[2 * i] = msh[2 * i + 1] = (v4f){0.f, 0.f, 0.f, 0.f}; }
    int cur_mod = -1;
    for (int t = wave; t < per; t += 8) {
        const int tok = tok0 + t;
        const int mr = row_mod(tok);
        if (mr != cur_mod) { cur_mod = mr; const float* m = modl + mr * 6144 + g_off;
#pragma unroll
            for (int i = 0; i < 2; ++i) { const int e0 = i * 512 + lane * 8; mg[2 * i] = *(const v4f*)(m + e0); mg[2 * i + 1] = *(const v4f*)(m + e0 + 4); }
            if (HAo) { const float* mn = modn + mr * 6144;
#pragma unroll
                for (int i = 0; i < 2; ++i) { const int e0 = i * 512 + lane * 8; msc[2 * i] = *(const v4f*)(mn + nsc_off + e0); msc[2 * i + 1] = *(const v4f*)(mn + nsc_off + e0 + 4); msh[2 * i] = *(const v4f*)(mn + nsh_off + e0); msh[2 * i + 1] = *(const v4f*)(mn + nsh_off + e0 + 4); } } }
        const bf16_t* xr = X1 + (size_t)tok * 1024 + lane * 8; const bf16_t* fr = F + (size_t)tok * 1024 + lane * 8;
        float v[16]; float s = 0.f;
#pragma unroll
        for (int i = 0; i < 2; ++i) {
            v4f x0, x1; ld8(xr + i * 512, x0, x1); const v4u fw = *(const v4u*)(fr + i * 512);
            const v4f f0 = {bflo(fw.x), bfhi(fw.x), bflo(fw.y), bfhi(fw.y)}, f1 = {bflo(fw.z), bfhi(fw.z), bflo(fw.w), bfhi(fw.w)};
#pragma unroll
            for (int c = 0; c < 4; ++c) { v[i * 8 + c] = DN_ALPHA * x0[c] + mg[2 * i][c] * f0[c]; v[i * 8 + 4 + c] = DN_ALPHA * x1[c] + mg[2 * i + 1][c] * f1[c]; } }
#pragma unroll
        for (int c = 0; c < 16; ++c) s += v[c];
        const float mu = wave_sum(s) * (1.f / 1024.f);
        float qq = 0.f;
#pragma unroll
        for (int c = 0; c < 16; ++c) { v[c] -= mu; qq += v[c] * v[c]; }
        const float rstd = rsqrtf(wave_sum(qq) * (1.f / 1024.f) + LN_EPS);
        TO* xo = XO + (size_t)tok * 1024 + lane * 8;
#pragma unroll
        for (int i = 0; i < 2; ++i) {
            v4f o0, o1;
#pragma unroll
            for (int c = 0; c < 4; ++c) { o0[c] = v[i * 8 + c] * rstd * ga[2 * i][c] + ba[2 * i][c]; o1[c] = v[i * 8 + 4 + c] * rstd * ga[2 * i + 1][c] + ba[2 * i + 1][c]; }
            st8(xo + i * 512, o0, o1);
            if (HAo) {
                const v4f y0 = o0 * (msc[2 * i] + 1.f) + msh[2 * i], y1 = o1 * (msc[2 * i + 1] + 1.f) + msh[2 * i + 1];
#pragma unroll
                for (int c = 0; c < 4; ++c) { v[i * 8 + c] = y0[c]; v[i * 8 + 4 + c] = y1[c]; } }
        }
        if (HAo) {
            float mx = 0.f;
#pragma unroll
            for (int c = 0; c < 16; ++c) mx = fmaxf(mx, fabsf(v[c]));
            mx = fmaxf(wave_max(mx), 1e-30f);
            const float inv = 127.f / mx;
            if (lane == 0) SA[tok] = mx * (1.f / 127.f);
#pragma unroll
            for (int i = 0; i < 2; ++i) { v2u o; o.x = q8pack4(v[i * 8], v[i * 8 + 1], v[i * 8 + 2], v[i * 8 + 3], inv); o.y = q8pack4(v[i * 8 + 4], v[i * 8 + 5], v[i * 8 + 6], v[i * 8 + 7], inv);
                *(v2u*)(HAo + (size_t)tok * 1024 + i * 512 + lane * 8) = o; }
        }
        if (WG) {
#pragma unroll 1
            for (int gq = 0; gq < 4; ++gq) {
                float gp[4];
#pragma unroll
                for (int m = 0; m < 4; ++m) { const LAS float* wr = wgT + (gq * 4 + m) * 1024 + lane * 8; float a = 0.f;
#pragma unroll
                    for (int i = 0; i < 2; ++i) { const v4f w0 = *(const LAS v4f*)(wr + i * 512), w1 = *(const LAS v4f*)(wr + i * 512 + 4);
#pragma unroll
                        for (int c = 0; c < 4; ++c) a += v[i * 8 + c] * w0[c] + v[i * 8 + 4 + c] * w1[c]; }
                    gp[m] = a; }
                float g2[2], g1;
                { const bool up = (lane & 32) != 0;
#pragma unroll
                  for (int m = 0; m < 2; ++m) { const float snd = up ? gp[m] : gp[m + 2], kp = up ? gp[m + 2] : gp[m]; g2[m] = kp + __shfl_xor(snd, 32); } }
                { const bool up = (lane & 16) != 0; const float snd = up ? g2[0] : g2[1], kp = up ? g2[1] : g2[0]; g1 = kp + __shfl_xor(snd, 16); }
                g1 += __shfl_xor(g1, 8); g1 += __shfl_xor(g1, 4); g1 += __shfl_xor(g1, 2); g1 += __shfl_xor(g1, 1);
                if ((lane & 15) == 0) GT[(size_t)tok * 16 + gq * 4 + ((lane >> 5) & 1) * 2 + ((lane >> 4) & 1)] = g1;
            }
        }
    }
}


__device__ __forceinline__ void ph_mixab(const bf16_t* Z, const float* conv_w, const float* conv_b, const float* cln_g, const float* cln_b, signed char* MIX8, float* SA,
                                         LAS unsigned char* lds, int tid, int lane, int wave, int vcu, int G) {
    LAS float* ybuf = (LAS float*)lds;
    LAS bf16_t* ul = (LAS bf16_t*)(lds + 32768);
    LAS bf16_t* zl = (LAS bf16_t*)(lds + 32768 + 47104);
    LAS float* pdl = (LAS float*)(lds + 32768 + 47104 + 32768);
    const int c = tid;
    float w[31];
#pragma unroll
    for (int k = 0; k < 31; ++k) w[k] = conv_w[k * 512 + c];
    const float cb = conv_b[c];
    const int pw = 1 << (c >> 7);
    for (int unit = vcu; unit < MT / 16; unit += G) {
        const int r0 = unit * 16, t0 = row_t(r0), T = row_T(r0);
        __syncthreads();
        for (int it = tid; it < 46 * 64; it += NTHR) { const int i = it >> 6, ch = it & 63, t = t0 - 15 + i; v4u o = {0u, 0u, 0u, 0u};
            if (t >= 0 && t < T) { const bf16_t* zr = Z + (size_t)(r0 - 15 + i) * AB_IN + 512 + ch * 8; const v4u av = *(const v4u*)zr, gv = *(const v4u*)(zr + 512);
#pragma unroll
                for (int e = 0; e < 4; ++e) o[e] = pk2(bflo(av[e]) * __builtin_amdgcn_rcpf(1.f + __expf(-bflo(gv[e]))), bfhi(av[e]) * __builtin_amdgcn_rcpf(1.f + __expf(-bfhi(gv[e])))); }
            *(LAS v4u*)(ul + i * 512 + ch * 8) = o; }
        for (int it = tid; it < 32 * 64; it += NTHR) { const int i = it >> 6, ch = it & 63, t = t0 - 8 + i; v4u o = {0u, 0u, 0u, 0u};
            if (t >= 0 && t < T) o = *(const v4u*)(Z + (size_t)(r0 - 8 + i) * AB_IN + ch * 8);
            *(LAS v4u*)(zl + i * 512 + ch * 8) = o; }
        __syncthreads();
        {
            float s = 0.f;
            for (int jj = 8 - pw; jj < 8 + pw; ++jj) s += bf2f(zl[jj * 512 + c]);
#pragma unroll
            for (int o = 0; o < 16; ++o) {
                const int t = t0 + o; const int lo = t - pw < 0 ? 0 : t - pw, hi = t + pw > T ? T : t + pw;
                pdl[o * 512 + c] = s * __builtin_amdgcn_rcpf((float)(hi - lo)) - bf2f(zl[(o + 8) * 512 + c]);
                s += bf2f(zl[(o + 8 + pw) * 512 + c]) - bf2f(zl[(o + 8 - pw) * 512 + c]);
            }
        }
        float win[31];
#pragma unroll
        for (int i = 0; i < 46; ++i) {
            win[i % 31] = bf2f(ul[i * 512 + c]);
            if (i >= 30) { const int o = i - 30; float y = cb;
#pragma unroll
                for (int k = 0; k < 31; ++k) y += w[k] * win[(o + k) % 31];
                ybuf[o * 512 + c] = y; }
        }
        __syncthreads();
#pragma unroll
        for (int rr = 0; rr < 2; ++rr) { const int o = wave * 2 + rr;
            const v4f y0 = *(const LAS v4f*)(ybuf + o * 512 + lane * 8), y1 = *(const LAS v4f*)(ybuf + o * 512 + lane * 8 + 4);
            float s = (y0[0] + y0[1]) + (y0[2] + y0[3]) + (y1[0] + y1[1]) + (y1[2] + y1[3]);
            const float mu = wave_sum(s) * (1.f / 512.f);
            const v4f d0 = y0 - mu, d1 = y1 - mu;
            float q = (d0[0] * d0[0] + d0[1] * d0[1]) + (d0[2] * d0[2] + d0[3] * d0[3]) + (d1[0] * d1[0] + d1[1] * d1[1]) + (d1[2] * d1[2] + d1[3] * d1[3]);
            const float rstd = rsqrtf(wave_sum(q) * (1.f / 512.f) + LN_EPS);
            const v4f g0 = *(const v4f*)(cln_g + lane * 8), g1 = *(const v4f*)(cln_g + lane * 8 + 4), b0 = *(const v4f*)(cln_b + lane * 8), b1 = *(const v4f*)(cln_b + lane * 8 + 4);
            float yn[8];
#pragma unroll
            for (int i = 0; i < 4; ++i) { yn[i] = d0[i] * rstd * g0[i] + b0[i]; yn[4 + i] = d1[i] * rstd * g1[i] + b1[i]; }
#pragma unroll
            for (int i = 0; i < 8; ++i) yn[i] = yn[i] * __builtin_amdgcn_rcpf(1.f + __expf(-yn[i]));
            const v4f p0 = *(const LAS v4f*)(pdl + o * 512 + lane * 8), p1 = *(const LAS v4f*)(pdl + o * 512 + lane * 8 + 4);
            float mx = fmaxf(fmaxf(fmaxf(fabsf(p0[0]), fabsf(p0[1])), fmaxf(fabsf(p0[2]), fabsf(p0[3]))), fmaxf(fmaxf(fabsf(p1[0]), fabsf(p1[1])), fmaxf(fabsf(p1[2]), fabsf(p1[3]))));
#pragma unroll
            for (int i = 0; i < 8; ++i) mx = fmaxf(mx, fabsf(yn[i]));
            mx = fmaxf(wave_max(mx), 1e-30f);
            const float inv = 127.f / mx;
            if (lane == 0) SA[r0 + o] = mx * (1.f / 127.f);
            v2u op, oy; op.x = q8pack4(p0[0], p0[1], p0[2], p0[3], inv); op.y = q8pack4(p1[0], p1[1], p1[2], p1[3], inv);
            oy.x = q8pack4(yn[0], yn[1], yn[2], yn[3], inv); oy.y = q8pack4(yn[4], yn[5], yn[6], yn[7], inv);
            *(v2u*)(MIX8 + (size_t)(r0 + o) * 1024 + lane * 8) = op; *(v2u*)(MIX8 + (size_t)(r0 + o) * 1024 + 512 + lane * 8) = oy; }
    }
}
struct LnRow { v4f x[4]; v4u y[2]; };
template <class TX>
__device__ __forceinline__ void ln1_load(LnRow& R, const TX* xl, const TX* xc, const bf16_t* Y, int r, int lane) {
    const TX* xr = r < ML ? xl + (size_t)r * D : xc + (size_t)(r - ML) * D;
#pragma unroll
    for (int i = 0; i < 2; ++i) { const int e0 = i * 512 + lane * 8; ld8(xr + e0, R.x[2 * i], R.x[2 * i + 1]); R.y[i] = *(const v4u*)(Y + (size_t)r * D + e0); }
}
template <class TX, class TO>
__device__ __forceinline__ void ph_ln1(const TX* xl, const TX* xc, const bf16_t* Y, const float* modl, int gate_off, const float* lng, const float* lnb,
                                       TO* XO, bf16_t* HAo, signed char* H8, float* HSC, int sh_off, int sc_off, int nrows, int lane, int wave, int vcu, int G, signed char* HA8o = nullptr, float* SAo = nullptr) {
    const int per = nrows / G, r0 = vcu * per;
    v4f ga[4], ba[4], mg[4], msc[4], msh[4];
#pragma unroll
    for (int i = 0; i < 2; ++i) { const int e0 = i * 512 + lane * 8; ga[2 * i] = *(const v4f*)(lng + e0); ga[2 * i + 1] = *(const v4f*)(lng + e0 + 4); ba[2 * i] = *(const v4f*)(lnb + e0); ba[2 * i + 1] = *(const v4f*)(lnb + e0 + 4); }
    int cur_mod = -1;
    LnRow A, B;
    if (wave < per) ln1_load(A, xl, xc, Y, r0 + wave, lane);
    for (int t = wave; t < per; t += 8) {
        const int r = r0 + t;
        if (t + 8 < per) ln1_load(B, xl, xc, Y, r + 8, lane);
        const int mr = row_mod(r);
        if (mr != cur_mod) { cur_mod = mr; const float* m = modl + mr * 6144;
#pragma unroll
            for (int i = 0; i < 2; ++i) { const int e0 = i * 512 + lane * 8;
                mg[2 * i] = *(const v4f*)(m + gate_off + e0); mg[2 * i + 1] = *(const v4f*)(m + gate_off + e0 + 4);
                msc[2 * i] = *(const v4f*)(m + sc_off + e0); msc[2 * i + 1] = *(const v4f*)(m + sc_off + e0 + 4);
                msh[2 * i] = *(const v4f*)(m + sh_off + e0); msh[2 * i + 1] = *(const v4f*)(m + sh_off + e0 + 4); } }
        float v[16], hq[16]; float s = 0.f;
#pragma unroll
        for (int i = 0; i < 2; ++i) { const v4u yy = A.y[i];
            const float yf[8] = {bflo(yy.x), bfhi(yy.x), bflo(yy.y), bfhi(yy.y), bflo(yy.z), bfhi(yy.z), bflo(yy.w), bfhi(yy.w)};
#pragma unroll
            for (int c = 0; c < 4; ++c) { v[i * 8 + c] = DN_ALPHA * A.x[2 * i][c] + mg[2 * i][c] * yf[c]; v[i * 8 + 4 + c] = DN_ALPHA * A.x[2 * i + 1][c] + mg[2 * i + 1][c] * yf[4 + c]; } }
#pragma unroll
        for (int c = 0; c < 16; ++c) s += v[c];
        const float mu = wave_sum(s) * (1.f / 1024.f);
        float qq = 0.f;
#pragma unroll
        for (int c = 0; c < 16; ++c) { v[c] -= mu; qq += v[c] * v[c]; }
        const float rstd = rsqrtf(wave_sum(qq) * (1.f / 1024.f) + LN_EPS);
#pragma unroll
        for (int i = 0; i < 2; ++i) { const int e0 = i * 512 + lane * 8;
            v4f o0, o1;
#pragma unroll
            for (int c = 0; c < 4; ++c) { o0[c] = v[i * 8 + c] * rstd * ga[2 * i][c] + ba[2 * i][c]; o1[c] = v[i * 8 + 4 + c] * rstd * ga[2 * i + 1][c] + ba[2 * i + 1][c]; }
            st8(XO + (size_t)r * 1024 + e0, o0, o1);
            const v4f y0 = o0 * (msc[2 * i] + 1.f) + msh[2 * i], y1 = o1 * (msc[2 * i + 1] + 1.f) + msh[2 * i + 1];
            if (!HA8o) st8(HAo + (size_t)r * 1024 + e0, y0, y1);
#pragma unroll
            for (int c = 0; c < 4; ++c) { hq[i * 8 + c] = y0[c]; hq[i * 8 + 4 + c] = y1[c]; } }
        float mx = 0.f;
#pragma unroll
        for (int c = 0; c < 16; ++c) mx = fmaxf(mx, fabsf(hq[c]));
        mx = fmaxf(wave_max(mx), 1e-30f);
        const float inv = 127.f / mx;
        int isum = 0;
#pragma unroll
        for (int i = 0; i < 2; ++i) { unsigned wh = 0u, wl = 0u; v2u wb = {0u, 0u};
#pragma unroll
            for (int c = 0; c < 8; ++c) { int qv = __float2int_rn(hq[i * 8 + c] * inv); qv = qv > 127 ? 127 : (qv < -127 ? -127 : qv); isum += qv;
                wb[c >> 2] |= (unsigned)(qv & 255) << (8 * (c & 3));
                const unsigned u = (unsigned)(qv + 128); const unsigned nh = ((u >> 4) - 8u) & 15u, nl = ((u & 15u) - 8u) & 15u;
                const int sh = (c & 3) * 8 + (c >> 2) * 4;
                wh |= nh << sh; wl |= nl << sh; }
            *(unsigned*)(H8 + (size_t)r * 1024 + (i * 64 + lane) * 4) = wh;
            if (HA8o) *(v2u*)(HA8o + (size_t)r * 1024 + i * 512 + lane * 8) = wb;
            *(unsigned*)(H8 + (size_t)r * 1024 + 512 + (i * 64 + lane) * 4) = wl; }
        const float hsum = wave_sum((float)isum), hsc = mx * (1.f / 127.f);
        if (lane == 0) { HSC[2 * r] = hsc; HSC[2 * r + 1] = 0.5f * hsum; if (SAo) SAo[r] = hsc; }
        A = B;
    }
}

namespace ml {
constexpr int LP = 272;
constexpr float KS = 0.08838834764831845f;
__device__ __forceinline__ int chunk_row0(int b, int c) { return c < 2 ? ML + b * CTX + c * 128 : b * SEQ + (c - 2) * 128; }
__device__ __forceinline__ float logsig(float x) { return fminf(x, 0.f) - log1pf(__expf(-fabsf(x))); }
__device__ __forceinline__ void load_T(const bf16_t* src  , LAS unsigned char* dst, int tid) {
    const int j0 = tid & 63, part = tid >> 6;
#pragma unroll
    for (int jj = 0; jj < 2; ++jj)
#pragma unroll
        for (int cc = 0; cc < 2; ++cc) { const int j = j0 + 64 * jj, ch = part * 2 + cc;
            const v4u d = *(const v4u*)(src + (size_t)j * ZZP + ch * 8);
#pragma unroll
            for (int e = 0; e < 4; ++e) { *(LAS bf16_t*)(dst + (ch * 8 + 2 * e) * LP + j * 2) = (bf16_t)(d[e] & 0xffffu); *(LAS bf16_t*)(dst + (ch * 8 + 2 * e + 1) * LP + j * 2) = (bf16_t)(d[e] >> 16); } }
}
__device__ __forceinline__ void load_R(const bf16_t* src, int ld, LAS unsigned char* dst, int tid) {
#pragma unroll
    for (int it = 0; it < 4; ++it) { const int i = tid + it * NTHR, r = i >> 4, ch = i & 15; *(LAS v4u*)(dst + r * LP + ch * 16) = *(const v4u*)(src + (size_t)r * ld + ch * 8); }
}
__device__ __forceinline__ void gate_scan(const float* GT, int row0, int h, int dir, const float* gate_b, int lane, LAS float* bvec, LAS float* avec, LAS float* Avec, float& Btot, float& Alast) {
    const float bi = gate_b[(dir * 2) * 4 + h], bfg = gate_b[(dir * 2 + 1) * 4 + h];
    const int p0 = dir ? 127 - 2 * lane : 2 * lane, p1 = dir ? 126 - 2 * lane : 2 * lane + 1;
    const float* z0 = GT + (size_t)(row0 + p0) * 16 + h; const float* z1 = GT + (size_t)(row0 + p1) * 16 + h;
    const float ig0 = z0[(dir * 2) * 4] + bi, ig1 = z1[(dir * 2) * 4] + bi;
    const float l0 = logsig(z0[(dir * 2 + 1) * 4] + bfg), l1 = logsig(z1[(dir * 2 + 1) * 4] + bfg);
    float inc = l0 + l1;
#pragma unroll
    for (int d = 1; d < 64; d <<= 1) { const float t = __shfl_up(inc, d); if (lane >= d) inc += t; }
    const float b1 = inc, b0 = inc - l1;
    const float a0 = ig0 - b0, a1 = ig1 - b1;
    float mx = fmaxf(a0, a1);
#pragma unroll
    for (int d = 1; d < 64; d <<= 1) { const float t = __shfl_up(mx, d); if (lane >= d) mx = fmaxf(mx, t); }
    float ex = __shfl_up(mx, 1); if (lane == 0) ex = -3.0e38f;
    const float A0 = fmaxf(ex, a0), A1 = mx;
    bvec[p0] = b0; bvec[p1] = b1; avec[p0] = a0; avec[p1] = a1; Avec[p0] = A0; Avec[p1] = A1;
    Btot = __shfl(b1, 63); Alast = __shfl(A1, 63);
}
}

__device__ __forceinline__ void ph_mla(const bf16_t* ZZ, const float* GT, const float* gate_b, bf16_t* DCT, float* DN, float* STAT, LAS unsigned char* lds, int tid, int lane, int wave, int vcu, int G) {
    LAS unsigned char* KT = lds; LAS unsigned char* VT = lds + 128 * ml::LP;
    LAS float* vec = (LAS float*)(lds + 272 * ml::LP);
    for (int i = tid; i < 16 * ml::LP / 4; i += NTHR) ((LAS unsigned*)(VT + 128 * ml::LP))[i] = (i < ml::LP / 4) ? 0x3F803F80u : 0u;
    const int n = lane & 15, q4 = lane >> 4;
    for (int unit = vcu; unit < NB * 4 * 66; unit += G) {
        const int c = unit % 66, h = (unit / 66) & 3, b = unit / (66 * 4);
        const int row0 = ml::chunk_row0(b, c);
        __syncthreads();
        ml::load_T(ZZ + (size_t)row0 * ZZP + 512 + h * 128, KT, tid);
        ml::load_T(ZZ + (size_t)row0 * ZZP + 1024 + h * 128, VT, tid);
        if (wave < 2) { const int dir = wave; LAS float* v = vec + dir * 512; float Bt, Al;
            ml::gate_scan(GT, row0, h, dir, gate_b, lane, v, v + 128, v + 256, Bt, Al);
            v[384 + 2 * lane] = __expf(v[128 + 2 * lane] - Al) * ml::KS; v[385 + 2 * lane] = __expf(v[129 + 2 * lane] - Al) * ml::KS;
            const int chain = (b * 4 + h) * 2 + dir; if (lane == 0) { STAT[(chain * 66 + c) * 2] = Bt; STAT[(chain * 66 + c) * 2 + 1] = Al; } }
        __syncthreads();
#pragma unroll
        for (int dir = 0; dir < 2; ++dir) {
            const LAS float* wk = vec + dir * 512 + 384;
            s16x8 bk[4];
#pragma unroll
            for (int ks = 0; ks < 4; ++ks) { const v4u d = *(const LAS v4u*)(KT + (wave * 16 + n) * ml::LP + ks * 64 + q4 * 16);
                const v4f w0 = *(const LAS v4f*)(wk + ks * 32 + q4 * 8), w1 = *(const LAS v4f*)(wk + ks * 32 + q4 * 8 + 4);
                v4u o; o.x = pk2(bflo(d.x) * w0[0], bfhi(d.x) * w0[1]); o.y = pk2(bflo(d.y) * w0[2], bfhi(d.y) * w0[3]); o.z = pk2(bflo(d.z) * w1[0], bfhi(d.z) * w1[1]); o.w = pk2(bflo(d.w) * w1[2], bfhi(d.w) * w1[3]);
                bk[ks] = __builtin_bit_cast(s16x8, o); }
            const int chain = (b * 4 + h) * 2 + dir;
            bf16_t* dct = DCT + (size_t)(chain * 66 + c) * 16384;
#pragma unroll
            for (int t = 0; t < 9; ++t) {
                pg8::f32x4 acc = {0.f, 0.f, 0.f, 0.f};
#pragma unroll
                for (int ks = 0; ks < 4; ++ks) { const s16x8 av = *(const LAS s16x8*)(VT + (t * 16 + n) * ml::LP + ks * 64 + q4 * 16); acc = __builtin_amdgcn_mfma_f32_16x16x32_bf16(av, bk[ks], acc, 0, 0, 0); }
                if (t < 8) {
#pragma unroll
                    for (int r = 0; r < 4; ++r) dct[(size_t)(t * 16 + q4 * 4 + r) * 128 + wave * 16 + n] = f2bf(acc[r]);
                } else if (q4 == 0) DN[(size_t)(chain * 66 + c) * 128 + wave * 16 + n] = acc[0];
            }
        }
    }
}

__device__ __forceinline__ void ph_mls(const bf16_t* DCT, const float* DN, const float* STAT, bf16_t* CTS, float* NS, float* MPREV, int gtid, int NGT) {
    for (int item = gtid; item < 32 * 2048 + 32 * 16; item += NGT) {
        const bool isn = item >= 32 * 2048;
        const int chain = isn ? (item - 32 * 2048) >> 4 : item >> 11, off = isn ? ((item - 32 * 2048) & 15) * 8 : (item & 2047) * 8, dir = chain & 1;
        float acc[8];
#pragma unroll
        for (int e = 0; e < 8; ++e) acc[e] = 0.f;
        float m = 0.f;
        for (int s = 0; s < 66; ++s) {
            const int c = dir ? (s < 2 ? 1 - s : 67 - s) : s;
            if (c >= 2) {
                const size_t ci = (size_t)chain * 64 + (c - 2);
                if (isn) { *(v4f*)(NS + ci * 128 + off) = (v4f){acc[0], acc[1], acc[2], acc[3]}; *(v4f*)(NS + ci * 128 + off + 4) = (v4f){acc[4], acc[5], acc[6], acc[7]}; if (off == 0) MPREV[ci] = m; }
                else { v4u o; o.x = pk2(acc[0], acc[1]); o.y = pk2(acc[2], acc[3]); o.z = pk2(acc[4], acc[5]); o.w = pk2(acc[6], acc[7]); *(v4u*)(CTS + ci * 16384 + off) = o; }
            }
            const size_t di = (size_t)chain * 66 + c;
            const float Bt = STAT[di * 2], Al = STAT[di * 2 + 1];
            const float M = fmaxf(m, Al), decay = __expf(m - M), scale = __expf(Al - M);
            float d[8];
            if (isn) { const v4f x0 = *(const v4f*)(DN + di * 128 + off), x1 = *(const v4f*)(DN + di * 128 + off + 4);
#pragma unroll
                for (int e = 0; e < 4; ++e) { d[e] = x0[e]; d[4 + e] = x1[e]; } }
            else { const v4u x = *(const v4u*)(DCT + di * 16384 + off);
#pragma unroll
                for (int e = 0; e < 4; ++e) { d[2 * e] = bflo(x[e]); d[2 * e + 1] = bfhi(x[e]); } }
#pragma unroll
            for (int e = 0; e < 8; ++e) acc[e] = decay * acc[e] + scale * d[e];
            m = Bt + M;
        }
    }
}

__device__ __forceinline__ void ph_mlo(const bf16_t* ZZ, const float* GT, const float* gate_b, const float* norm_g, const bf16_t* CTS, const float* NS, const float* MPREV, bf16_t* MIX,
                                       LAS unsigned char* lds, int tid, int lane, int wave, int vcu, int G) {
    LAS unsigned char* QL = lds; LAS unsigned char* KL = lds + 128 * ml::LP; LAS unsigned char* VT = lds + 256 * ml::LP; LAS unsigned char* CT = lds + 400 * ml::LP;
    LAS float* vec0 = (LAS float*)(lds + 544 * ml::LP);
    for (int i = tid; i < 16 * ml::LP / 4; i += NTHR) { ((LAS unsigned*)(VT + 128 * ml::LP))[i] = (i < ml::LP / 4) ? 0x3F803F80u : 0u; ((LAS unsigned*)(CT + 128 * ml::LP))[i] = 0u; }
    const int n = lane & 15, q4 = lane >> 4;
    for (int unit = vcu; unit < NB * 4 * 64; unit += G) {
        const int cl = unit & 63, h = (unit >> 6) & 3, b = unit >> 8;
        const int row0 = b * SEQ + cl * 128;
        __syncthreads();
        ml::load_R(ZZ + (size_t)row0 * ZZP + h * 128, ZZP, QL, tid);
        ml::load_R(ZZ + (size_t)row0 * ZZP + 512 + h * 128, ZZP, KL, tid);
        ml::load_T(ZZ + (size_t)row0 * ZZP + 1024 + h * 128, VT, tid);
        if (wave < 2) { const int dir = wave; LAS float* v = vec0 + dir * 768; float Bt, Al;
            ml::gate_scan(GT, row0, h, dir, gate_b, lane, v, v + 128, v + 256, Bt, Al);
            const float mp = MPREV[(size_t)((b * 4 + h) * 2 + dir) * 64 + cl];
#pragma unroll
            for (int e = 0; e < 2; ++e) { const int p = 2 * lane + e; const float M = fmaxf(mp, v[256 + p]); v[384 + p] = M; v[512 + p] = __expf(mp - M); v[640 + p] = __expf(-v[p] - M); } }
        pg8::f32x4 hs[8];
#pragma unroll
        for (int t = 0; t < 8; ++t) hs[t] = (pg8::f32x4){0.f, 0.f, 0.f, 0.f};
        float ngv[8];
#pragma unroll
        for (int t = 0; t < 8; ++t) ngv[t] = norm_g[h * 128 + t * 16 + n];
        bf16_t omv[4][8];
#pragma unroll
        for (int r = 0; r < 4; ++r)
#pragma unroll
            for (int t = 0; t < 8; ++t) omv[r][t] = ZZ[(size_t)(row0 + wave * 16 + q4 * 4 + r) * ZZP + 1536 + h * 128 + t * 16 + n];
#pragma unroll
        for (int dir = 0; dir < 2; ++dir) {
            const int chain = (b * 4 + h) * 2 + dir; const size_t ci = (size_t)chain * 64 + cl;
            if (dir) __syncthreads();
            ml::load_R(CTS + ci * 16384, 128, CT, tid);
            if (tid < 128) *(LAS bf16_t*)(CT + 128 * ml::LP + tid * 2) = f2bf(NS[ci * 128 + tid]);
            __syncthreads();
            const LAS float* vec = vec0 + dir * 768;
            s16x8 qf[4];
#pragma unroll
            for (int ks = 0; ks < 4; ++ks) qf[ks] = *(const LAS s16x8*)(QL + (wave * 16 + n) * ml::LP + ks * 64 + q4 * 16);
            const int i_row = wave * 16 + n; const float Mi = vec[384 + i_row];
            s16x8 pf[4];
#pragma unroll
            for (int T2 = 0; T2 < 4; ++T2) { unsigned pk[4];
#pragma unroll
                for (int hh = 0; hh < 2; ++hh) { const int T = T2 * 2 + hh;
                    pg8::f32x4 acc = {0.f, 0.f, 0.f, 0.f};
#pragma unroll
                    for (int ks = 0; ks < 4; ++ks) { const s16x8 kf = *(const LAS s16x8*)(KL + (T * 16 + n) * ml::LP + ks * 64 + q4 * 16); acc = __builtin_amdgcn_mfma_f32_16x16x32_bf16(kf, qf[ks], acc, 0, 0, 0); }
                    const v4f aj = *(const LAS v4f*)(vec + 128 + T * 16 + q4 * 4);
                    float pv[4];
#pragma unroll
                    for (int r = 0; r < 4; ++r) { const int j = T * 16 + q4 * 4 + r; const bool ok = dir ? (j >= i_row) : (j <= i_row); pv[r] = ok ? acc[r] * ml::KS * __expf(aj[r] - Mi) : 0.f; }
                    pk[hh * 2] = pk2(pv[0], pv[1]); pk[hh * 2 + 1] = pk2(pv[2], pv[3]); }
                pf[T2] = __builtin_bit_cast(s16x8, (v4u){pk[0], pk[1], pk[2], pk[3]}); }
            const v4f wi = *(const LAS v4f*)(vec + 512 + wave * 16 + q4 * 4), bd = *(const LAS v4f*)(vec + 640 + wave * 16 + q4 * 4);
            pg8::f32x4 o[9];
#pragma unroll
            for (int t = 0; t < 9; ++t) {
                pg8::f32x4 acc = {0.f, 0.f, 0.f, 0.f};
#pragma unroll
                for (int ks = 0; ks < 4; ++ks) { const s16x8 cf = *(const LAS s16x8*)(CT + (t * 16 + n) * ml::LP + ks * 64 + q4 * 16); acc = __builtin_amdgcn_mfma_f32_16x16x32_bf16(qf[ks], cf, acc, 0, 0, 0); }
                acc = acc * wi;
#pragma unroll
                for (int T2 = 0; T2 < 4; ++T2) { const v2u lo = *(const LAS v2u*)(VT + (t * 16 + n) * ml::LP + T2 * 64 + q4 * 8), hi = *(const LAS v2u*)(VT + (t * 16 + n) * ml::LP + T2 * 64 + 32 + q4 * 8);
                    const s16x8 vf = __builtin_bit_cast(s16x8, (v4u){lo.x, lo.y, hi.x, hi.y});
                    acc = __builtin_amdgcn_mfma_f32_16x16x32_bf16(pf[T2], vf, acc, 0, 0, 0); }
                o[t] = acc;
            }
#pragma unroll
            for (int r = 0; r < 4; ++r) { const float den = __shfl(o[8][r], lane & 48); const float rd = 1.f / fmaxf(fabsf(den), bd[r]);
#pragma unroll
                for (int t = 0; t < 8; ++t) hs[t][r] += o[t][r] * rd; }
        }
#pragma unroll
        for (int r = 0; r < 4; ++r) {
            float s = 0.f;
#pragma unroll
            for (int t = 0; t < 8; ++t) s += hs[t][r];
            s += __shfl_xor(s, 1); s += __shfl_xor(s, 2); s += __shfl_xor(s, 4); s += __shfl_xor(s, 8);
            const float mu = s * (1.f / 128.f); float qv = 0.f;
#pragma unroll
            for (int t = 0; t < 8; ++t) { const float d = hs[t][r] - mu; qv += d * d; }
            qv += __shfl_xor(qv, 1); qv += __shfl_xor(qv, 2); qv += __shfl_xor(qv, 4); qv += __shfl_xor(qv, 8);
            const float rstd = rsqrtf(qv * (1.f / 128.f) + LN_EPS);
            const int row = row0 + wave * 16 + q4 * 4 + r;
#pragma unroll
            for (int t = 0; t < 8; ++t) { const int dv = t * 16 + n; const float om = bf2f(omv[r][t]);
                MIX[(size_t)row * 1024 + h * 128 + dv] = f2bf((hs[t][r] - mu) * rstd * ngv[t] / (1.f + __expf(-om))); }
        }
    }
}


constexpr int N_PHASES = 18;
constexpr int CW_BAR = 1024;
constexpr int MISC_OFF = LDS_BYTES - 64;

struct Args { const float* in[26]; float* out; unsigned char* ws; int ph_lo, ph_hi, pad0, pad1; };

__global__ void __launch_bounds__(NTHR, 2) mk(Args a) {
    extern __shared__ __attribute__((aligned(16))) unsigned char lds_raw[];
    LAS unsigned char* lds = (LAS unsigned char*)lds_raw;
    const int tid = threadIdx.x, lane = tid & 63, wave = __builtin_amdgcn_readfirstlane(tid >> 6);
    const int G = gridDim.x, bx = blockIdx.x;
    const int vcu = (G % 8 == 0) ? (bx % 8) * (G / 8) + bx / 8 : bx;
    const int gw = vcu * NWAVES + wave, NGW = G * NWAVES;
    unsigned char* ws = a.ws;
    const float* mod = (const float*)(ws + WS_MOD);
    bf16_t* XS = (bf16_t*)(ws + WS_XS);   bf16_t* HA = (bf16_t*)(ws + WS_HA); signed char* HA8 = (signed char*)(ws + WS_HA); float* SA = (float*)(ws + WS_SA); const unsigned* CMX = (const unsigned*)(ws + WS_CTL) + CW_CMAX; bf16_t* ZB = (bf16_t*)(ws + WS_ZB);
    bf16_t* MIX = (bf16_t*)a.out;
    unsigned* IDXG = (unsigned*)(ws + WS_IDXG);
    const unsigned char* UQ = ws + WS_TAB; const unsigned char* VQ = ws + WS_TAB + TAB_VQ; const float* SU = (const float*)(ws + WS_SU);
    signed char* H8 = (signed char*)(ws + WS_ZB + 133 * MiB); float* HSC = (float*)(ws + WS_ZB + 170 * MiB); bf16_t* FB = (bf16_t*)(ws + WS_ZB); float* GT = (float*)((unsigned char*)a.out + 116 * MiB);
    bf16_t* QA = (bf16_t*)((unsigned char*)a.out + 66 * MiB); bf16_t* KA = (bf16_t*)((unsigned char*)a.out + 98 * MiB); bf16_t* VA = (bf16_t*)((unsigned char*)a.out + 107 * MiB);
    bf16_t* DCT = HA; bf16_t* CTS = (bf16_t*)(ws + WS_TAB);
    float* DN = (float*)(ws + WS_IDXG); float* STAT = (float*)(ws + WS_IDXG + 2 * MiB); float* NS = (float*)(ws + WS_IDXG + 3 * MiB); float* MPREV = (float*)(ws + WS_IDXG + 5 * MiB);

    const int lo = a.ph_lo, hi = a.ph_hi;
    const bool multi = (hi - lo) > 1;
    XcdBarrier bar; bar.bar = (unsigned*)(ws + WS_CTL) + CW_BAR; bar.x = 0; bar.st = nullptr;
    if (multi) {
        if (tid < 16) ((LAS unsigned*)(lds + MISC_OFF))[tid] = 0u;
        __syncthreads();
        bar = xcd_barrier_post((unsigned*)(ws + WS_CTL) + CW_BAR, (volatile LAS unsigned*)(lds + MISC_OFF));
    }
#ifndef GEMM_ALIGN
#define GEMM_ALIGN true
#endif
#ifndef GEMM_SP2
#define GEMM_SP2 true
#endif
#define GEMM_PHASE(Aptr, Wptr, Mrows, Ncols, Optr, ldc_, nvalid_) do { \
        pg8::Gemm g{(Aptr), (const bf16_t*)(Wptr), (Mrows), (Ncols), 1024}; EpiStore E{(Optr), (ldc_), (nvalid_)}; \
        pg8::StaticOrder S; S.init((Mrows), (Ncols), G, bx); \
        pg8::gemm_phase<EpiStore, pg8::StaticOrder, GEMM_ALIGN, GEMM_SP2>(lds, g, S, E); } while (0)

#ifndef PROBE_MASK
#define PROBE_MASK 0
#endif
#define GEMM8_PHASE(A8ptr, Wptr, Mrows, Ncols, Optr, ldc_, cm_) do { \
        pg8::Gemm g{(const bf16_t*)(A8ptr), (const bf16_t*)(Wptr), (Mrows), (Ncols), 512}; EpiStoreI8 E{(Optr), (ldc_), (Ncols), SA, CMX + (cm_)}; \
        pg8::StaticOrder S; S.init((Mrows), (Ncols), G, bx); \
        pg8::gemm_phase<EpiStoreI8, pg8::StaticOrder, GEMM_ALIGN, GEMM_SP2, true>(lds, g, S, E); } while (0)
#define IN(k) (lo <= (k) && (k) < hi)
#define REP(k) for (int rep_ = 0; rep_ < (((PROBE_MASK >> (k)) & 1) ? 2 : 1); ++rep_)
#ifndef BAR_REP
#define BAR_REP 1
#endif
#define SEAM(k) do { if (IN(k) && IN((k) + 1)) { for (int br_ = 0; br_ < BAR_REP; ++br_) xcd_barrier(bar); } } while (0)
    if (IN(0)) REP(0) { ph_prologue(a.in, ws, lds, tid, lane, wave, gw, NGW); } SEAM(0);
    if (IN(1)) REP(1) { ph_moda(a.in[0], a.in[2], mod, 0, 1024, HA8, SA, MT, lane, wave, vcu, G);
                 ph_w8(a.in, ws, lds, lane, wave, gw, NGW);
                 ph_tables(a.in, ws, 0, gw, NGW, lane); } SEAM(1);
    if (IN(2)) REP(2) { GEMM8_PHASE(HA8, ws + WS_W_IN, MT, AB_IN, ZB, AB_IN, CM_WIN); } SEAM(2);
    if (IN(3)) REP(3) { ph_mixab(ZB, a.in[11], a.in[12], a.in[13], a.in[14], (signed char*)a.out, SA, lds, tid, lane, wave, vcu, G); } SEAM(3);
    if (IN(4)) REP(4) { GEMM8_PHASE(a.out, ws + WS_W_OUT8, MT, 1024, ZB, 1024, CM_WOUT); } SEAM(4);
    if (IN(5)) REP(5) { ph_ln1<float, bf16_t>(a.in[0], a.in[2], ZB, mod, 2048, a.in[6], a.in[7], XS, HA, H8, HSC, 3072, 4096, MT, lane, wave, vcu, G, HA8, SA); } SEAM(5);
    if (IN(6)) REP(6) { GEMM8_PHASE(HA8, ws + WS_WQ, MT, 2048, ZB, 2048, CM_WQ0); } SEAM(6);
    if (IN(7)) REP(7) { ph_route(ZB, a.in[23], IDXG, MT, lds, tid, lane, wave, vcu, G); }
    if (IN(7) && IN(8)) { asm volatile("s_waitcnt vmcnt(0)" ::: "memory"); __syncthreads(); }
    if (IN(8)) REP(8) { ph_gather<bf16_t>(XS, H8, HSC, IDXG, UQ, SU, VQ, FB, mod, 5120, a.in[6] + 1024, a.in[7] + 1024, XS, HA8, SA, mod + 5 * 6144, 0, 1024, a.in[16] + 2048, CMX + CM_GATE, GT, MT, lds, tid, lane, wave, vcu, G); } SEAM(8);
    if (IN(9)) REP(9) { GEMM8_PHASE(HA8, ws + WS_CD_IN, MT, ZZP, ZB, ZZP, CM_CD); } SEAM(9);
    if (IN(10)) REP(10) { REP(18) ph_mla(ZB, GT, a.in[17], DCT, DN, STAT, lds, tid, lane, wave, vcu, G);
                  REP(19) ph_attn_prep(ZB, a.in[19], a.in[20], QA, KA, VA, gw, NGW, lane); } SEAM(10);
    if (IN(11)) REP(11) { REP(20) ph_mls(DCT, DN, STAT, CTS, NS, MPREV, vcu * NTHR + tid, G * NTHR);
                  const attn_body::AttnTensors AT{(const attn_body::bf16*)QA, (const attn_body::bf16*)KA, (const attn_body::bf16*)VA, (attn_body::bf16*)(MIX + 512)};
                  const attn_body::StaticOrder S(G, bx);
                  attn_body::attn_phase<attn_body::StaticOrder>((char*)lds_raw, AT, S); } SEAM(11);
    if (IN(12)) REP(12) { ph_mlo(ZB, GT, a.in[17], a.in[18], CTS, NS, MPREV, MIX, lds, tid, lane, wave, vcu, G); } SEAM(12);
    if (IN(13)) REP(13) { GEMM_PHASE(MIX, ws + WS_CD_OUT, ML, 1024, ZB, 1024, 1024); } SEAM(13);
    if (IN(14)) REP(14) { REP(22) ph_tables(a.in, ws, 1, gw, NGW, lane);
                  ph_ln1<bf16_t, bf16_t>(XS, XS + (size_t)ML * D, ZB, mod + 5 * 6144, 2048, a.in[6] + 2048, a.in[7] + 2048, XS, HA, H8, HSC, 3072, 4096, ML, lane, wave, vcu, G, HA8, SA); } SEAM(14);
    if (IN(15)) REP(15) { GEMM8_PHASE(HA8, ws + WS_WQ + (size_t)4 * MiB, ML, 2048, ZB, 2048, CM_WQ1); } SEAM(15);
    if (IN(16)) REP(16) { ph_route(ZB, a.in[23] + 2 * 128 * 128, IDXG, ML, lds, tid, lane, wave, vcu, G); }
    if (IN(16) && IN(17)) { asm volatile("s_waitcnt vmcnt(0)" ::: "memory"); __syncthreads(); }
    if (IN(17)) REP(17) { ph_gather<float>(XS, H8, HSC, IDXG, UQ, SU, VQ, FB, mod + 5 * 6144, 5120, a.in[6] + 3072, a.in[7] + 3072, a.out, nullptr, nullptr, nullptr, 0, 0, nullptr, nullptr, nullptr, ML, lds, tid, lane, wave, vcu, G); }
#undef IN
#undef SEAM
#undef GEMM_PHASE
#undef GEMM8_PHASE
}

extern "C" void kernel_launch(void* const* d_in, const int* in_sizes, int n_in, void* d_out, int out_size, void* d_ws, size_t ws_size, hipStream_t stream) {
    static int grid = 0;
    if (grid == 0) {
        if (n_in != 26 || out_size != ML * D || ws_size < WS_END) { fprintf(stderr, "kernel_launch: unexpected sizes n_in %d out %d ws %zu\n", n_in, out_size, ws_size); grid = -1; return; }
        int dev = 0, cus = 0, per_cu = 0;
        (void)hipGetDevice(&dev); (void)hipDeviceGetAttribute(&cus, hipDeviceAttributeMultiprocessorCount, dev);
        if (hipFuncSetAttribute((const void*)mk, hipFuncAttributeMaxDynamicSharedMemorySize, LDS_BYTES) != hipSuccess) { fprintf(stderr, "kernel_launch: hipFuncSetAttribute failed\n"); grid = -1; return; }
        (void)hipOccupancyMaxActiveBlocksPerMultiprocessor(&per_cu, (const void*)mk, NTHR, LDS_BYTES);
        (void)hipGetLastError();
        if (cus != 256) { fprintf(stderr, "kernel_launch: built for a 256-CU device, found %d CUs; nothing launched\n", cus); grid = -1; return; }
        if (per_cu < 1) { fprintf(stderr, "kernel_launch: occupancy query says %d blocks per CU\n", per_cu); }
        grid = cus * (per_cu < 1 ? 1 : 1);
    }
    if (grid < 0) return;
    if (hipMemsetAsync((char*)d_ws + WS_CTL, 0, CTL_ZERO_BYTES, stream) != hipSuccess) { fprintf(stderr, "kernel_launch: memset failed\n"); return; }
    Args a{}; for (int i = 0; i < 26; ++i) a.in[i] = (const float*)d_in[i]; a.out = (float*)d_out; a.ws = (unsigned char*)d_ws;
#if defined(MK_PER_PHASE)
    for (int p = 0; p < N_PHASES; ++p) { a.ph_lo = p; a.ph_hi = p + 1; hipLaunchKernelGGL(mk, dim3(grid), dim3(NTHR), LDS_BYTES, stream, a); }
#else
    a.ph_lo = 0; a.ph_hi = N_PHASES;
    void* args[] = {&a};
    hipError_t e = hipLaunchCooperativeKernel((const void*)mk, dim3(grid), dim3(NTHR), args, LDS_BYTES, stream);
    if (e != hipSuccess) fprintf(stderr, "kernel_launch: cooperative launch failed: %s (grid %d)\n", hipGetErrorString(e), grid);
#endif
}
```

```cpp
#include <hip/hip_runtime.h>
#include <stdint.h>
#include <stdio.h>

constexpr int D = 1024, NB = 4, SEQ = 8192, CTX = 256;
constexpr int ML = NB * SEQ;
constexpr int MC = NB * CTX;
constexpr int MT = ML + MC;
constexpr int TK = CTX + SEQ;
constexpr float DN_ALPHA = 1.4142135623730951f;
constexpr float LN_EPS = 1e-5f, RMS_EPS = 1e-6f;
constexpr int AB_IN = 1536, CD_IN = 2832;
constexpr int ZZP = 2816;

#define GAS __attribute__((address_space(1)))
#define LAS __attribute__((address_space(3)))
typedef unsigned short bf16_t;
__device__ __forceinline__ float bf2f(bf16_t v) { return __uint_as_float(((unsigned)v) << 16); }
__device__ __forceinline__ bf16_t f2bf(float f) { unsigned u = __float_as_uint(f); return (bf16_t)((u + 0x7fffu + ((u >> 16) & 1u)) >> 16); }

__device__ __forceinline__ int row_b(int r) { return r < ML ? (r >> 13) : ((r - ML) >> 8); }
__device__ __forceinline__ int row_t(int r) { return r < ML ? (r & 8191) : ((r - ML) & 255); }
__device__ __forceinline__ int row_T(int r) { return r < ML ? SEQ : CTX; }
__device__ __forceinline__ int row_mod(int r) { return r < ML ? (r >> 13) : 4; }


namespace pg8 {
#define PG8_LAS __attribute__((address_space(3)))
typedef unsigned short bf16_t;
typedef short bf16x8 __attribute__((ext_vector_type(8)));
typedef float f32x4 __attribute__((ext_vector_type(4)));
typedef int i32x4 __attribute__((ext_vector_type(4)));
template <bool I8> struct AccSel { typedef f32x4 T; };
template <> struct AccSel<true> { typedef i32x4 T; };
typedef unsigned u32x4 __attribute__((ext_vector_type(4)));
constexpr int BM = 256, BK = 64, HALF = 128, HTB = HALF * BK * 2  , STAGE_BYTES = 8 * HTB, NXCD = 8, WGM = 8;

__host__ __device__ __forceinline__ int lds_byte(int r, int c) { const int st = (r >> 4) * 2 + (c >> 5), rr = r & 15, cc = c & 31, ob = rr * 64 + cc * 2; return st * 1024 + (ob ^ (((ob >> 9) & 1) << 5)); }
__host__ __device__ __forceinline__ void stage_rc(int b, int& R, int& C) { const int st = b / 1024, sb = b % 1024, swz = sb ^ (((sb >> 9) & 1) << 5); R = (st >> 1) * 16 + swz / 64; C = (st & 1) * 32 + (swz % 64) / 2; }
__host__ __device__ __forceinline__ int perm32(int rho) { const int n = rho >> 4, i = rho & 15; return 8 * (i >> 2) + 4 * n + (i & 3); }

struct Unit { int pm, pn; };
struct Gemm { const bf16_t* A; const bf16_t* Bt; int M, N, K; };

struct StaticOrder {
    int nM, nN, nwg, G, c;
    __host__ __device__ void init(int M, int N, int G_, int c_) { nM = M / BM; nN = N / BM; nwg = nM * nN; G = G_; c = c_; }
    __host__ __device__ bool next(int i, Unit& u) const {
        const long L = (long)i * G + c; if (L >= nwg) return false;
        int wgid = (int)L; { const int q = nwg / NXCD, r = nwg % NXCD, xcd = wgid % NXCD, off = wgid / NXCD; wgid = (xcd < r ? xcd * (q + 1) : r * (q + 1) + (xcd - r) * q) + off; }
        const int nig = WGM * nN, gid = wgid / nig, fm = gid * WGM, gsz = (nM - fm) < WGM ? (nM - fm) : WGM;
        u.pm = fm + ((wgid % nig) % gsz); u.pn = (wgid % nig) / gsz; return true;
    }
    __device__ __forceinline__ void a_ready(const Unit&) const {}
    __device__ __forceinline__ void done(const Unit&) const {}
};
__device__ __forceinline__ unsigned cvt_pk_bf16(float lo, float hi) { unsigned r; asm volatile("v_cvt_pk_bf16_f32 %0, %1, %2" : "=v"(r) : "v"(lo), "v"(hi)); return r; }
typedef float f32x2 __attribute__((ext_vector_type(2)));
template <class Epi, class Sched, bool ALIGN_EPI = false, bool SP2 = false, bool I8 = false>
__device__ __forceinline__ void gemm_phase(PG8_LAS unsigned char* lds, const Gemm g, const Sched& S, const Epi& E) {
    const int tid = threadIdx.x, wid = __builtin_amdgcn_readfirstlane(tid >> 6), lane = tid & 63, wr = wid >> 2, wc = wid & 3, fr = lane & 15, fq = lane >> 4;
    const int K = g.K, nt = K / BK;
    unsigned voffA[2], voffB[2];
#pragma unroll
    for (int i = 0; i < 2; ++i) { int R, C; stage_rc(tid * 16 + i * 8192, R, C); const int Rb = Epi::PERM ? ((R & ~31) + perm32(R & 31)) : R;
        voffA[i] = (unsigned)(R * K + C) * 2u; voffB[i] = (unsigned)(Rb * K + C) * 2u; }
    const size_t kstep = (size_t)(BK * 2);
    const size_t hstep = (size_t)HALF * K * 2;
    const size_t tstep = 2 * hstep;
    const unsigned ldsw = (unsigned)wid * 1024u;
    const int aoff = lds_byte(wr * 64 + fr, fq * 8), boff = lds_byte(wc * 32 + fr, fq * 8);
#define PG8_SA(b, h) (((b) * 2 + (h)) * HTB)
#define PG8_SB(b, h) ((4 + (b) * 2 + (h)) * HTB)
#define PG8_STAGE(bufoff, gbase, voff) do { _Pragma("unroll") for (int _i = 0; _i < 2; ++_i) \
        __builtin_amdgcn_global_load_lds((const unsigned*)((const char*)(gbase) + (voff)[_i]), (PG8_LAS unsigned*)(lds + (bufoff) + ldsw + _i * 8192), 16, 0, 0); } while (0)
#define PG8_LDA(dst, b, h) do { _Pragma("unroll") for (int m = 0; m < 4; ++m) _Pragma("unroll") for (int k = 0; k < 2; ++k) dst[m][k] = *(const PG8_LAS bf16x8*)(lds + PG8_SA(b, h) + aoff + m * 2048 + k * 1024); } while (0)
#define PG8_LDB(dst, b, h) do { _Pragma("unroll") for (int n = 0; n < 2; ++n) _Pragma("unroll") for (int k = 0; k < 2; ++k) dst[n][k] = *(const PG8_LAS bf16x8*)(lds + PG8_SB(b, h) + boff + n * 2048 + k * 1024); } while (0)
#define PG8_MMA(ai, bj, At, Bt) do { __builtin_amdgcn_s_setprio(1); _Pragma("unroll") for (int m = 0; m < 4; ++m) _Pragma("unroll") for (int n = 0; n < 2; ++n) _Pragma("unroll") for (int k = 0; k < 2; ++k) \
        { if constexpr (I8) acc[ai][bj][m][n] = __builtin_amdgcn_mfma_i32_16x16x64_i8(__builtin_bit_cast(i32x4, Bt[n][k]), __builtin_bit_cast(i32x4, At[m][k]), acc[ai][bj][m][n], 0, 0, 0); \
          else acc[ai][bj][m][n] = __builtin_amdgcn_mfma_f32_16x16x32_bf16(Bt[n][k], At[m][k], acc[ai][bj][m][n], 0, 0, 0); } __builtin_amdgcn_s_setprio(0); } while (0)
#define PG8_WAIT_V(n) asm volatile("s_waitcnt vmcnt(" #n ")" ::: "memory")
#define PG8_WAIT_L(n) asm volatile("s_waitcnt lgkmcnt(" #n ")" ::: "memory")
#define PG8_BAR __builtin_amdgcn_s_barrier()
#define PG8_SCHED __builtin_amdgcn_sched_barrier(0)
    Unit cur, nxt; int ui = 0;
    if (!S.next(0, cur)) return;
    typedef typename AccSel<I8>::T AccT;
    AccT acc[2][2][4][2];
#pragma unroll
    for (int a = 0; a < 2; ++a)
#pragma unroll
        for (int b = 0; b < 2; ++b)
#pragma unroll
            for (int m = 0; m < 4; ++m)
#pragma unroll
                for (int n = 0; n < 2; ++n) acc[a][b][m][n] = AccT{};
    bf16x8 At[4][2], B0[2][2], B1[2][2];
    const char* cA = (const char*)g.A + (size_t)cur.pm * tstep; const char* cB = (const char*)g.Bt + (size_t)cur.pn * tstep;
    S.a_ready(cur);
    if constexpr (SP2) {
        PG8_STAGE(PG8_SB(0, 0), cB, voffB); PG8_STAGE(PG8_SB(0, 1), cB + hstep, voffB); PG8_STAGE(PG8_SA(0, 0), cA, voffA); PG8_STAGE(PG8_SA(0, 1), cA + hstep, voffA);
        if (wr == 1) PG8_BAR;
        PG8_WAIT_V(2); PG8_BAR;
        PG8_STAGE(PG8_SB(1, 0), cB + kstep, voffB); PG8_STAGE(PG8_SA(1, 0), cA + kstep, voffA); PG8_STAGE(PG8_SB(1, 1), cB + hstep + kstep, voffB);
        PG8_WAIT_V(6); PG8_BAR;
    } else {
        PG8_STAGE(PG8_SB(0, 0), cB, voffB); PG8_STAGE(PG8_SA(0, 0), cA, voffA); PG8_STAGE(PG8_SB(0, 1), cB + hstep, voffB); PG8_STAGE(PG8_SA(0, 1), cA + hstep, voffA);
        if (wr == 1) PG8_BAR;
        PG8_WAIT_V(4); PG8_BAR;
        PG8_STAGE(PG8_SB(1, 0), cB + kstep, voffB); PG8_STAGE(PG8_SA(1, 0), cA + kstep, voffA); PG8_STAGE(PG8_SB(1, 1), cB + hstep + kstep, voffB);
        PG8_WAIT_V(6); PG8_BAR;
    }
    for (;;) {
        const bool has_next = S.next(ui + 1, nxt);
        const char* nA = has_next ? (const char*)g.A + (size_t)nxt.pm * tstep : cA; const char* nB = has_next ? (const char*)g.Bt + (size_t)nxt.pn * tstep : cB;
        for (int t = 0; t < nt; t += 2) {
            const bool last = (t == nt - 2);
            const char* a1 = cA + (size_t)(t + 1) * kstep;
            const char* a2 = last ? nA : cA + (size_t)(t + 2) * kstep; const char* b2 = last ? nB : cB + (size_t)(t + 2) * kstep;
            const char* a3 = a2 + kstep; const char* b3 = b2 + kstep;
            if (last && has_next) S.a_ready(nxt);
            if constexpr (SP2) {
            PG8_LDB(B0, 0, 0); PG8_LDB(B1, 0, 1); PG8_SCHED; PG8_LDA(At, 0, 0); PG8_STAGE(PG8_SA(1, 1), a1 + hstep, voffA);
            PG8_WAIT_V(8); PG8_WAIT_L(0); PG8_BAR; PG8_MMA(0, 0, At, B0); PG8_MMA(0, 1, At, B1); PG8_BAR; PG8_SCHED;
            PG8_LDA(At, 0, 1); PG8_STAGE(PG8_SB(0, 0), b2, voffB); PG8_STAGE(PG8_SB(0, 1), b2 + hstep, voffB); PG8_STAGE(PG8_SA(0, 0), a2, voffA);
            PG8_WAIT_V(8); PG8_WAIT_L(0); PG8_BAR; PG8_MMA(1, 0, At, B0); PG8_MMA(1, 1, At, B1); PG8_BAR; PG8_SCHED;
            PG8_LDB(B0, 1, 0); PG8_LDB(B1, 1, 1); PG8_SCHED; PG8_LDA(At, 1, 0); PG8_STAGE(PG8_SA(0, 1), a2 + hstep, voffA);
            PG8_WAIT_V(8); PG8_WAIT_L(0); PG8_BAR; PG8_MMA(0, 0, At, B0); PG8_MMA(0, 1, At, B1); PG8_BAR; PG8_SCHED;
            PG8_LDA(At, 1, 1); PG8_STAGE(PG8_SB(1, 0), b3, voffB); PG8_STAGE(PG8_SB(1, 1), b3 + hstep, voffB); PG8_STAGE(PG8_SA(1, 0), a3, voffA);
            PG8_WAIT_V(8); PG8_WAIT_L(0); PG8_BAR; PG8_MMA(1, 0, At, B0); PG8_MMA(1, 1, At, B1); PG8_BAR; PG8_SCHED;
            } else {
            PG8_LDB(B0, 0, 0); PG8_SCHED; PG8_LDA(At, 0, 0); PG8_STAGE(PG8_SA(1, 1), a1 + hstep, voffA);
            PG8_WAIT_L(8); PG8_BAR; PG8_WAIT_L(0); PG8_MMA(0, 0, At, B0); PG8_BAR; PG8_SCHED;
            PG8_LDB(B1, 0, 1); PG8_STAGE(PG8_SB(0, 0), b2, voffB);
            PG8_BAR; PG8_WAIT_L(0); PG8_MMA(0, 1, At, B1); PG8_BAR;
            PG8_LDA(At, 0, 1); PG8_STAGE(PG8_SA(0, 0), a2, voffA);
            PG8_BAR; PG8_WAIT_L(0); PG8_MMA(1, 0, At, B0); PG8_BAR; PG8_SCHED;
            PG8_STAGE(PG8_SB(0, 1), b2 + hstep, voffB);
            PG8_WAIT_V(6); PG8_BAR; PG8_MMA(1, 1, At, B1); PG8_BAR;
            PG8_LDB(B0, 1, 0); PG8_SCHED; PG8_LDA(At, 1, 0); PG8_STAGE(PG8_SA(0, 1), a2 + hstep, voffA);
            PG8_WAIT_L(8); PG8_BAR; PG8_WAIT_L(0); PG8_MMA(0, 0, At, B0); PG8_BAR; PG8_SCHED;
            PG8_LDB(B1, 1, 1); PG8_STAGE(PG8_SB(1, 0), b3, voffB);
            PG8_BAR; PG8_WAIT_L(0); PG8_MMA(0, 1, At, B1); PG8_BAR;
            PG8_LDA(At, 1, 1); PG8_STAGE(PG8_SA(1, 0), a3, voffA);
            PG8_BAR; PG8_WAIT_L(0); PG8_MMA(1, 0, At, B0); PG8_BAR; PG8_SCHED;
            PG8_STAGE(PG8_SB(1, 1), b3 + hstep, voffB);
            PG8_WAIT_V(6); PG8_BAR; PG8_MMA(1, 1, At, B1); PG8_BAR;
            }
        }
        if constexpr (ALIGN_EPI) { if (wr == 0) PG8_BAR; }
        if constexpr (!Epi::AFTER_DRAIN) { E(acc, cur, wr, wc, fr, fq); S.done(cur); }
        if (!has_next) break;
#pragma unroll
        for (int a = 0; a < 2; ++a)
#pragma unroll
            for (int b = 0; b < 2; ++b)
#pragma unroll
                for (int m = 0; m < 4; ++m)
#pragma unroll
                    for (int n = 0; n < 2; ++n) acc[a][b][m][n] = AccT{};
        cur = nxt; cA = nA; cB = nB; ++ui;
        if constexpr (ALIGN_EPI) { if (wr == 1) PG8_BAR; }
    }
    PG8_WAIT_V(0);
    if constexpr (!ALIGN_EPI) { if (wr == 0) PG8_BAR; }
    PG8_BAR;
    if constexpr (Epi::AFTER_DRAIN) { E.fused(acc, cur, wr, wc, fr, fq, lds, wid, lane); S.done(cur); }
#undef PG8_SA
#undef PG8_SB
#undef PG8_STAGE
#undef PG8_LDA
#undef PG8_LDB
#undef PG8_MMA
#undef PG8_WAIT_V
#undef PG8_WAIT_L
#undef PG8_BAR
#undef PG8_SCHED
}
}

#include <hip/hip_bf16.h>
#include <cmath>
namespace attn_body {
using bf16=__hip_bfloat16;
using bf16x8=__attribute__((ext_vector_type(8)))short;
using s16x4=__attribute__((ext_vector_type(4)))short;
using f32x16=__attribute__((ext_vector_type(16)))float;
using u32x4=__attribute__((ext_vector_type(4)))unsigned;
constexpr int D=64, QP=512, KP=128, OP=1024, SEQ=8192, TKV=8448;
constexpr int NW=8,QBLK=32,QB=QBLK*NW,KVBLK=64,NQB=SEQ/QB;
constexpr int ATTN_UNIT_ROWS=QB;
__device__ __forceinline__ int crow(int r,int hi){return (r&3)+8*(r>>2)+4*hi;}
#define SBAR() __builtin_amdgcn_sched_barrier(0)
__device__ __forceinline__ void cmask(f32x16&p0,f32x16&p1,int jb,int qrel,int hi){
  const float NEG=-INFINITY; int kb=64*jb+4*hi;
  #pragma unroll
  for(int r=0;r<16;++r){int kv=kb+(r&3)+8*(r>>2); if(kv>qrel)p0[r]=NEG; if(kv+32>qrel)p1[r]=NEG;}
}

constexpr int NSLOT=3, SLOTB=8192;
constexpr int LDS_K=0, LDS_V=NSLOT*SLOTB, LDS_WS=2*NSLOT*SLOTB, LDS_OST=LDS_WS+NW*64*4, LDS_BYTES=LDS_OST+NW*4096;
constexpr float C2=0.125f*1.4426950408889634f;
__device__ __forceinline__ void glds16(const void*gsrc,unsigned lds_dst){unsigned keep;
  asm volatile("s_mov_b32 %0, m0\n\ts_mov_b32 m0, %2\n\ts_nop 0\n\tglobal_load_lds_dwordx4 %1, off\n\ts_mov_b32 m0, %0":"=&s"(keep):"v"(gsrc),"s"(lds_dst):"memory");}
__device__ __forceinline__ float max3f(float a,float b,float c){float r;asm("v_max3_f32 %0, %1, %2, %3":"=v"(r):"v"(a),"v"(b),"v"(c));return r;}
__device__ __forceinline__ float max2f(float a,float b){float r;asm("v_max_f32_e32 %0, %1, %2":"=v"(r):"v"(a),"v"(b));return r;}
__device__ __forceinline__ float fadd_s(float a,float b){float r;asm("v_add_f32_e32 %0, %1, %2":"=v"(r):"v"(a),"v"(b));return r;}
__device__ __forceinline__ float fsub_s(float a,float b){float r;asm("v_sub_f32_e32 %0, %1, %2":"=v"(r):"v"(a),"v"(b));return r;}
typedef float f32x2_t __attribute__((ext_vector_type(2))); typedef __bf16 bf16x2_t __attribute__((ext_vector_type(2)));
__device__ __forceinline__ unsigned cvtpk_s(float lo,float hi){f32x2_t v={lo,hi};bf16x2_t b=__builtin_convertvector(v,bf16x2_t);return __builtin_bit_cast(unsigned,b);}
#define WAIT_BAR(N) asm volatile("s_waitcnt vmcnt(" #N ") lgkmcnt(0)\n\ts_barrier":::"memory")

__device__ __forceinline__ void qkt(f32x16&p0,f32x16&p1,const char*Kslot,const bf16x8*qr,const f32x16&negm,int r32,int hi){
  const char*kb=Kslot+hi*1024+r32*16;
  #pragma unroll
  for(int d0=0;d0<4;++d0){
    const bf16x8 b0=*reinterpret_cast<const bf16x8*>(kb+d0*2048);
    const bf16x8 b1=*reinterpret_cast<const bf16x8*>(kb+d0*2048+512);
    if(d0==0){p0=__builtin_amdgcn_mfma_f32_32x32x16_bf16(b0,qr[0],negm,0,0,0);p1=__builtin_amdgcn_mfma_f32_32x32x16_bf16(b1,qr[0],negm,0,0,0);}
    else{p0=__builtin_amdgcn_mfma_f32_32x32x16_bf16(b0,qr[d0],p0,0,0,0);p1=__builtin_amdgcn_mfma_f32_32x32x16_bf16(b1,qr[d0],p1,0,0,0);}}
}
typedef __attribute__((address_space(3))) const char* lds_cptr;
typedef short v4i16_t __attribute__((ext_vector_type(4)));
__device__ __forceinline__ void kload8(bf16x8*kf,lds_cptr kp){
  kf[0]=*(const __attribute__((address_space(3))) bf16x8*)(kp);      kf[1]=*(const __attribute__((address_space(3))) bf16x8*)(kp+512);
  kf[2]=*(const __attribute__((address_space(3))) bf16x8*)(kp+2048); kf[3]=*(const __attribute__((address_space(3))) bf16x8*)(kp+2560);
  kf[4]=*(const __attribute__((address_space(3))) bf16x8*)(kp+4096); kf[5]=*(const __attribute__((address_space(3))) bf16x8*)(kp+4608);
  kf[6]=*(const __attribute__((address_space(3))) bf16x8*)(kp+6144); kf[7]=*(const __attribute__((address_space(3))) bf16x8*)(kp+6656);
}
__device__ __forceinline__ void kload2(bf16x8*kf,lds_cptr kp,int j){ kf[2*j]=*(const __attribute__((address_space(3))) bf16x8*)(kp+j*2048); kf[2*j+1]=*(const __attribute__((address_space(3))) bf16x8*)(kp+j*2048+512); }
__device__ __forceinline__ s16x4 vtr(lds_cptr p){ return __builtin_bit_cast(s16x4,__builtin_amdgcn_ds_read_tr16_b64_v4i16((__attribute__((address_space(3))) v4i16_t*)p)); }
__device__ __forceinline__ float rowmax(const f32x16&p0,const f32x16&p1){
  float a=max3f(p0[0],p0[1],p1[0]),b=max3f(p0[2],p0[3],p1[1]);a=max3f(a,p1[2],p1[3]);
  #pragma unroll
  for(int r=4;r<16;r+=4){a=max3f(a,p0[r],p0[r+1]);b=max3f(b,p0[r+2],p0[r+3]);a=max3f(a,p1[r],p1[r+1]);b=max3f(b,p1[r+2],p1[r+3]);}
  const float m=max2f(a,b);
  auto rr=__builtin_amdgcn_permlane32_swap(__float_as_uint(m),__float_as_uint(m),false,false);
  return max2f(__uint_as_float(rr[0]),__uint_as_float(rr[1]));
}
__device__ __forceinline__ void pv(f32x16*o,int vb,bf16x8 pa0,bf16x8 pa1,bf16x8 pa2,bf16x8 pa3){
  #pragma unroll
  for(int d0=0;d0<2;++d0){s16x4 lo[4],hi[4];
    #pragma unroll
    for(int ks=0;ks<4;++ks){
      asm volatile("ds_read_b64_tr_b16 %0,%1 offset:%c2":"=&v"(lo[ks]):"v"(vb),"i"(d0*4096+ks*1024):"memory");
      asm volatile("ds_read_b64_tr_b16 %0,%1 offset:%c2":"=&v"(hi[ks]):"v"(vb),"i"(d0*4096+ks*1024+512):"memory");}
    asm volatile("s_waitcnt lgkmcnt(0)":::"memory");SBAR();
    #define PK(k) (bf16x8){lo[k][0],lo[k][1],lo[k][2],lo[k][3],hi[k][0],hi[k][1],hi[k][2],hi[k][3]}
    o[d0]=__builtin_amdgcn_mfma_f32_32x32x16_bf16(pa0,PK(0),o[d0],0,0,0);
    o[d0]=__builtin_amdgcn_mfma_f32_32x32x16_bf16(pa1,PK(1),o[d0],0,0,0);
    o[d0]=__builtin_amdgcn_mfma_f32_32x32x16_bf16(pa2,PK(2),o[d0],0,0,0);
    o[d0]=__builtin_amdgcn_mfma_f32_32x32x16_bf16(pa3,PK(3),o[d0],0,0,0);
    #undef PK
  }
}

#ifndef ATTN_STORE16
#define ATTN_STORE16(p,v) (*(u32x4*)(p)=(v))
#endif
template<int THRL> __device__ __forceinline__ void attn_unit(int b,int h,int qb,const bf16*Q,const bf16*__restrict__ K,const bf16*__restrict__ V,bf16*O,char*shm){
  const int tid=threadIdx.x,lane=tid&63,r32=lane&31,hi=lane>>5; const int wid=__builtin_amdgcn_readfirstlane(tid>>6);
  const long rowbase=(long)b*SEQ, kvbase=(long)b*TKV; const int q0=qb*QB, kvh=h>>2;
  const bf16*Qw=Q+(rowbase+q0+wid*QBLK)*QP+h*D;
  const bf16*Kh=K+kvbase*KP+kvh*D,*Vh=V+kvbase*KP+kvh*D;
  const unsigned lds0=(unsigned)(uintptr_t)shm;
  float*wsf=(float*)(shm+LDS_WS)+wid*64;
  const bf16*ksrc=Kh+(long)lane*KP+wid*8;
  const bf16*vsrc=Vh+(long)(16*(wid&3)+(lane>>2))*KP+(wid>>2)*32+(lane&3)*8;
  const unsigned kdst=lds0+LDS_K+wid*1024, vdst=lds0+LDS_V+wid*1024;
  #define DMA_K(t,slot) glds16(ksrc+(long)(t)*KVBLK*KP,(unsigned)__builtin_amdgcn_readfirstlane(kdst+(slot)))
  #define DMA_V(t,slot) glds16(vsrc+(long)(t)*KVBLK*KP,(unsigned)__builtin_amdgcn_readfirstlane(vdst+(slot)))
  const int vb0=(int)(lds0+LDS_V)+((lane>>4)&1)*32+(lane&3)*8+(4*hi+((lane&15)>>2))*64;
  const char*Kbase=shm+LDS_K; bf16x8 kf[8];
  const lds_cptr shm3=(lds_cptr)shm; const lds_cptr kp0=shm3+LDS_K+hi*1024+r32*16; const lds_cptr vp0=shm3+LDS_V+((lane>>4)&1)*32+(lane&3)*8+(4*hi+((lane&15)>>2))*64;
  const int NT=TKV/KVBLK;
  DMA_K(0,0);DMA_V(0,0);DMA_K(1,SLOTB);
  bf16x8 qr[4];
  #pragma unroll
  for(int d0=0;d0<4;++d0)qr[d0]=*reinterpret_cast<const bf16x8*>(&Qw[(long)r32*QP+d0*16+hi*8]);
  float mhat=0.f,l_reg=0.f;f32x16 o[2];o[0]=f32x16{};o[1]=f32x16{};f32x16 negm=f32x16{};asm volatile("":"+v"(negm));
  const int qrel=wid*QBLK+r32;
  #define CMASK(P0,P1,t) do{}while(0)
  bool resc=false;
  #define START(P0,P1) do{ const float rm=rowmax(P0,P1); resc=false; \
    { const float dl=rm; mhat=fadd_s(mhat,dl); \
      _Pragma("unroll") for(int r=0;r<16;++r){P0[r]=fsub_s(P0[r],dl);P1[r]=fsub_s(P1[r],dl);} \
      _Pragma("unroll") for(int r=0;r<16;++r)negm[r]=-mhat; asm volatile("":"+v"(negm)); } \
    _Pragma("unroll") for(int r=0;r<16;++r)P0[r]=__builtin_amdgcn_exp2f(P0[r]); }while(0)
  #define RESC() do{ if(resc){ asm volatile("s_waitcnt lgkmcnt(0)":::"memory"); \
      _Pragma("unroll") for(int d_=0;d_<2;++d_) _Pragma("unroll") for(int r=0;r<16;++r)o[d_][r]*=wsf[crow(r,hi)]; } }while(0)
  f32x16 pA0,pA1,pB0,pB1;
  int sl_prev=0,sl_cur=0,sl_next=SLOTB;
  #define ROT() do{sl_prev=sl_cur;sl_cur=sl_next;sl_next=(sl_next==(NSLOT-1)*SLOTB)?0:sl_next+SLOTB;}while(0)
  DMA_K(2,2*SLOTB);
  WAIT_BAR(3);
  qkt(pA0,pA1,Kbase,qr,negm,r32,hi);asm volatile("s_nop 15\n\ts_nop 7":"+v"(pA0),"+v"(pA1));CMASK(pA0,pA1,0);
  START(pA0,pA1);
  _Pragma("unroll") for(int r=0;r<16;++r)pA1[r]=__builtin_amdgcn_exp2f(pA1[r]);
  WAIT_BAR(0);
  DMA_K(3,0);DMA_V(1,SLOTB);
  ROT();
  kload8(kf,kp0+sl_cur);
  WAIT_BAR(2);
  s16x4 vlo[8],vhi[8]; u32x4 pw0,pw1,pw2,pw3;
  #define PKW(P,B) cvtpk_s(P[B],P[B+1])
  #define PAF(k) __builtin_bit_cast(bf16x8,pw##k)
  #define VFR(i) (bf16x8){vlo[i][0],vlo[i][1],vlo[i][2],vlo[i][3],vhi[i][0],vhi[i][1],vhi[i][2],vhi[i][3]}
  #define PIN(x) asm volatile("":"+v"(x))
  #define MX3(a,b,c) __builtin_fmaxf(__builtin_fmaxf((a),(b)),(c))
  #define GAPA(MF,A0,A1,A2,A3,W0,W1,PW) do{ MF; sacc+=A0; sacc+=A1; sacc+=A2; sacc+=A3; PIN(sacc); W0; W1; PIN(PW); SBAR(); }while(0)
  #define EX(v) __builtin_amdgcn_exp2f(v)
  #define GAPB(MF,X,B) do{ MF; X[B]=EX(X[B]); X[B+1]=EX(X[B+1]); X[B+2]=EX(X[B+2]); X[B+3]=EX(X[B+3]); PIN(X); SBAR(); }while(0)
  #define VRD(i) do{ vlo[i]=vtr(vp_+(((i)>>2)*4096+((i)&3)*1024)); vhi[i]=vtr(vp_+(((i)>>2)*4096+((i)&3)*1024+512)); }while(0)
  #define KRD(G,j) do{ if(G){ kload2(kf,kp0+sl_next,j); SBAR(); } }while(0)
  #define STEP(C0,C1,P0,P1,t,GK,GV,GL) do{ SBAR(); \
    const lds_cptr vp_=vp0+sl_prev; \
    VRD(0); SBAR(); float sacc=(P0[0]+P0[1]); \
    GAPA(C0=__builtin_amdgcn_mfma_f32_32x32x16_bf16(kf[0],qr[0],negm,0,0,0), P0[2],P0[3],P0[4],P0[5],     pw0[0]=PKW(P0,0), pw0[1]=PKW(P0,2), pw0); \
    VRD(4); SBAR(); GAPA(C1=__builtin_amdgcn_mfma_f32_32x32x16_bf16(kf[1],qr[0],negm,0,0,0), P0[6],P0[7],P0[8],P0[9],     pw0[2]=PKW(P0,4), pw0[3]=PKW(P0,6), pw0); \
    VRD(1); SBAR(); GAPA(C0=__builtin_amdgcn_mfma_f32_32x32x16_bf16(kf[2],qr[1],C0,0,0,0),   P0[10],P0[11],P0[12],P0[13], pw1[0]=PKW(P0,8), pw1[1]=PKW(P0,10), pw1); \
    VRD(5); SBAR(); GAPA(C1=__builtin_amdgcn_mfma_f32_32x32x16_bf16(kf[3],qr[1],C1,0,0,0),   P0[14],P0[15],P1[0],P1[1],   pw1[2]=PKW(P0,12),pw1[3]=PKW(P0,14), pw1); \
    VRD(2); SBAR(); GAPA(C0=__builtin_amdgcn_mfma_f32_32x32x16_bf16(kf[4],qr[2],C0,0,0,0),   P1[2],P1[3],P1[4],P1[5],     pw2[0]=PKW(P1,0), pw2[1]=PKW(P1,2), pw2); \
    VRD(6); SBAR(); GAPA(C1=__builtin_amdgcn_mfma_f32_32x32x16_bf16(kf[5],qr[2],C1,0,0,0),   P1[6],P1[7],P1[8],P1[9],     pw2[2]=PKW(P1,4), pw2[3]=PKW(P1,6), pw2); \
    VRD(3); SBAR(); GAPA(C0=__builtin_amdgcn_mfma_f32_32x32x16_bf16(kf[6],qr[3],C0,0,0,0),   P1[10],P1[11],P1[12],P1[13], pw3[0]=PKW(P1,8), pw3[1]=PKW(P1,10), pw3); \
    VRD(7); SBAR(); GAPA(C1=__builtin_amdgcn_mfma_f32_32x32x16_bf16(kf[7],qr[3],C1,0,0,0),   P1[14],P1[15],0.f,0.f,       pw3[2]=PKW(P1,12),pw3[3]=PKW(P1,14), pw3); \
    l_reg+=sacc; \
    if(GK){DMA_K((t)+3,sl_cur);} if(GV){DMA_V((t)+1,sl_next);} \
    CMASK(C0,C1,t); \
    { float a=MX3(C0[0],C0[1],C1[0]),b=MX3(C0[2],C0[3],C1[1]); a=MX3(a,C1[2],C1[3]); \
      _Pragma("unroll") for(int r=4;r<16;r+=4){a=MX3(a,C0[r],C0[r+1]);b=MX3(b,C0[r+2],C0[r+3]);a=MX3(a,C1[r],C1[r+1]);b=MX3(b,C1[r+2],C1[r+3]);} \
      float rm=__builtin_fmaxf(a,b); { auto rr=__builtin_amdgcn_permlane32_swap(__float_as_uint(rm),__float_as_uint(rm),false,false); rm=__builtin_fmaxf(__uint_as_float(rr[0]),__uint_as_float(rr[1])); } \
      resc=false; \
      if(__builtin_expect(__any(rm>(float)THRL),0)){ const float dl=__builtin_fmaxf(rm,0.f); mhat+=dl; \
        _Pragma("unroll") for(int r=0;r<16;++r){C0[r]-=dl;C1[r]-=dl;} \
        _Pragma("unroll") for(int r=0;r<16;++r)negm[r]=-mhat; asm volatile("":"+v"(negm)); \
        const float f=__builtin_amdgcn_exp2f(-dl); l_reg*=f; if(hi==0)wsf[r32]=f; resc=true; } } \
    SBAR(); \
    GAPB(o[0]=__builtin_amdgcn_mfma_f32_32x32x16_bf16(PAF(0),VFR(0),o[0],0,0,0), C0,0); \
    GAPB(o[1]=__builtin_amdgcn_mfma_f32_32x32x16_bf16(PAF(0),VFR(4),o[1],0,0,0), C0,4); \
    KRD(GL,0); GAPB(o[0]=__builtin_amdgcn_mfma_f32_32x32x16_bf16(PAF(1),VFR(1),o[0],0,0,0), C0,8); \
    KRD(GL,1); GAPB(o[1]=__builtin_amdgcn_mfma_f32_32x32x16_bf16(PAF(1),VFR(5),o[1],0,0,0), C0,12); \
    KRD(GL,2); GAPB(o[0]=__builtin_amdgcn_mfma_f32_32x32x16_bf16(PAF(2),VFR(2),o[0],0,0,0), C1,0); \
    KRD(GL,3); GAPB(o[1]=__builtin_amdgcn_mfma_f32_32x32x16_bf16(PAF(2),VFR(6),o[1],0,0,0), C1,4); \
    GAPB(o[0]=__builtin_amdgcn_mfma_f32_32x32x16_bf16(PAF(3),VFR(3),o[0],0,0,0), C1,8); \
    GAPB(o[1]=__builtin_amdgcn_mfma_f32_32x32x16_bf16(PAF(3),VFR(7),o[1],0,0,0), C1,12); \
    }while(0)
  int t=1;
  #undef CMASK
  #define CMASK(P0,P1,t) do{}while(0)
  for(;t+5<NT;t+=2){
    STEP(pB0,pB1,pA0,pA1,t,true,true,true);     WAIT_BAR(2); RESC(); ROT();
    STEP(pA0,pA1,pB0,pB1,t+1,true,true,true);   WAIT_BAR(2); RESC(); ROT();
  }
  #undef CMASK
  #define CMASK(P0,P1,t) do{}while(0)
  #define ENDW(tt) do{ if((tt)+3<NT){WAIT_BAR(2);} else if((tt)+2<NT){WAIT_BAR(1);} else {WAIT_BAR(0);} }while(0)
  for(;t+1<NT;t+=2){
    STEP(pB0,pB1,pA0,pA1,t,(t+3<NT),(t+1<NT),(t+1<NT));       ENDW(t);   RESC(); ROT();
    STEP(pA0,pA1,pB0,pB1,t+1,(t+4<NT),(t+2<NT),(t+2<NT));     ENDW(t+1); RESC(); ROT();
  }
  STEP(pB0,pB1,pA0,pA1,NT-1,false,false,false); RESC();
  { float sacc=pB0[0]+pB0[1]; _Pragma("unroll") for(int r=2;r<16;++r)sacc+=pB0[r]; _Pragma("unroll") for(int r=0;r<16;++r)sacc+=pB1[r]; l_reg+=sacc;
    pw0=(u32x4){PKW(pB0,0),PKW(pB0,2),PKW(pB0,4),PKW(pB0,6)};pw1=(u32x4){PKW(pB0,8),PKW(pB0,10),PKW(pB0,12),PKW(pB0,14)};pw2=(u32x4){PKW(pB1,0),PKW(pB1,2),PKW(pB1,4),PKW(pB1,6)};pw3=(u32x4){PKW(pB1,8),PKW(pB1,10),PKW(pB1,12),PKW(pB1,14)};
    SBAR(); pv(o,vb0+sl_cur,PAF(0),PAF(1),PAF(2),PAF(3)); }
  #undef PKW
  #undef PAF
  #undef VFR
  #undef PIN
  #undef MX3
  #undef GAPA
  #undef GAPB
  #undef EX
  #undef VRD
  #undef KRD
  #undef STEP
  #undef ENDW
  {auto rr=__builtin_amdgcn_permlane32_swap(__float_as_uint(l_reg),__float_as_uint(l_reg),false,false);l_reg=__uint_as_float(rr[0])+__uint_as_float(rr[1]);}
  if(hi==0)wsf[32+r32]=l_reg;asm volatile("s_waitcnt lgkmcnt(0)":::"memory");
  float rli[16];
  #pragma unroll
  for(int r=0;r<16;++r)rli[r]=__builtin_amdgcn_rcpf(wsf[32+crow(r,hi)]);
  bf16*Ow=O+(rowbase+q0+wid*QBLK)*OP+h*D;
  { bf16*stg=(bf16*)(shm+LDS_OST)+wid*2048;
    #pragma unroll
    for(int r=0;r<16;++r){const int orow=crow(r,hi);
      #pragma unroll
      for(int d0=0;d0<2;++d0)stg[orow*64+d0*32+r32]=__float2bfloat16(o[d0][r]*rli[r]);}
    asm volatile("s_waitcnt lgkmcnt(0)":::"memory");
    #pragma unroll
    for(int i=0;i<4;++i){const int row=i*8+(lane>>3),ch=lane&7; const u32x4 v=*(const u32x4*)(stg+row*64+ch*8); ATTN_STORE16(Ow+(long)row*OP+ch*8,v);} }
  asm volatile("s_waitcnt lgkmcnt(0)\n\ts_barrier":::"memory");
  #undef DMA_K
  #undef DMA_V
  #undef CMASK
  #undef START
  #undef RESC
  #undef ROT
}
constexpr int ATTN_LDS_BYTES=LDS_BYTES;
struct AttnTensors { const bf16* Q; const bf16* K; const bf16* V; bf16* O; };
struct AttnUnit { int b; int h; int qb; };
struct StaticOrder {
  int vcu, G;
  __device__ __forceinline__ explicit StaticOrder(int grid,int block):vcu((grid%8==0)?(block%8)*(grid/8)+block/8:block),G(grid){}
  __device__ __forceinline__ bool next(int i,AttnUnit&u)const{
    if(G==256){ if(i>=4)return false; const int g=vcu>>5; u.b=g>>1; u.h=(g&1)*4+i; u.qb=vcu&31; return true; }
    const int id=i*G+vcu; if(id>=1024)return false; const int g=id>>7, r=id&127; u.b=g>>1; u.h=(g&1)*4+(r&3); u.qb=r>>2; return true; }
  __device__ __forceinline__ void a_ready(const AttnUnit&)const{}
  __device__ __forceinline__ void done(const AttnUnit&)const{}
};
template<class Sched,int THRL=8> __device__ __forceinline__ void attn_phase(char*lds,const AttnTensors&T,const Sched&S){
  AttnUnit u;
  for(int i=0;S.next(i,u);++i){ S.a_ready(u); attn_unit<THRL>(u.b,u.h,u.qb,T.Q,T.K,T.V,T.O,lds); S.done(u); }
}
#undef SBAR
#undef WAIT_BAR
}

#define XB_TMO      128
#define XB_XCNT(j)  (256  + 64 * (j))
#define XB_XSUB(j)  (1280 + 64 * (j))
#define XB_XGEN(j)  (2304 + 64 * (j))
#define XB_TOP      3328
#define XB_TOPGEN   3392
#define XCD_BAR_WORDS 3456
#define XB_SPIN_CAP (1u << 18)

__device__ __forceinline__ unsigned xb_ld(unsigned* p)              { return __hip_atomic_load(p, __ATOMIC_RELAXED, __HIP_MEMORY_SCOPE_AGENT); }
__device__ __forceinline__ unsigned xb_add(unsigned* p, unsigned v) { return __hip_atomic_fetch_add(p, v, __ATOMIC_RELAXED, __HIP_MEMORY_SCOPE_AGENT); }
__device__ __forceinline__ unsigned xb_xcc_id() { return (unsigned)__builtin_amdgcn_s_getreg((3 << 11) | 20) & 0xFu; }
#define XB_SPIN(cond, bar) do { unsigned _sp = 0; while (cond) { __builtin_amdgcn_s_sleep(1); \
    if ((++_sp & 255u) == 0u) { if (xb_ld(&(bar)[XB_TMO])) break; if (_sp > XB_SPIN_CAP) { atomicAdd(&(bar)[XB_TMO], 1u); break; } } } } while (0)

struct XcdBarrier {
    unsigned* bar; unsigned x;
    volatile LAS unsigned* st;
};

__device__ __forceinline__ XcdBarrier xcd_barrier_post(unsigned* bar, volatile LAS unsigned* st) {
    XcdBarrier b; b.bar = bar; b.x = xb_xcc_id(); b.st = st;
    if (threadIdx.x == 0) (void)xb_add(&bar[XB_XCNT(b.x)], 1u);
    return b;
}
__device__ __forceinline__ void xcd_barrier_complete(unsigned* bar, unsigned x, unsigned& nloc, unsigned& nx) {
    const unsigned G = gridDim.x * gridDim.y * gridDim.z;
    unsigned sum, cnt, mine, sp = 0u;
    for (;;) {
        sum = 0u; cnt = 0u; mine = 0u;
#pragma unroll
        for (unsigned j = 0; j < 16; ++j) { const unsigned c = xb_ld(&bar[XB_XCNT(j)]); sum += c; cnt += (c > 0u) ? 1u : 0u; mine = (j == x) ? c : mine; }
        if (sum == G) break;
        __builtin_amdgcn_s_sleep(1);
        if ((++sp & 255u) == 0u) { if (xb_ld(&bar[XB_TMO])) break; if (sp > XB_SPIN_CAP) { atomicAdd(&bar[XB_TMO], 1u); break; } }
    }
    nloc = mine > 0u ? mine : 1u; nx = cnt > 0u ? cnt : 1u;
}

__device__ __forceinline__ void xcd_barrier(const XcdBarrier& b) {
    asm volatile("s_waitcnt vmcnt(0)" ::: "memory");
    __syncthreads();
    if (threadIdx.x == 0) {
        unsigned* bar = b.bar;
        __builtin_amdgcn_s_waitcnt(0);
        unsigned nloc = b.st[0], nx = b.st[1];
        if (nloc == 0u) { xcd_barrier_complete(bar, b.x, nloc, nx); b.st[0] = nloc; b.st[1] = nx; }
        const unsigned old = xb_add(&bar[XB_XSUB(b.x)], 1u);
        const unsigned gen = old / nloc;
        if (old + 1u == (gen + 1u) * nloc) {
            __builtin_amdgcn_fence(__ATOMIC_RELEASE, "agent");
            asm volatile("s_waitcnt vmcnt(0)" ::: "memory");
            const unsigned og = xb_add(&bar[XB_TOP], 1u);
            const unsigned tg = og / nx;
            if (og + 1u == (tg + 1u) * nx) xb_add(&bar[XB_TOPGEN], 1u);
            else XB_SPIN(xb_ld(&bar[XB_TOPGEN]) == tg, bar);
            __builtin_amdgcn_fence(__ATOMIC_ACQUIRE, "agent");
            xb_add(&bar[XB_XGEN(b.x)], 1u);
            asm volatile("s_waitcnt vmcnt(0)" ::: "memory");
        } else {
            XB_SPIN(xb_ld(&bar[XB_XGEN(b.x)]) == gen, bar);
            __builtin_amdgcn_fence(__ATOMIC_ACQUIRE, "agent");
            asm volatile("s_waitcnt vmcnt(0)" ::: "memory");
        }
    }
    __syncthreads();
}

typedef unsigned v4u __attribute__((ext_vector_type(4)));
typedef unsigned v2u __attribute__((ext_vector_type(2)));
typedef float v4f __attribute__((ext_vector_type(4)));
constexpr int NWAVES = 8, NTHR = 512;
constexpr size_t MiB = 1u << 20;
constexpr int LDS_BYTES = 163840;
constexpr size_t WS_CTL = 0, CTL_ZERO_BYTES = 64 * 1024;
constexpr size_t WS_MOD = 1 * MiB;
constexpr size_t WS_W_IN = 2 * MiB, WS_W_OUT = 5 * MiB, WS_CD_IN = 7 * MiB, WS_CD_OUT = 13 * MiB, WS_WQ = 15 * MiB;
constexpr size_t WS_TAB = 24 * MiB;
constexpr size_t WS_XS = 88 * MiB;
constexpr size_t WS_HA = 220 * MiB;
constexpr size_t WS_ZB = 286 * MiB;
constexpr size_t WS_IDXG = 469 * MiB;
constexpr size_t WS_END = 486 * MiB;
constexpr int CD_PAD = ZZP;
constexpr int CW_CMAX = 6144, CM_WIN = 0, CM_CD = 1536, CM_GATE = 4352, CM_WOUT = 4416, CM_WQ1 = 5440, CM_WQ0 = 7488;
constexpr size_t WS_W_OUT8 = 4 * MiB;
constexpr size_t WS_SA = WS_MOD + 832 * 1024;

__device__ __forceinline__ unsigned pk2(float lo, float hi) { return (unsigned)f2bf(lo) | ((unsigned)f2bf(hi) << 16); }
__device__ __forceinline__ float bflo(unsigned d) { return __uint_as_float(d << 16); }
__device__ __forceinline__ float bfhi(unsigned d) { return __uint_as_float(d & 0xffff0000u); }
__device__ __forceinline__ void ld8(const float* p, v4f& a, v4f& b) { a = *(const v4f*)p; b = *(const v4f*)(p + 4); }
__device__ __forceinline__ void ld8(const bf16_t* p, v4f& a, v4f& b) { const v4u w = *(const v4u*)p; a = (v4f){bflo(w.x), bfhi(w.x), bflo(w.y), bfhi(w.y)}; b = (v4f){bflo(w.z), bfhi(w.z), bflo(w.w), bfhi(w.w)}; }
__device__ __forceinline__ void st8(float* p, const v4f& a, const v4f& b) { *(v4f*)p = a; *(v4f*)(p + 4) = b; }
__device__ __forceinline__ void st8(bf16_t* p, const v4f& a, const v4f& b) { v4u o; o.x = pk2(a[0], a[1]); o.y = pk2(a[2], a[3]); o.z = pk2(b[0], b[1]); o.w = pk2(b[2], b[3]); *(v4u*)p = o; }
__device__ __forceinline__ void st8nt(float* p, const v4f& a, const v4f& b) { __builtin_nontemporal_store(a, (v4f*)p); __builtin_nontemporal_store(b, (v4f*)(p + 4)); }
__device__ __forceinline__ void st8nt(bf16_t* p, const v4f& a, const v4f& b) { v4u o; o.x = pk2(a[0], a[1]); o.y = pk2(a[2], a[3]); o.z = pk2(b[0], b[1]); o.w = pk2(b[2], b[3]); __builtin_nontemporal_store(o, (v4u*)p); }
#define LDS_WAIT() asm volatile("s_waitcnt lgkmcnt(0)" ::: "memory")
#define VM_WAIT() asm volatile("s_waitcnt vmcnt(0)" ::: "memory")


__device__ __forceinline__ int rowperm(int n) { return (n & ~255) | (((((n >> 5) & 1) << 2) | ((n >> 6) & 3)) << 5) | (n & 31); }
__device__ __forceinline__ int roworig(int p) { return (p & ~255) | (((((p >> 5) & 3) << 1) | ((p >> 7) & 1)) << 5) | (p & 31); }
struct EpiStore {
    static constexpr bool PERM = true, AFTER_DRAIN = false;
    bf16_t* O; int ldc; int nvalid;
    __device__ __forceinline__ void operator()(const pg8::f32x4 (&acc)[2][2][4][2], const pg8::Unit& u, int wr, int wc, int fr, int fq) const {
        const int row0 = u.pm * 256 + wr * 64 + fr, colw = u.pn * 256 + wc * 64 + 8 * fq; const bool up = fr >= 8;
#pragma unroll
        for (int ai = 0; ai < 2; ++ai)
#pragma unroll
            for (int m = 0; m < 4; ++m) { const int r = row0 + ai * 128 + m * 16; pg8::u32x4 w[2];
#pragma unroll
                for (int bj = 0; bj < 2; ++bj) { const pg8::f32x4 v0 = acc[ai][bj][m][0], v1 = acc[ai][bj][m][1];
                    w[bj].x = pg8::cvt_pk_bf16(v0[0], v0[1]); w[bj].y = pg8::cvt_pk_bf16(v0[2], v0[3]); w[bj].z = pg8::cvt_pk_bf16(v1[0], v1[1]); w[bj].w = pg8::cvt_pk_bf16(v1[2], v1[3]); }
                const pg8::u32x4 snd = up ? w[0] : w[1]; pg8::u32x4 rcv;
                rcv.x = __shfl_xor(snd.x, 8); rcv.y = __shfl_xor(snd.y, 8); rcv.z = __shfl_xor(snd.z, 8); rcv.w = __shfl_xor(snd.w, 8);
                bf16_t* p1 = O + (size_t)(up ? r - 8 : r) * ldc + colw + (up ? 32 : 0);
                *(pg8::u32x4*)p1 = up ? rcv : w[0]; *(pg8::u32x4*)(p1 + (size_t)8 * ldc) = up ? w[1] : rcv; }
    }
};

struct EpiStoreI8 {
    static constexpr bool PERM = true, AFTER_DRAIN = false;
    bf16_t* O; int ldc; int nvalid; const float* sa; const unsigned* cmax;
    __device__ __forceinline__ void operator()(const pg8::i32x4 (&acc)[2][2][4][2], const pg8::Unit& u, int wr, int wc, int fr, int fq) const {
        const int row0 = u.pm * 256 + wr * 64 + fr, colw = u.pn * 256 + wc * 64 + 8 * fq; const bool up = fr >= 8;
        float sb[2][8];
#pragma unroll
        for (int bj = 0; bj < 2; ++bj)
#pragma unroll
            for (int c = 0; c < 8; ++c) sb[bj][c] = __uint_as_float(cmax[colw + bj * 32 + c]) * (1.f / 127.f);
#pragma unroll
        for (int ai = 0; ai < 2; ++ai)
#pragma unroll
            for (int m = 0; m < 4; ++m) { const int r = row0 + ai * 128 + m * 16; const float s = sa[r]; pg8::u32x4 w[2];
#pragma unroll
                for (int bj = 0; bj < 2; ++bj) { const pg8::i32x4 a0 = acc[ai][bj][m][0], a1 = acc[ai][bj][m][1];
                    w[bj].x = pg8::cvt_pk_bf16((float)a0[0] * s * sb[bj][0], (float)a0[1] * s * sb[bj][1]); w[bj].y = pg8::cvt_pk_bf16((float)a0[2] * s * sb[bj][2], (float)a0[3] * s * sb[bj][3]);
                    w[bj].z = pg8::cvt_pk_bf16((float)a1[0] * s * sb[bj][4], (float)a1[1] * s * sb[bj][5]); w[bj].w = pg8::cvt_pk_bf16((float)a1[2] * s * sb[bj][6], (float)a1[3] * s * sb[bj][7]); }
                const pg8::u32x4 snd = up ? w[0] : w[1]; pg8::u32x4 rcv;
                rcv.x = __shfl_xor(snd.x, 8); rcv.y = __shfl_xor(snd.y, 8); rcv.z = __shfl_xor(snd.z, 8); rcv.w = __shfl_xor(snd.w, 8);
                bf16_t* p1 = O + (size_t)(up ? r - 8 : r) * ldc + colw + (up ? 32 : 0);
                *(pg8::u32x4*)p1 = up ? rcv : w[0]; *(pg8::u32x4*)(p1 + (size_t)8 * ldc) = up ? w[1] : rcv; }
    }
};

__device__ __forceinline__ int win_pos(int n) {
    if (n < 512) return rowperm(n);
    const int c = (n - 512) & 511, isg = n >= 1024 ? 1 : 0;
    return (2 + (c >> 7)) * 256 + isg * 128 + ((c >> 5) & 3) * 32 + (c & 31);
}
struct EpiGlu {
    static constexpr bool PERM = true, AFTER_DRAIN = false;
    bf16_t* O; const float* sa; const unsigned* cmax;
    __device__ __forceinline__ void operator()(const pg8::i32x4 (&acc)[2][2][4][2], const pg8::Unit& u, int wr, int wc, int fr, int fq) const {
        const int row0 = u.pm * 256 + wr * 64 + fr;
        if (u.pn < 2) { const EpiStoreI8 E{O, 1024, 1024, sa, cmax}; E(acc, u, wr, wc, fr, fq); return; }
        const int ch0 = (u.pn - 2) * 128 + wc * 32 + 8 * fq;
        float sA[8], sG[8];
#pragma unroll
        for (int c = 0; c < 8; ++c) { sA[c] = __uint_as_float(cmax[512 + ch0 + c]) * (1.f / 127.f); sG[c] = __uint_as_float(cmax[1024 + ch0 + c]) * (1.f / 127.f); }
#pragma unroll
        for (int ai = 0; ai < 2; ++ai)
#pragma unroll
            for (int m = 0; m < 4; ++m) { const int r = row0 + ai * 128 + m * 16; const float s = sa[r]; float uv[8];
#pragma unroll
                for (int c = 0; c < 8; ++c) { const float av = (float)acc[ai][0][m][c >> 2][c & 3] * s * sA[c], gv = (float)acc[ai][1][m][c >> 2][c & 3] * s * sG[c];
                    uv[c] = av * __builtin_amdgcn_rcpf(1.f + __expf(-gv)); }
                pg8::u32x4 w; w.x = pg8::cvt_pk_bf16(uv[0], uv[1]); w.y = pg8::cvt_pk_bf16(uv[2], uv[3]); w.z = pg8::cvt_pk_bf16(uv[4], uv[5]); w.w = pg8::cvt_pk_bf16(uv[6], uv[7]);
                *(pg8::u32x4*)(O + (size_t)r * 1024 + 512 + ch0) = w; }
    }
};

__device__ __forceinline__ void transpose_item(const float* W, int K, int N, int Npad, bf16_t* WT, LAS float* scr, int item, int lane, int ldo = 0, int ldw = 0) {
    if (ldo == 0) ldo = K;
    if (ldw == 0) ldw = N;
    const int nblk = Npad / 32, kb = item / nblk, nb = item % nblk, k0 = 64 * kb, n0 = 32 * nb;
    const int nn = n0 + (lane & 31);
#pragma unroll 8
    for (int i = 0; i < 32; ++i) { const int kk = 2 * i + (lane >> 5); scr[kk * 33 + (lane & 31)] = nn < N ? W[(size_t)(k0 + kk) * ldw + nn] : 0.f; }
    LDS_WAIT(); asm volatile("" ::: "memory");
    const int c = lane & 7;
#pragma unroll
    for (int j = 0; j < 4; ++j) { const int n = (lane >> 3) + 8 * j; const LAS float* s = scr + (8 * c) * 33 + n;
        v4u o; o.x = pk2(s[0 * 33], s[1 * 33]); o.y = pk2(s[2 * 33], s[3 * 33]); o.z = pk2(s[4 * 33], s[5 * 33]); o.w = pk2(s[6 * 33], s[7 * 33]);
        *(v4u*)(WT + (size_t)rowperm(n0 + n) * ldo + k0 + 8 * c) = o; }
    LDS_WAIT(); asm volatile("" ::: "memory");
}
__device__ __forceinline__ void fold_item(const float* pool_w, const float* pool_ls, const float* w_out, bf16_t* WT, LAS float* scr, int item, int lane) {
    const int kg = item & 15, nb = (item >> 4) & 15, g = item >> 8, n = nb * 64 + lane;
    { const float* pw = pool_w + ((size_t)g * 128 + kg * 8) * 128;
#pragma unroll
      for (int q = 0; q < 4; ++q) *(LAS v4f*)(scr + q * 256 + lane * 4) = *(const v4f*)(pw + q * 256 + lane * 4); }
    LDS_WAIT(); asm volatile("" ::: "memory");
    float acc[8];
#pragma unroll
    for (int kk = 0; kk < 8; ++kk) acc[kk] = 0.f;
#pragma unroll 1
    for (int hf = 0; hf < 8; ++hf) {
        float wc[16];
#pragma unroll
        for (int j = 0; j < 16; ++j) wc[j] = w_out[(size_t)(g * 128 + hf * 16 + j) * 1024 + n] * pool_ls[g * 128 + hf * 16 + j];
#pragma unroll
        for (int kk = 0; kk < 8; ++kk) { float a0 = 0.f, a1 = 0.f;
#pragma unroll
            for (int j = 0; j < 16; j += 4) { const v4f p = *(const LAS v4f*)(scr + kk * 128 + hf * 16 + j); a0 += p[0] * wc[j] + p[2] * wc[j + 2]; a1 += p[1] * wc[j + 1] + p[3] * wc[j + 3]; }
            acc[kk] += a0 + a1; }
    }
    LDS_WAIT(); asm volatile("" ::: "memory");
    v4u o; o.x = pk2(acc[0], acc[1]); o.y = pk2(acc[2], acc[3]); o.z = pk2(acc[4], acc[5]); o.w = pk2(acc[6], acc[7]);
    *(v4u*)(WT + (size_t)rowperm(n) * 1024 + g * 128 + kg * 8) = o;
}
__device__ __forceinline__ unsigned q8pack4(float a, float b, float c, float d, float inv) {
    int q0 = __float2int_rn(a * inv), q1 = __float2int_rn(b * inv), q2 = __float2int_rn(c * inv), q3 = __float2int_rn(d * inv);
    q0 = q0 > 127 ? 127 : (q0 < -127 ? -127 : q0); q1 = q1 > 127 ? 127 : (q1 < -127 ? -127 : q1); q2 = q2 > 127 ? 127 : (q2 < -127 ? -127 : q2); q3 = q3 > 127 ? 127 : (q3 < -127 ? -127 : q3);
    return (unsigned)(q0 & 255) | ((unsigned)(q1 & 255) << 8) | ((unsigned)(q2 & 255) << 16) | ((unsigned)(q3 & 255) << 24);
}
__device__ __forceinline__ void colmax_item(const float* W  , int ldw, int ncols, unsigned* cmax, int item, int lane) {
    const int kr = item & 15, n = (item >> 4) * 256 + lane * 4;
    if (n < ncols) { const float* w = W + (size_t)(kr * 64) * ldw + n; v4f mx = {0.f, 0.f, 0.f, 0.f};
#pragma unroll 16
        for (int k = 0; k < 64; ++k) { const v4f v = *(const v4f*)(w + (size_t)k * ldw); mx[0] = fmaxf(mx[0], fabsf(v[0])); mx[1] = fmaxf(mx[1], fabsf(v[1])); mx[2] = fmaxf(mx[2], fabsf(v[2])); mx[3] = fmaxf(mx[3], fabsf(v[3])); }
#pragma unroll
        for (int c = 0; c < 4; ++c) atomicMax(&cmax[n + c], __float_as_uint(mx[c])); }
}
__device__ __forceinline__ void transpose8_item(const float* W, int ldw, int ncols, const unsigned* cmax, signed char* WT, LAS float* scr, int item, int lane, bool glu = false) {
    const int nblk = ncols / 32, kb = item / nblk, nb = item % nblk, k0 = 64 * kb, n0 = 32 * nb;
#pragma unroll 8
    for (int i = 0; i < 32; ++i) { const int kk = 2 * i + (lane >> 5); scr[kk * 33 + (lane & 31)] = W[(size_t)(k0 + kk) * ldw + n0 + (lane & 31)]; }
    LDS_WAIT(); asm volatile("" ::: "memory");
    const int c = lane & 3;
#pragma unroll
    for (int j = 0; j < 2; ++j) { const int n = (lane >> 2) + 16 * j; const LAS float* s = scr + (16 * c) * 33 + n;
        const float inv = 127.f / fmaxf(__uint_as_float(cmax[n0 + n]), 1e-30f);
        v4u o;
#pragma unroll
        for (int q = 0; q < 4; ++q) o[q] = q8pack4(s[(4 * q) * 33], s[(4 * q + 1) * 33], s[(4 * q + 2) * 33], s[(4 * q + 3) * 33], inv);
        *(v4u*)(WT + (size_t)(glu ? win_pos(n0 + n) : rowperm(n0 + n)) * 1024 + k0 + 16 * c) = o; }
    LDS_WAIT(); asm volatile("" ::: "memory");
}
__device__ __forceinline__ void ph_w8(const float* const* in, unsigned char* ws, LAS unsigned char* lds, int lane, int wave, int gw, int NGW) {
    LAS float* scr = (LAS float*)(lds + 24576 + wave * 8704);
    const unsigned* cm = (const unsigned*)(ws + WS_CTL) + CW_CMAX;
    constexpr int I_WIN = 16 * (AB_IN / 32), I_CDA = 16 * 64, I_CDB = 16 * 24;
    constexpr int I_WQ8 = 16 * 64;
    for (int it = gw; it < I_WIN + I_CDA + I_CDB + 1024 + 2 * I_WQ8; it += NGW) {
        int r = it;
        if (r >= I_WIN + I_CDA + I_CDB + 1024 + I_WQ8) { transpose8_item(in[22], 2048, 2048, cm + CM_WQ0, (signed char*)(ws + WS_WQ), scr, r - (I_WIN + I_CDA + I_CDB + 1024 + I_WQ8), lane); continue; }
        if (r >= I_WIN + I_CDA + I_CDB + 1024) { transpose8_item(in[22] + (size_t)1024 * 2048, 2048, 2048, cm + CM_WQ1, (signed char*)(ws + WS_WQ) + (size_t)4 * MiB, scr, r - (I_WIN + I_CDA + I_CDB + 1024), lane); continue; }
        if (r >= I_WIN + I_CDA + I_CDB) {
            const int n = r - (I_WIN + I_CDA + I_CDB); const bf16_t* wr = (const bf16_t*)(ws + WS_W_OUT) + (size_t)n * 1024 + lane * 16;
            const v4u a0 = *(const v4u*)wr, a1 = *(const v4u*)(wr + 8); float f[16]; float mx = 0.f;
#pragma unroll
            for (int e = 0; e < 4; ++e) { f[2 * e] = bflo(a0[e]); f[2 * e + 1] = bfhi(a0[e]); f[8 + 2 * e] = bflo(a1[e]); f[9 + 2 * e] = bfhi(a1[e]); }
#pragma unroll
            for (int e = 0; e < 16; ++e) mx = fmaxf(mx, fabsf(f[e]));
#pragma unroll
            for (int o_ = 1; o_ < 64; o_ <<= 1) mx = fmaxf(mx, __shfl_xor(mx, o_));
            mx = fmaxf(mx, 1e-30f); const float inv = 127.f / mx;
            if (lane == 0) ((unsigned*)(ws + WS_CTL) + CW_CMAX)[CM_WOUT + roworig(n)] = __float_as_uint(mx);
            v4u o;
#pragma unroll
            for (int q = 0; q < 4; ++q) o[q] = q8pack4(f[4 * q], f[4 * q + 1], f[4 * q + 2], f[4 * q + 3], inv);
            *(v4u*)(ws + WS_W_OUT8 + (size_t)n * 1024 + lane * 16) = o; continue; }
        if (r < I_WIN) { transpose8_item(in[8], AB_IN, AB_IN, cm + CM_WIN, (signed char*)(ws + WS_W_IN), scr, r, lane, true); continue; } r -= I_WIN;
        if (r < I_CDA) { transpose8_item(in[16], CD_IN, 2048, cm + CM_CD, (signed char*)(ws + WS_CD_IN), scr, r, lane); continue; } r -= I_CDA;
        transpose8_item(in[16] + 2064, CD_IN, 768, cm + CM_CD + 2048, (signed char*)(ws + WS_CD_IN) + (size_t)2048 * 1024, scr, r, lane);
    }
}
__device__ __forceinline__ void cvt_row_bf16(const float* src, bf16_t* dst, int lane) {
#pragma unroll
    for (int j = 0; j < 2; ++j) { const int e = (j * 64 + lane) * 8; const v4f a = *(const v4f*)(src + e), b = *(const v4f*)(src + e + 4);
        v4u o; o.x = pk2(a[0], a[1]); o.y = pk2(a[2], a[3]); o.z = pk2(b[0], b[1]); o.w = pk2(b[2], b[3]); *(v4u*)(dst + e) = o; }
}
typedef int v4i __attribute__((ext_vector_type(4)));
typedef float v2f __attribute__((ext_vector_type(2)));
constexpr size_t TAB_VQ = 16 * MiB, SLICE_B = (size_t)16384 * 128;
constexpr size_t WS_SU = WS_MOD + 512 * 1024;
#define DPP_F(x, ctrl) __int_as_float(__builtin_amdgcn_update_dpp(0, __float_as_int(x), (ctrl), 0xf, 0xf, true))
__device__ __forceinline__ float wave_sum_early(float v) {
    v += DPP_F(v, 0xB1); v += DPP_F(v, 0x4E); v += DPP_F(v, 0x141); v += DPP_F(v, 0x140);
    const int b = __float_as_int(v);
    return (__int_as_float(__builtin_amdgcn_readlane(b, 0)) + __int_as_float(__builtin_amdgcn_readlane(b, 16))) + (__int_as_float(__builtin_amdgcn_readlane(b, 32)) + __int_as_float(__builtin_amdgcn_readlane(b, 48)));
}
__device__ __forceinline__ float wave_max(float v) {
    v = fmaxf(v, DPP_F(v, 0xB1)); v = fmaxf(v, DPP_F(v, 0x4E)); v = fmaxf(v, DPP_F(v, 0x141)); v = fmaxf(v, DPP_F(v, 0x140));
    const int b = __float_as_int(v);
    return fmaxf(fmaxf(__int_as_float(__builtin_amdgcn_readlane(b, 0)), __int_as_float(__builtin_amdgcn_readlane(b, 16))), fmaxf(__int_as_float(__builtin_amdgcn_readlane(b, 32)), __int_as_float(__builtin_amdgcn_readlane(b, 48))));
}
__device__ __forceinline__ void ph_tables(const float* const* in, unsigned char* ws, int layer, int gw, int NGW, int lane) {
    const float* U = in[24] + (size_t)layer * 16384 * 1024; const float* V = in[25] + (size_t)layer * 16384 * 1024;
    unsigned char* UQ = ws + WS_TAB; unsigned char* VQ = ws + WS_TAB + TAB_VQ; float* SU = (float*)(ws + WS_SU);
    const int s = lane >> 3, j = lane & 7;
    v4f nx[4];
    if (gw < 32768) { const float* src = (gw < 16384 ? U + (size_t)gw * 1024 : V + (size_t)(gw - 16384) * 1024) + s * 128 + j * 16;
#pragma unroll
        for (int c = 0; c < 4; ++c) nx[c] = *(const v4f*)(src + 4 * c); }
    for (int it = gw; it < 32768; it += NGW) {
        const bool isu = it < 16384; const int e = isu ? it : it - 16384;
        float x[16];
#pragma unroll
        for (int c = 0; c < 4; ++c) { x[4 * c] = nx[c][0]; x[4 * c + 1] = nx[c][1]; x[4 * c + 2] = nx[c][2]; x[4 * c + 3] = nx[c][3]; }
        if (it + NGW < 32768) { const int i2 = it + NGW; const float* src = (i2 < 16384 ? U + (size_t)i2 * 1024 : V + (size_t)(i2 - 16384) * 1024) + s * 128 + j * 16;
#pragma unroll
            for (int c = 0; c < 4; ++c) nx[c] = *(const v4f*)(src + 4 * c); }
        v4i o;
        if (isu) {
            float ss = 0.f;
#pragma unroll
            for (int c = 0; c < 16; ++c) ss += x[c] * x[c];
            const float stp = 0.3352f * sqrtf(wave_sum_early(ss) * (1.f / 1024.f)) + 1e-30f, istp = 1.f / stp;
            unsigned nb[16]; int qs = 0;
#pragma unroll
            for (int c = 0; c < 16; ++c) { int q = (int)floorf(x[c] * istp); q = q < -8 ? -8 : (q > 7 ? 7 : q); qs += q; nb[c] = (unsigned)(q & 15); }
            const float qsum = wave_sum_early((float)qs);
            if (lane == 0) { SU[2 * e] = stp; SU[2 * e + 1] = 8.f * qsum; }
            v2u ow;
#pragma unroll
            for (int w = 0; w < 2; ++w) { unsigned ww = 0;
#pragma unroll
                for (int b = 0; b < 4; ++b) ww |= (nb[8 * w + b] | (nb[8 * w + 4 + b] << 4)) << (8 * b);
                ow[w] = ww; }
            *(v2u*)(UQ + (size_t)(lane >> 4) * SLICE_B + (size_t)e * 128 + (lane & 15) * 8) = ow;
        } else {
#pragma unroll
            for (int c = 0; c < 4; ++c) { int w = __builtin_amdgcn_cvt_pk_fp8_f32(x[4 * c], x[4 * c + 1], 0, false); w = __builtin_amdgcn_cvt_pk_fp8_f32(x[4 * c + 2], x[4 * c + 3], w, true); o[c] = w; }
            *(v4i*)(VQ + (size_t)s * SLICE_B + (size_t)e * 128 + j * 16) = o;
        }
    }
}
#ifndef P0PART
#define P0PART 3
#endif
__device__ __forceinline__ void ph_prologue(const float* const* in, unsigned char* ws, LAS unsigned char* lds, int tid, int lane, int wave, int gw, int NGW, int rep_ = 0) {
    LAS float* sv = (LAS float*)lds;
    LAS float* scr = (LAS float*)(lds + 24576 + wave * 8704);
    for (int i = tid; i < 5120; i += NTHR) { const int r = i >> 10, k = i & 1023; const float v = r < 4 ? in[1][r * 1024 + k] : in[3][k]; sv[i] = v / (1.f + __expf(-v)); }
    __syncthreads();
    {
        LAS float* red = (LAS float*)(lds + 24576);
        const int vb = (int)blockIdx.x;
        if (rep_ == 0 || (P0PART & 1)) for (int item = vb; item < 192; item += (int)gridDim.x) {
            const int l = item / 96, col = (item % 96) * 64 + lane;
            const float* w = in[4] + (size_t)l * 1024 * 6144 + (size_t)(wave * 128) * 6144 + col;
            float acc[5] = {0.f, 0.f, 0.f, 0.f, 0.f};
#pragma unroll 16
            for (int k = 0; k < 128; ++k) { const float wv = w[(size_t)k * 6144];
#pragma unroll
                for (int r = 0; r < 5; ++r) acc[r] += sv[r * 1024 + wave * 128 + k] * wv; }
#pragma unroll
            for (int r = 0; r < 5; ++r) red[(wave * 5 + r) * 64 + lane] = acc[r];
            __syncthreads();
            if (wave < 5) { float s = 0.f;
#pragma unroll
                for (int ww = 0; ww < 8; ++ww) s += red[(ww * 5 + wave) * 64 + lane];
                ((float*)(ws + WS_MOD))[(l * 5 + wave) * 6144 + col] = s + in[5][l * 6144 + col]; }
            __syncthreads();
        }
    }
    constexpr int N_MOD = 0;
    constexpr int I_WOUT = 8 * 32, I_FOLD = 4 * 16 * 16, I_CDOUT = 16 * 32;
    constexpr int C_WIN = 16 * (AB_IN / 256), C_CDA = 16 * 8, C_CDB = 16 * 3, C_GATE = 16, I_WQ = 16 * 64;
    constexpr int C_WQ = 16 * 8;
    constexpr int N_TR = I_WOUT + I_FOLD + I_CDOUT + C_WIN + C_CDA + C_CDB + C_GATE + 2 * C_WQ;
    unsigned* cm = (unsigned*)(ws + WS_CTL) + CW_CMAX;
    if (rep_ == 0 || (P0PART & 2)) for (int it = NGW - 1 - gw; it < N_TR; it += NGW) {
        int r = it;
#ifdef P0TYPES
        { const int ncm = C_WIN + C_CDA + C_CDB + C_GATE + 2 * C_WQ; const int ty = it < ncm ? 0 : (it < ncm + I_WOUT ? 1 : (it < ncm + I_WOUT + I_FOLD ? 2 : 3)); if (rep_ > 0 && !((P0TYPES >> ty) & 1)) continue; }
#endif
        if (r < C_WIN) { colmax_item(in[8], AB_IN, AB_IN, cm + CM_WIN, r, lane); continue; } r -= C_WIN;
        if (r < C_CDA) { colmax_item(in[16], CD_IN, 2048, cm + CM_CD, r, lane); continue; } r -= C_CDA;
        if (r < C_CDB) { colmax_item(in[16] + 2064, CD_IN, 768, cm + CM_CD + 2048, r, lane); continue; } r -= C_CDB;
        if (r < C_GATE) { colmax_item(in[16] + 2048, CD_IN, 16, cm + CM_GATE, r, lane); continue; } r -= C_GATE;
        if (r < C_WQ) { colmax_item(in[22], 2048, 2048, cm + CM_WQ0, r, lane); continue; } r -= C_WQ;
        if (r < C_WQ) { colmax_item(in[22] + (size_t)1024 * 2048, 2048, 2048, cm + CM_WQ1, r, lane); continue; } r -= C_WQ;
        if (r < I_WOUT) { transpose_item(in[15] + (size_t)512 * 1024, 512, 1024, 1024, (bf16_t*)(ws + WS_W_OUT) + 512, scr, r, lane, 1024); continue; } r -= I_WOUT;
        if (r < I_FOLD) { fold_item(in[9], in[10], in[15], (bf16_t*)(ws + WS_W_OUT), scr, r, lane); continue; } r -= I_FOLD;
        transpose_item(in[21], 1024, 1024, 1024, (bf16_t*)(ws + WS_CD_OUT), scr, r, lane);
    }
}
__device__ __forceinline__ void ph_moda(const float* xl, const float* xc, const float* mod  , int sh_off, int sc_off, signed char* HA8, float* SA, int nrows, int lane, int wave, int vcu, int G) {
    const int per = nrows / G, r0 = vcu * per;
    v4f msc[4], msh[4], A[4], B[4]; int cur_mod = -1;
    auto ld = [&](v4f (&R)[4], int r) { const float* xr = r < ML ? xl + (size_t)r * D : xc + (size_t)(r - ML) * D;
#pragma unroll
        for (int i = 0; i < 2; ++i) { R[2 * i] = *(const v4f*)(xr + i * 512 + lane * 8); R[2 * i + 1] = *(const v4f*)(xr + i * 512 + lane * 8 + 4); } };
    if (wave < per) ld(A, r0 + wave);
    for (int t = wave; t < per; t += 8) {
        const int r = r0 + t;
        if (t + 8 < per) ld(B, r + 8);
        const int mr = row_mod(r);
        if (mr != cur_mod) { cur_mod = mr; const float* m = mod + mr * 6144;
#pragma unroll
            for (int i = 0; i < 2; ++i) { const int e0 = i * 512 + lane * 8; msc[2 * i] = *(const v4f*)(m + sc_off + e0); msc[2 * i + 1] = *(const v4f*)(m + sc_off + e0 + 4); msh[2 * i] = *(const v4f*)(m + sh_off + e0); msh[2 * i + 1] = *(const v4f*)(m + sh_off + e0 + 4); } }
        v4f y[4]; float mx = 0.f;
#pragma unroll
        for (int i = 0; i < 4; ++i) { y[i] = A[i] * (msc[i] + 1.f) + msh[i]; mx = fmaxf(mx, fmaxf(fmaxf(fabsf(y[i][0]), fabsf(y[i][1])), fmaxf(fabsf(y[i][2]), fabsf(y[i][3])))); }
        mx = fmaxf(wave_max(mx), 1e-30f);
        const float inv = 127.f / mx;
        if (lane == 0) SA[r] = mx * (1.f / 127.f);
#pragma unroll
        for (int i = 0; i < 2; ++i) { v2u o; o.x = q8pack4(y[2 * i][0], y[2 * i][1], y[2 * i][2], y[2 * i][3], inv); o.y = q8pack4(y[2 * i + 1][0], y[2 * i + 1][1], y[2 * i + 1][2], y[2 * i + 1][3], inv);
            *(v2u*)(HA8 + (size_t)r * D + i * 512 + lane * 8) = o; }
#pragma unroll
        for (int i = 0; i < 4; ++i) A[i] = B[i];
    }
}

__device__ __forceinline__ float wave_sum(float v) { return wave_sum_early(v); }
__device__ __forceinline__ void ph_attn_prep(const bf16_t* ZZ, const float* qn_g, const float* kn_g, bf16_t* QA, bf16_t* KA, bf16_t* VA, int gw, int NGW, int lane) {
    const int hs = lane >> 3, j = lane & 7;
    const int half = j >> 2, second = (j >> 1) & 1;
    float qg[8], kg[8], freq[8];
#pragma unroll
    for (int e = 0; e < 8; ++e) { qg[e] = qn_g[j * 8 + e] * attn_body::C2; kg[e] = kn_g[j * 8 + e]; freq[e] = exp2f(-(float)((j & 1) * 8 + e) * (13.287712379549449f / 16.f)); }
    const int col0 = 2048 + hs * 64 + j * 8, col1 = (hs < 2 ? 2560 + hs * 64 : 2688 + (hs & 1) * 64) + j * 8;
    v4u A0, A1, B0 = {0u, 0u, 0u, 0u}, B1 = {0u, 0u, 0u, 0u};
    if (gw < MT) { const bf16_t* zr = ZZ + (size_t)gw * ZZP; A0 = *(const v4u*)(zr + col0); A1 = *(const v4u*)(zr + col1); }
    for (int r = gw; r < MT; r += NGW) {
        if (r + NGW < MT) { const bf16_t* zn = ZZ + (size_t)(r + NGW) * ZZP; B0 = *(const v4u*)(zn + col0); B1 = *(const v4u*)(zn + col1); }
        const bool lat = r < ML; const int b = row_b(r), t = row_t(r);
        const size_t krow = (size_t)b * TK + (lat ? CTX + t : t);
        const float pos = half == 0 ? (float)(t >> 6) : (float)(t & 63);
        float cs[8], sn[8];
#pragma unroll
        for (int e = 0; e < 8; ++e) { const float ang = pos * freq[e]; cs[e] = lat ? __cosf(ang) : 1.f; sn[e] = lat ? __sinf(ang) : 0.f; }
#pragma unroll
        for (int pass = 0; pass < 2; ++pass) {
            if (pass == 0 && !lat) continue;
            const v4u raw = pass == 0 ? A0 : A1;
            float v[8] = {bflo(raw.x), bfhi(raw.x), bflo(raw.y), bfhi(raw.y), bflo(raw.z), bfhi(raw.z), bflo(raw.w), bfhi(raw.w)};
            float ss = 0.f;
#pragma unroll
            for (int e = 0; e < 8; ++e) ss += v[e] * v[e];
            ss += DPP_F(ss, 0xB1); ss += DPP_F(ss, 0x4E); ss += DPP_F(ss, 0x141);
            const float rs = rsqrtf(ss * (1.f / 64.f) + RMS_EPS);
            v4u o;
            if (pass == 1 && hs >= 2) o = raw;
            else {
#pragma unroll
                for (int e = 0; e < 8; ++e) { v[e] *= rs * (pass == 0 ? qg[e] : kg[e]);
                    const float ot = DPP_F(v[e], 0x4E);
                    v[e] = second ? (ot * sn[e] + v[e] * cs[e]) : (v[e] * cs[e] - ot * sn[e]); }
                o.x = pk2(v[0], v[1]); o.y = pk2(v[2], v[3]); o.z = pk2(v[4], v[5]); o.w = pk2(v[6], v[7]);
            }
            if (pass == 0) *(v4u*)(QA + (size_t)r * 512 + hs * 64 + j * 8) = o;
            else if (hs < 2) *(v4u*)(KA + krow * 128 + hs * 64 + j * 8) = o;
            else if (hs < 4) *(v4u*)(VA + krow * 128 + (hs & 1) * 64 + j * 8) = o;
        }
        A0 = B0; A1 = B1;
    }
}

typedef short s16x8 __attribute__((ext_vector_type(8)));
typedef __bf16 bf16x2_v __attribute__((ext_vector_type(2)));
__device__ __forceinline__ int kmax(int a, int b) { return __float_as_int(__builtin_amdgcn_fmed3f(__int_as_float(a), __int_as_float(b), __builtin_inff())); }
__device__ __forceinline__ int kmin(int a, int b) { return __float_as_int(__builtin_amdgcn_fmed3f(__int_as_float(a), __int_as_float(b), -__builtin_inff())); }
template <int N> __device__ __forceinline__ void bitonic_sort_desc(int (&a)[N]) {
#pragma unroll
    for (int k = 2; k <= N; k <<= 1) {
#pragma unroll
        for (int j = k >> 1; j > 0; j >>= 1) {
#pragma unroll
            for (int i = 0; i < N; ++i) { const int l = i ^ j; if (l > i) { const bool desc = ((i & k) == 0); const int hi = kmax(a[i], a[l]), lo = kmin(a[i], a[l]); a[i] = desc ? hi : lo; a[l] = desc ? lo : hi; } }
        }
    }
}
template <int N> __device__ __forceinline__ void oem_sort_desc(int (&a)[N]) {
#pragma unroll
    for (int p = 1; p < N; p <<= 1) {
#pragma unroll
        for (int k = p; k >= 1; k >>= 1) {
#pragma unroll
            for (int j = k % p; j <= N - 1 - k; j += 2 * k) {
#pragma unroll
                for (int i = 0; i <= (k - 1 < N - j - k - 1 ? k - 1 : N - j - k - 1); ++i) {
                    if ((i + j) / (2 * p) == (i + j + k) / (2 * p)) { const int x = i + j, y = i + j + k; const int hi = kmax(a[x], a[y]), lo = kmin(a[x], a[y]); a[x] = hi; a[y] = lo; } }
            }
        }
    }
}
template <int N> __device__ __forceinline__ void bitonic_clean_desc(int (&a)[N]) {
#pragma unroll
    for (int j = N >> 1; j > 0; j >>= 1) {
#pragma unroll
        for (int i = 0; i < N; ++i) { const int l = i ^ j; if (l > i) { const int hi = kmax(a[i], a[l]), lo = kmin(a[i], a[l]); a[i] = hi; a[l] = lo; } }
    }
}
__device__ __forceinline__ void merge_top16(int (&a)[16], const int (&b)[16]) {
#pragma unroll
    for (int i = 0; i < 16; ++i) a[i] = kmax(a[i], b[15 - i]);
    bitonic_clean_desc<16>(a);
}
__device__ __forceinline__ int ckey(float v, int pos) { return (__float_as_int(v) & ~255) | (255 - pos); }

__device__ __forceinline__ void ph_route(const bf16_t* Q, const float* keys, unsigned* IDXG, int ntok, LAS unsigned char* lds, int tid, int lane, int wave, int vcu, int G) {
    LAS unsigned char* kl = lds;
    for (int i = tid; i < 4096; i += NTHR) { const int row = i >> 4, ch = i & 15; const float* src = keys + row * 128 + ch * 8;
        const v4f x0 = *(const v4f*)src, x1 = *(const v4f*)(src + 4);
        v4u o; o.x = pk2(x0[0], x0[1]); o.y = pk2(x0[2], x0[3]); o.z = pk2(x1[0], x1[1]); o.w = pk2(x1[2], x1[3]);
        *(LAS v4u*)(kl + row * 272 + ch * 16) = o; }
    __syncthreads();
    LAS int* rowscr = (LAS int*)(lds + 69632 + wave * 8192);
    const int n = lane & 15, q4 = lane >> 4;
    const int per = ntok / G, tok0 = vcu * per, ntile = per / 2;
    for (int tb = wave; tb < ntile; tb += 32) {
        int s0[16], s1[16];
#pragma unroll
        for (int i = 0; i < 16; ++i) { s0[i] = 0; s1[i] = 0; }
#pragma unroll 1
        for (int T = 0; T < 4; ++T) {
            const int tile = tb + 8 * T;
            if (tile < ntile) {
                const int tok = tok0 + tile * 2 + (n >> 3), head = n & 7;
                const bf16_t* qrow = Q + (size_t)tok * 2048 + head * 256;
#pragma unroll
                for (int p = 0; p < 2; ++p) {
                    s16x8 bq[4];
#pragma unroll
                    for (int ks = 0; ks < 4; ++ks) bq[ks] = *(const s16x8*)(qrow + p * 128 + ks * 32 + q4 * 8);
                    int v[32];
#pragma unroll
                    for (int kt = 0; kt < 8; ++kt) {
                        pg8::f32x4 acc = {0.f, 0.f, 0.f, 0.f};
#pragma unroll
                        for (int ks = 0; ks < 4; ++ks) { const s16x8 af = *(const LAS s16x8*)(kl + (p * 128 + kt * 16 + n) * 272 + ks * 64 + q4 * 16);
                            acc = __builtin_amdgcn_mfma_f32_16x16x32_bf16(af, bq[ks], acc, 0, 0, 0); }
#pragma unroll
                        for (int r = 0; r < 4; ++r) v[kt * 4 + r] = (__float_as_int(acc[r]) & ~127) | (127 - (kt * 16 + q4 * 4 + r));
                    }
                    int a16[16], hi16[16];
#pragma unroll
                    for (int i = 0; i < 16; ++i) { a16[i] = v[i]; hi16[i] = v[16 + i]; }
                    oem_sort_desc<16>(a16); oem_sort_desc<16>(hi16); merge_top16(a16, hi16);
#pragma unroll
                    for (int xm = 16; xm <= 32; xm <<= 1) { int b[16];
#pragma unroll
                        for (int i = 0; i < 16; ++i) b[i] = __shfl_xor(a16[i], xm);
                        merge_top16(a16, b); }
                    const bool mine = (q4 == T);
#pragma unroll
                    for (int i = 0; i < 16; ++i) { if (p == 0) s0[i] = mine ? a16[i] : s0[i]; else s1[i] = mine ? a16[i] : s1[i]; }
                }
            }
        }
        const int mytile = tb + 8 * q4;
#pragma unroll
        for (int i = 0; i < 16; ++i) { rowscr[i * 64 + lane] = s0[i]; rowscr[(16 + i) * 64 + lane] = s1[i]; }
        float f0[16], f1[16];
#pragma unroll
        for (int i = 0; i < 16; ++i) { f0[i] = __int_as_float(s0[i] & ~127); f1[i] = __int_as_float(s1[i] & ~127); }
        int g0[16], g1[16], g2[16], g3[16];
        constexpr int NEG = (int)0xff800000;
#pragma unroll
        for (int j = 0; j < 16; ++j) { g0[j] = ckey(f0[0] + f1[j], j); g1[j] = NEG; g2[j] = NEG; g3[j] = NEG; }
#pragma unroll
        for (int j = 0; j < 8; ++j) g1[j] = ckey(f0[1] + f1[j], 16 + j);
#pragma unroll
        for (int j = 0; j < 5; ++j) g1[8 + j] = ckey(f0[2] + f1[j], 32 + j);
#pragma unroll
        for (int j = 0; j < 4; ++j) g2[j] = ckey(f0[3] + f1[j], 48 + j);
#pragma unroll
        for (int j = 0; j < 3; ++j) g2[4 + j] = ckey(f0[4] + f1[j], 64 + j);
#pragma unroll
        for (int i = 5; i < 8; ++i) { g2[7 + (i - 5) * 2] = ckey(f0[i] + f1[0], i * 16); g2[8 + (i - 5) * 2] = ckey(f0[i] + f1[1], i * 16 + 1); }
#pragma unroll
        for (int i = 8; i < 16; ++i) g3[i - 8] = ckey(f0[i] + f1[0], i * 16);
        oem_sort_desc<16>(g1); oem_sort_desc<16>(g2); oem_sort_desc<16>(g3);
        merge_top16(g0, g1); merge_top16(g2, g3); merge_top16(g0, g2);
        float t[16]; float den = 0.f;
#pragma unroll
        for (int k = 0; k < 16; ++k) { t[k] = __expf(__int_as_float(g0[k] & ~255) - __int_as_float(g0[0] & ~255)); den += t[k]; }
        const float rden = __builtin_amdgcn_rcpf(den);
        if (mytile < ntile) {
            const int tok = tok0 + mytile * 2 + (n >> 3), head = n & 7;
            unsigned* op = IDXG + ((size_t)tok * 8 + head) * 16;
#pragma unroll
            for (int e4 = 0; e4 < 4; ++e4) { v4u ov;
#pragma unroll
                for (int e = 0; e < 4; ++e) { const int k = e4 * 4 + e; const int pos = 255 - (g0[k] & 255);
                    const int k0 = rowscr[(pos >> 4) * 64 + lane], k1 = rowscr[(16 + (pos & 15)) * 64 + lane];
                    ov[e] = (unsigned)((127 - (k0 & 127)) * 128 + (127 - (k1 & 127))) | ((unsigned)f2bf(t[k] * rden) << 16); }
                *(v4u*)(op + e4 * 4) = ov; }
        }
    }
}

__device__ __forceinline__ float bfly32(float A, float B) { const auto r = __builtin_amdgcn_permlane32_swap(__float_as_uint(A), __float_as_uint(B), false, false); return __uint_as_float(r[0]) + __uint_as_float(r[1]); }
__device__ __forceinline__ float bfly16(float A, float B) { const auto r = __builtin_amdgcn_permlane16_swap(__float_as_uint(A), __float_as_uint(B), false, false); return __uint_as_float(r[0]) + __uint_as_float(r[1]); }
#ifndef GATHER_FUSE
#define GATHER_FUSE 1
#endif
template <class TO>
__device__ __forceinline__ void ph_gather(const bf16_t* X1, const signed char* H8, const float* HSC, const unsigned* IDXG, const unsigned char* UQ, const float* SU, const unsigned char* VQ, bf16_t* F,
                                          const float* modl, int g_off, const float* lng, const float* lnb, TO* XO, signed char* HAo, float* SA, const float* modn, int nsh_off, int nsc_off, const float* WG  , const unsigned* GCMp  , float* GT,
                                          int ntok, LAS unsigned char* lds, int tid, int lane, int wave, int vcu, int G) {
    const int per = ntok / G, tok0 = vcu * per;
    LAS unsigned* igl = (LAS unsigned*)lds;
    LAS float* act = (LAS float*)(lds + 67584);
    for (int i = tid; i < per * 128; i += NTHR) { igl[i] = IDXG[(size_t)tok0 * 128 + i]; act[i] = 0.f; }
    __syncthreads();
    {
        const int g = lane >> 3, j = lane & 7;
        const int ib = ((lane >> 2) & 1) * 8 + ((lane >> 1) & 1) * 4 + (lane & 1) * 2;
        for (int s = 0; s < 4; ++s) {
            const unsigned char* Us = UQ + (size_t)s * SLICE_B + j * 16;
            for (int t = wave; t < per; t += 8) {
                const signed char* hp = H8 + (size_t)(tok0 + t) * 1024 + (s * 32 + j * 4) * 4;
                const v4i hH = *(const v4i*)hp, hL = *(const v4i*)(hp + 512);
                v4i d[16];
#pragma unroll
                for (int i = 0; i < 16; ++i) { const unsigned e = igl[t * 128 + i * 8 + g] & 0xffffu; d[i] = *(const v4i*)(Us + (size_t)e * 128); }
                int pp[16];
#pragma unroll
                for (int i = 0; i < 16; ++i) { int a1, a2;
                    asm("v_dot8_i32_i4 %0, %1, %2, 0" : "=v"(a1) : "v"(d[i][0]), "v"(hH[0]));
                    asm("v_dot8_i32_i4 %0, %1, %2, 0" : "=v"(a2) : "v"(d[i][0]), "v"(hL[0]));
#pragma unroll
                    for (int w = 1; w < 4; ++w) { a1 = __builtin_amdgcn_sdot8(d[i][w], hH[w], a1, false); a2 = __builtin_amdgcn_sdot8(d[i][w], hL[w], a2, false); }
                    pp[i] = a1 * 16 + a2; }
                int q8[8], q4_[4], q2[2];
                { const bool up = (lane & 4) != 0;
#pragma unroll
                  for (int m = 0; m < 8; ++m) { const int snd = up ? pp[m] : pp[m + 8], kp = up ? pp[m + 8] : pp[m]; q8[m] = kp + __shfl_xor(snd, 4); } }
                { const bool up = (lane & 2) != 0;
#pragma unroll
                  for (int m = 0; m < 4; ++m) { const int snd = up ? q8[m] : q8[m + 4], kp = up ? q8[m + 4] : q8[m]; q4_[m] = kp + __builtin_amdgcn_update_dpp(0, snd, 0x4E, 0xf, 0xf, true); } }
                { const bool up = (lane & 1) != 0;
#pragma unroll
                  for (int m = 0; m < 2; ++m) { const int snd = up ? q4_[m] : q4_[m + 2], kp = up ? q4_[m + 2] : q4_[m]; q2[m] = kp + __builtin_amdgcn_update_dpp(0, snd, 0xB1, 0xf, 0xf, true); } }
                LAS float* ap = act + t * 128 + ib * 8 + g;
                ap[0] += (float)q2[0]; ap[8] += (float)q2[1];
            }
        }
    }
    __syncthreads();
    for (int i = tid; i < per * 128; i += NTHR) { const unsigned ig = igl[i]; const float* hc = HSC + 2 * (size_t)(tok0 + (i >> 7)); const float* su = SU + 2 * (ig & 0xffffu); const float av = su[0] * hc[0] * (act[i] + su[1] + hc[1]);
        act[i] = bfhi(ig) * 0.5f * av * (1.f + erff(av * 0.70710678118654752f)); }
    const unsigned* GCM = GCMp;
    LAS unsigned short* igl16 = (LAS unsigned short*)lds;
    LAS signed char* wg8 = (LAS signed char*)(lds + 33792);
    if (WG) {
        unsigned short tmp[33];
#pragma unroll
        for (int k = 0; k < 33; ++k) { const int i = tid + k * NTHR; tmp[k] = (unsigned short)(i < per * 128 ? (igl[i] & 0xffffu) : 0u); }
        __syncthreads();
#pragma unroll
        for (int k = 0; k < 33; ++k) { const int i = tid + k * NTHR; if (i < per * 128) igl16[i] = tmp[k]; }
        for (int k = tid; k < 1024; k += NTHR) { const float* src = WG + (size_t)k * CD_IN;
#pragma unroll
            for (int c = 0; c < 4; ++c) { const v4f x = *(const v4f*)(src + 4 * c);
#pragma unroll
                for (int m = 0; m < 4; ++m) { const float inv = 127.f / fmaxf(__uint_as_float(GCM[4 * c + m]), 1e-30f); int q = __float2int_rn(x[m] * inv); q = q > 127 ? 127 : (q < -127 ? -127 : q); wg8[(4 * c + m) * 1024 + k] = (signed char)q; } } }
    }
    const bool fuse = (GATHER_FUSE != 0);
    LAS float* pga = (LAS float*)(lds + 135168); LAS float* pba = pga + 1024; LAS float* pmg = pba + 1024;
    LAS bf16_t* pset = (LAS bf16_t*)(lds + 135168 + 8192);
    LAS unsigned* fscr = (LAS unsigned*)(lds + 135168 + 20480) + wave * 64;
    const int mrA = row_mod(tok0), mrB = row_mod(tok0 + per - 1);
    if (fuse) {
        for (int i = tid; i < 1024; i += NTHR) { pga[i] = lng[i]; pba[i] = lnb[i]; }
        if (HAo) { for (int i = tid; i < 2048; i += NTHR) { const int sI = i >> 10, e = i & 1023, mr = sI ? mrB : mrA;
                       pset[sI * 3072 + e] = f2bf(modl[mr * 6144 + g_off + e]); pset[sI * 3072 + 1024 + e] = f2bf(modn[mr * 6144 + nsc_off + e]); pset[sI * 3072 + 2048 + e] = f2bf(modn[mr * 6144 + nsh_off + e]); } }
        else { const float* m = modl + mrA * 6144 + g_off; for (int i = tid; i < 1024; i += NTHR) pmg[i] = m[i]; }
    }
    __syncthreads();
    {
        const int g = lane >> 3, j = lane & 7;
        const int ebase = ((lane >> 5) & 1) * 8 + ((lane >> 4) & 1) * 4 + ((lane >> 3) & 1) * 2;
#ifndef GATHER_VREP
#define GATHER_VREP 1
#endif
        auto vissue = [&](int t, const unsigned char* Vs, v4i (&d)[16], float (&wv)[16]) {
#pragma unroll
                for (int i = 0; i < 16; ++i) { const int k = i * 8 + g; const unsigned e = WG ? (unsigned)igl16[t * 128 + k] : (igl[t * 128 + k] & 0xffffu); wv[i] = act[t * 128 + k]; d[i] = *(const v4i*)(Vs + (size_t)e * 128); } };
        auto vreduce = [&](const v4i (&d)[16], const float (&wv)[16]) -> v2f {
                v2f acc[8];
#pragma unroll
                for (int m = 0; m < 8; ++m) acc[m] = (v2f){0.f, 0.f};
#pragma unroll
                for (int i = 0; i < 16; ++i) { const v2f w2 = {wv[i], wv[i]};
#pragma unroll
                    for (int c = 0; c < 4; ++c) { acc[2 * c] += w2 * __builtin_amdgcn_cvt_pk_f32_fp8(d[i][c], false); acc[2 * c + 1] += w2 * __builtin_amdgcn_cvt_pk_f32_fp8(d[i][c], true); } }
                v2f b4[4], b2[2], b1;
#pragma unroll
                for (int m = 0; m < 4; ++m) b4[m] = (v2f){bfly32(acc[m].x, acc[m + 4].x), bfly32(acc[m].y, acc[m + 4].y)};
#pragma unroll
                for (int m = 0; m < 2; ++m) b2[m] = (v2f){bfly16(b4[m].x, b4[m + 2].x), bfly16(b4[m].y, b4[m + 2].y)};
                { const bool up = (lane & 8) != 0; const v2f snd = up ? b2[0] : b2[1], kp = up ? b2[1] : b2[0]; b1 = (v2f){kp.x + DPP_F(snd.x, 0x128), kp.y + DPP_F(snd.y, 0x128)}; }
                return b1; };
        const int nplain = fuse ? 7 : 8;
        for (int s = 0; s < nplain; ++s) {
            const unsigned char* Vs = VQ + (size_t)s * SLICE_B + j * 16;
            for (int t = wave; t < per; t += 8) {
                v4i d[16]; float wv[16]; vissue(t, Vs, d, wv);
                const v2f b1 = vreduce(d, wv);
                __builtin_nontemporal_store(pk2(b1.x, b1.y), (unsigned*)(F + (size_t)(tok0 + t) * 1024 + s * 128 + j * 16 + ebase));
            }
        }
        if (fuse) {
            const unsigned char* Vs = VQ + (size_t)7 * SLICE_B + j * 16;
            auto rowload = [&](int t, v4u (&xw)[2], v4u (&fw)[2]) { const int tok = tok0 + t;
                const bf16_t* xr = X1 + (size_t)tok * 1024 + lane * 8; const bf16_t* fr = F + (size_t)tok * 1024 + lane * 8;
                xw[0] = __builtin_nontemporal_load((const v4u*)xr); xw[1] = __builtin_nontemporal_load((const v4u*)(xr + 512)); fw[0] = __builtin_nontemporal_load((const v4u*)fr); fw[1] = __builtin_nontemporal_load((const v4u*)(fr + (lane < 48 ? 512 : 0))); };
            v4u xw[2], fw[2];
            auto finish = [&](int tok) {
                unsigned yq[4] = {0u, 0u, 0u, 0u}; float ysc = 0.f;
                if (lane >= 48) fw[1] = *(const LAS v4u*)(fscr + (lane - 48) * 4);
                const LAS bf16_t* psel = pset + (row_mod(tok) != mrA ? 3072 : 0);
                float v[16]; float sm = 0.f;
#pragma unroll
                for (int i = 0; i < 2; ++i) {
                    const v4f x0 = {bflo(xw[i].x), bfhi(xw[i].x), bflo(xw[i].y), bfhi(xw[i].y)}, x1 = {bflo(xw[i].z), bfhi(xw[i].z), bflo(xw[i].w), bfhi(xw[i].w)};
                    const v4f f0 = {bflo(fw[i].x), bfhi(fw[i].x), bflo(fw[i].y), bfhi(fw[i].y)}, f1 = {bflo(fw[i].z), bfhi(fw[i].z), bflo(fw[i].w), bfhi(fw[i].w)};
                    v4f g0, g1;
                    if (HAo) { const v4u gw = *(const LAS v4u*)(psel + i * 512 + lane * 8); g0 = (v4f){bflo(gw.x), bfhi(gw.x), bflo(gw.y), bfhi(gw.y)}; g1 = (v4f){bflo(gw.z), bfhi(gw.z), bflo(gw.w), bfhi(gw.w)}; }
                    else { g0 = *(const LAS v4f*)(pmg + i * 512 + lane * 8); g1 = *(const LAS v4f*)(pmg + i * 512 + lane * 8 + 4); }
#pragma unroll
                    for (int c = 0; c < 4; ++c) { v[i * 8 + c] = DN_ALPHA * x0[c] + g0[c] * f0[c]; v[i * 8 + 4 + c] = DN_ALPHA * x1[c] + g1[c] * f1[c]; } }
#pragma unroll
                for (int c = 0; c < 16; ++c) sm += v[c];
                const float mu = wave_sum(sm) * (1.f / 1024.f);
                float qq = 0.f;
#pragma unroll
                for (int c = 0; c < 16; ++c) { v[c] -= mu; qq += v[c] * v[c]; }
                const float rstd = rsqrtf(wave_sum(qq) * (1.f / 1024.f) + LN_EPS);
                TO* xo = XO + (size_t)tok * 1024 + lane * 8;
#pragma unroll
                for (int i = 0; i < 2; ++i) {
                    const v4f a0 = *(const LAS v4f*)(pga + i * 512 + lane * 8), a1 = *(const LAS v4f*)(pga + i * 512 + lane * 8 + 4), c0 = *(const LAS v4f*)(pba + i * 512 + lane * 8), c1 = *(const LAS v4f*)(pba + i * 512 + lane * 8 + 4);
                    v4f o0, o1;
#pragma unroll
                    for (int c = 0; c < 4; ++c) { o0[c] = v[i * 8 + c] * rstd * a0[c] + c0[c]; o1[c] = v[i * 8 + 4 + c] * rstd * a1[c] + c1[c]; }
                    st8nt(xo + i * 512, o0, o1);
                    if (HAo) { const v4u sw = *(const LAS v4u*)(psel + 1024 + i * 512 + lane * 8), hw = *(const LAS v4u*)(psel + 2048 + i * 512 + lane * 8);
                        const v4f s0 = {bflo(sw.x), bfhi(sw.x), bflo(sw.y), bfhi(sw.y)}, s1 = {bflo(sw.z), bfhi(sw.z), bflo(sw.w), bfhi(sw.w)}, h0 = {bflo(hw.x), bfhi(hw.x), bflo(hw.y), bfhi(hw.y)}, h1 = {bflo(hw.z), bfhi(hw.z), bflo(hw.w), bfhi(hw.w)};
                        const v4f y0 = o0 * (s0 + 1.f) + h0, y1 = o1 * (s1 + 1.f) + h1;
#pragma unroll
                        for (int c = 0; c < 4; ++c) { v[i * 8 + c] = y0[c]; v[i * 8 + 4 + c] = y1[c]; } }
                }
                if (HAo) {
                    float mx = 0.f;
#pragma unroll
                    for (int c = 0; c < 16; ++c) mx = fmaxf(mx, fabsf(v[c]));
                    mx = fmaxf(wave_max(mx), 1e-30f);
                    const float inv = 127.f / mx;
                    if (lane == 0) SA[tok] = mx * (1.f / 127.f);
                    ysc = mx * (1.f / 127.f);
#pragma unroll
                    for (int i = 0; i < 2; ++i) { v2u o; o.x = q8pack4(v[i * 8], v[i * 8 + 1], v[i * 8 + 2], v[i * 8 + 3], inv); o.y = q8pack4(v[i * 8 + 4], v[i * 8 + 5], v[i * 8 + 6], v[i * 8 + 7], inv);
                        yq[2 * i] = o.x; yq[2 * i + 1] = o.y;
                        *(v2u*)(HAo + (size_t)tok * 1024 + i * 512 + lane * 8) = o; }
                }
                if (WG) {
                    float pq[16];
#pragma unroll
                    for (int gi = 0; gi < 16; ++gi) { const v2u wl = *(const LAS v2u*)(wg8 + gi * 1024 + lane * 8), wh = *(const LAS v2u*)(wg8 + gi * 1024 + 512 + lane * 8);
                        int a = __builtin_amdgcn_sdot4((int)wl.x, (int)yq[0], 0, false); a = __builtin_amdgcn_sdot4((int)wl.y, (int)yq[1], a, false);
                        a = __builtin_amdgcn_sdot4((int)wh.x, (int)yq[2], a, false); a = __builtin_amdgcn_sdot4((int)wh.y, (int)yq[3], a, false);
                        pq[gi] = (float)a; }
                    float p8[8], p4[4], p2[2], p1;
#pragma unroll
                    for (int m = 0; m < 8; ++m) p8[m] = bfly32(pq[m], pq[m + 8]);
#pragma unroll
                    for (int m = 0; m < 4; ++m) p4[m] = bfly16(p8[m], p8[m + 4]);
                    { const bool up = (lane & 8) != 0;
#pragma unroll
                      for (int m = 0; m < 2; ++m) { const float snd = up ? p4[m] : p4[m + 2], kp = up ? p4[m + 2] : p4[m]; p2[m] = kp + DPP_F(snd, 0x128); } }
                    { const bool up = (lane & 4) != 0; const float snd = up ? p2[0] : p2[1], kp = up ? p2[1] : p2[0]; p1 = kp + __shfl_xor(snd, 4); }
                    p1 += __shfl_xor(p1, 2); p1 += __shfl_xor(p1, 1);
                    if ((lane & 3) == 0) GT[(size_t)tok * 16 + (lane >> 2)] = p1 * ysc * (__uint_as_float(GCM[lane >> 2]) * (1.f / 127.f));
                }
            };
            int prev = -1;
            for (int t = wave; t < per; t += 8) {
                v4i d[16]; float wv[16]; vissue(t, Vs, d, wv);
                asm volatile("" ::: "memory"); __builtin_amdgcn_sched_barrier(0);
                if (prev >= 0) finish(tok0 + prev);
                asm volatile("" ::: "memory"); __builtin_amdgcn_sched_barrier(0);
                rowload(t, xw, fw);
                asm volatile("" ::: "memory"); __builtin_amdgcn_sched_barrier(0);
                const v2f b1 = vreduce(d, wv);
                fscr[(j * 16 + ebase) >> 1] = pk2(b1.x, b1.y);
                prev = t;
            }
            if (prev >= 0) finish(tok0 + prev);
            return;
        }
    }
    asm volatile("s_waitcnt vmcnt(0)" ::: "memory");
    __syncthreads();
    LAS float* wgT = (LAS float*)lds;
    if (WG) { for (int k = tid; k < 1024; k += NTHR) { const float* src = WG + (size_t)k * CD_IN;
#pragma unroll
            for (int c = 0; c < 4; ++c) { const v4f x = *(const v4f*)(src + 4 * c); wgT[(4 * c) * 1024 + k] = x[0]; wgT[(4 * c + 1) * 1024 + k] = x[1]; wgT[(4 * c + 2) * 1024 + k] = x[2]; wgT[(4 * c + 3) * 1024 + k] = x[3]; } }
        __syncthreads(); }
    v4f ga[4], ba[4], mg[4], msc[4], msh[4];
#pragma unroll
    for (int i = 0; i < 2; ++i) { const int e0 = i * 512 + lane * 8; ga[2 * i] = *(const v4f*)(lng + e0); ga[2 * i + 1] = *(const v4f*)(lng + e0 + 4); ba[2 * i] = *(const v4f*)(lnb + e0); ba[2 * i + 1] = *(const v4f*)(lnb + e0 + 4);
        msc[2 * i] = msc[2 * i + 1] = msh[2 * i] = msh[2 * i + 1] = (v4f){0.f, 0.f, 0.f, 0.f}; }
    int cur_mod = -1;
    for (int t = wave; t < per; t += 8) {
        const int tok = tok0 + t;
        const int mr = row_mod(tok);
        if (mr != cur_mod) { cur_mod = mr; const float* m = modl + mr * 6144 + g_off;
#pragma unroll
            for (int i = 0; i < 2; ++i) { const int e0 = i * 512 + lane * 8; mg[2 * i] = *(const v4f*)(m + e0); mg[2 * i + 1] = *(const v4f*)(m + e0 + 4); }
            if (HAo) { const float* mn = modn + mr * 6144;
#pragma unroll
                for (int i = 0; i < 2; ++i) { const int e0 = i * 512 + lane * 8; msc[2 * i] = *(const v4f*)(mn + nsc_off + e0); msc[2 * i + 1] = *(const v4f*)(mn + nsc_off + e0 + 4); msh[2 * i] = *(const v4f*)(mn + nsh_off + e0); msh[2 * i + 1] = *(const v4f*)(mn + nsh_off + e0 + 4); } } }
        const bf16_t* xr = X1 + (size_t)tok * 1024 + lane * 8; const bf16_t* fr = F + (size_t)tok * 1024 + lane * 8;
        float v[16]; float s = 0.f;
#pragma unroll
        for (int i = 0; i < 2; ++i) {
            v4f x0, x1; ld8(xr + i * 512, x0, x1); const v4u fw = *(const v4u*)(fr + i * 512);
            const v4f f0 = {bflo(fw.x), bfhi(fw.x), bflo(fw.y), bfhi(fw.y)}, f1 = {bflo(fw.z), bfhi(fw.z), bflo(fw.w), bfhi(fw.w)};
#pragma unroll
            for (int c = 0; c < 4; ++c) { v[i * 8 + c] = DN_ALPHA * x0[c] + mg[2 * i][c] * f0[c]; v[i * 8 + 4 + c] = DN_ALPHA * x1[c] + mg[2 * i + 1][c] * f1[c]; } }
#pragma unroll
        for (int c = 0; c < 16; ++c) s += v[c];
        const float mu = wave_sum(s) * (1.f / 1024.f);
        float qq = 0.f;
#pragma unroll
        for (int c = 0; c < 16; ++c) { v[c] -= mu; qq += v[c] * v[c]; }
        const float rstd = rsqrtf(wave_sum(qq) * (1.f / 1024.f) + LN_EPS);
        TO* xo = XO + (size_t)tok * 1024 + lane * 8;
#pragma unroll
        for (int i = 0; i < 2; ++i) {
            v4f o0, o1;
#pragma unroll
            for (int c = 0; c < 4; ++c) { o0[c] = v[i * 8 + c] * rstd * ga[2 * i][c] + ba[2 * i][c]; o1[c] = v[i * 8 + 4 + c] * rstd * ga[2 * i + 1][c] + ba[2 * i + 1][c]; }
            st8(xo + i * 512, o0, o1);
            if (HAo) {
                const v4f y0 = o0 * (msc[2 * i] + 1.f) + msh[2 * i], y1 = o1 * (msc[2 * i + 1] + 1.f) + msh[2 * i + 1];
#pragma unroll
                for (int c = 0; c < 4; ++c) { v[i * 8 + c] = y0[c]; v[i * 8 + 4 + c] = y1[c]; } }
        }
        if (HAo) {
            float mx = 0.f;
#pragma unroll
            for (int c = 0; c < 16; ++c) mx = fmaxf(mx, fabsf(v[c]));
            mx = fmaxf(wave_max(mx), 1e-30f);
            const float inv = 127.f / mx;
            if (lane == 0) SA[tok] = mx * (1.f / 127.f);
#pragma unroll
            for (int i = 0; i < 2; ++i) { v2u o; o.x = q8pack4(v[i * 8], v[i * 8 + 1], v[i * 8 + 2], v[i * 8 + 3], inv); o.y = q8pack4(v[i * 8 + 4], v[i * 8 + 5], v[i * 8 + 6], v[i * 8 + 7], inv);
                *(v2u*)(HAo + (size_t)tok * 1024 + i * 512 + lane * 8) = o; }
        }
        if (WG) {
#pragma unroll 1
            for (int gq = 0; gq < 4; ++gq) {
                float gp[4];
#pragma unroll
                for (int m = 0; m < 4; ++m) { const LAS float* wr = wgT + (gq * 4 + m) * 1024 + lane * 8; float a = 0.f;
#pragma unroll
                    for (int i = 0; i < 2; ++i) { const v4f w0 = *(const LAS v4f*)(wr + i * 512), w1 = *(const LAS v4f*)(wr + i * 512 + 4);
#pragma unroll
                        for (int c = 0; c < 4; ++c) a += v[i * 8 + c] * w0[c] + v[i * 8 + 4 + c] * w1[c]; }
                    gp[m] = a; }
                float g2[2], g1;
                { const bool up = (lane & 32) != 0;
#pragma unroll
                  for (int m = 0; m < 2; ++m) { const float snd = up ? gp[m] : gp[m + 2], kp = up ? gp[m + 2] : gp[m]; g2[m] = kp + __shfl_xor(snd, 32); } }
                { const bool up = (lane & 16) != 0; const float snd = up ? g2[0] : g2[1], kp = up ? g2[1] : g2[0]; g1 = kp + __shfl_xor(snd, 16); }
                g1 += __shfl_xor(g1, 8); g1 += __shfl_xor(g1, 4); g1 += __shfl_xor(g1, 2); g1 += __shfl_xor(g1, 1);
                if ((lane & 15) == 0) GT[(size_t)tok * 16 + gq * 4 + ((lane >> 5) & 1) * 2 + ((lane >> 4) & 1)] = g1;
            }
        }
    }
}


__device__ __forceinline__ void ph_mixab(const bf16_t* Z, const float* conv_w, const float* conv_b, const float* cln_g, const float* cln_b, signed char* MIX8, float* SA,
                                         LAS unsigned char* lds, int tid, int lane, int wave, int vcu, int G) {
    LAS float* ybuf = (LAS float*)lds;
    LAS bf16_t* ul = (LAS bf16_t*)(lds + 32768);
    LAS bf16_t* zl = (LAS bf16_t*)(lds + 32768 + 47104);
    LAS float* pdl = (LAS float*)(lds + 32768 + 47104 + 32768);
    const int c = tid;
    float w[31];
#pragma unroll
    for (int k = 0; k < 31; ++k) w[k] = conv_w[k * 512 + c];
    const float cb = conv_b[c];
    const int pw = 1 << (c >> 7);
    const v4f lg0 = *(const v4f*)(cln_g + lane * 8), lg1 = *(const v4f*)(cln_g + lane * 8 + 4), lb0 = *(const v4f*)(cln_b + lane * 8), lb1 = *(const v4f*)(cln_b + lane * 8 + 4);
    v4u pu[6], pz[4];
    auto tile_load = [&](int unit_) { const int r0_ = unit_ * 16, t0_ = row_t(r0_), T_ = row_T(r0_);
#pragma unroll
        for (int q = 0; q < 6; ++q) { const int it = tid + q * NTHR, i = it >> 6, ch = it & 63, t = t0_ - 15 + i; pu[q] = (v4u){0u, 0u, 0u, 0u};
            if (it < 46 * 64 && t >= 0 && t < T_) pu[q] = *(const v4u*)(Z + (size_t)(r0_ - 15 + i) * 1024 + 512 + ch * 8); }
#pragma unroll
        for (int q = 0; q < 4; ++q) { const int it = tid + q * NTHR, i = it >> 6, ch = it & 63, t = t0_ - 8 + i; pz[q] = (v4u){0u, 0u, 0u, 0u};
            if (t >= 0 && t < T_) pz[q] = *(const v4u*)(Z + (size_t)(r0_ - 8 + i) * 1024 + ch * 8); } };
    if (vcu < MT / 16) tile_load(vcu);
    for (int unit = vcu; unit < MT / 16; unit += G) {
        const int r0 = unit * 16, t0 = row_t(r0), T = row_T(r0);
        __syncthreads();
#pragma unroll
        for (int q = 0; q < 6; ++q) { const int it = tid + q * NTHR; if (it < 46 * 64) *(LAS v4u*)(ul + (it >> 6) * 512 + (it & 63) * 8) = pu[q]; }
#pragma unroll
        for (int q = 0; q < 4; ++q) { const int it = tid + q * NTHR; *(LAS v4u*)(zl + (it >> 6) * 512 + (it & 63) * 8) = pz[q]; }
        if (unit + G < MT / 16) tile_load(unit + G);
        __syncthreads();
        {
            float s = 0.f;
            for (int jj = 8 - pw; jj < 8 + pw; ++jj) s += bf2f(zl[jj * 512 + c]);
            bf16_t zc[16], zp[16], zm[16];
#pragma unroll
            for (int o = 0; o < 16; ++o) { zc[o] = zl[(o + 8) * 512 + c]; zp[o] = zl[(o + 8 + pw) * 512 + c]; zm[o] = zl[(o + 8 - pw) * 512 + c]; }
            LDS_WAIT();
#pragma unroll
            for (int o = 0; o < 16; ++o) {
                const int t = t0 + o; const int lo = t - pw < 0 ? 0 : t - pw, hi = t + pw > T ? T : t + pw;
                pdl[o * 512 + c] = s * __builtin_amdgcn_rcpf((float)(hi - lo)) - bf2f(zc[o]);
                s += bf2f(zp[o]) - bf2f(zm[o]);
            }
        }
        bf16_t ur[46];
#pragma unroll
        for (int i = 0; i < 46; ++i) ur[i] = ul[i * 512 + c];
        LDS_WAIT();
        float win[31];
#pragma unroll
        for (int i = 0; i < 46; ++i) {
            win[i % 31] = bf2f(ur[i]);
            if (i >= 30) { const int o = i - 30; float y = cb;
#pragma unroll
                for (int k = 0; k < 31; ++k) y += w[k] * win[(o + k) % 31];
                ybuf[o * 512 + c] = y; }
        }
        __syncthreads();
#pragma unroll
        for (int rr = 0; rr < 2; ++rr) { const int o = wave * 2 + rr;
            const v4f y0 = *(const LAS v4f*)(ybuf + o * 512 + lane * 8), y1 = *(const LAS v4f*)(ybuf + o * 512 + lane * 8 + 4);
            float s = (y0[0] + y0[1]) + (y0[2] + y0[3]) + (y1[0] + y1[1]) + (y1[2] + y1[3]);
            const float mu = wave_sum(s) * (1.f / 512.f);
            const v4f d0 = y0 - mu, d1 = y1 - mu;
            float q = (d0[0] * d0[0] + d0[1] * d0[1]) + (d0[2] * d0[2] + d0[3] * d0[3]) + (d1[0] * d1[0] + d1[1] * d1[1]) + (d1[2] * d1[2] + d1[3] * d1[3]);
            const float rstd = rsqrtf(wave_sum(q) * (1.f / 512.f) + LN_EPS);
            const v4f g0 = lg0, g1 = lg1, b0 = lb0, b1 = lb1;
            float yn[8];
#pragma unroll
            for (int i = 0; i < 4; ++i) { yn[i] = d0[i] * rstd * g0[i] + b0[i]; yn[4 + i] = d1[i] * rstd * g1[i] + b1[i]; }
#pragma unroll
            for (int i = 0; i < 8; ++i) yn[i] = yn[i] * __builtin_amdgcn_rcpf(1.f + __expf(-yn[i]));
            const v4f p0 = *(const LAS v4f*)(pdl + o * 512 + lane * 8), p1 = *(const LAS v4f*)(pdl + o * 512 + lane * 8 + 4);
            float mx = fmaxf(fmaxf(fmaxf(fabsf(p0[0]), fabsf(p0[1])), fmaxf(fabsf(p0[2]), fabsf(p0[3]))), fmaxf(fmaxf(fabsf(p1[0]), fabsf(p1[1])), fmaxf(fabsf(p1[2]), fabsf(p1[3]))));
#pragma unroll
            for (int i = 0; i < 8; ++i) mx = fmaxf(mx, fabsf(yn[i]));
            mx = fmaxf(wave_max(mx), 1e-30f);
            const float inv = 127.f / mx;
            if (lane == 0) SA[r0 + o] = mx * (1.f / 127.f);
            v2u op, oy; op.x = q8pack4(p0[0], p0[1], p0[2], p0[3], inv); op.y = q8pack4(p1[0], p1[1], p1[2], p1[3], inv);
            oy.x = q8pack4(yn[0], yn[1], yn[2], yn[3], inv); oy.y = q8pack4(yn[4], yn[5], yn[6], yn[7], inv);
            *(v2u*)(MIX8 + (size_t)(r0 + o) * 1024 + lane * 8) = op; *(v2u*)(MIX8 + (size_t)(r0 + o) * 1024 + 512 + lane * 8) = oy; }
    }
}
struct LnRow { v4u xw[4]; v4u y[2]; };
template <class TX>
__device__ __forceinline__ void ln1_load(LnRow& R, const TX* xl, const TX* xc, const bf16_t* Y, int r, int lane) {
    const TX* xr = r < ML ? xl + (size_t)r * D : xc + (size_t)(r - ML) * D;
#pragma unroll
    for (int i = 0; i < 2; ++i) { const int e0 = i * 512 + lane * 8;
        if constexpr (sizeof(TX) == 4) { R.xw[2 * i] = *(const v4u*)(xr + e0); R.xw[2 * i + 1] = *(const v4u*)(xr + e0 + 4); } else { R.xw[i] = *(const v4u*)(xr + e0); R.xw[2 + i] = (v4u){0u, 0u, 0u, 0u}; }
        R.y[i] = *(const v4u*)(Y + (size_t)r * D + e0); }
}
template <class TX, class TO>
__device__ __forceinline__ void ph_ln1(const TX* xl, const TX* xc, const bf16_t* Y, const float* modl, int gate_off, const float* lng, const float* lnb,
                                       TO* XO, bf16_t* HAo, signed char* H8, float* HSC, int sh_off, int sc_off, int r0  , int per  , LAS unsigned char* lds, int tid, int lane, int wave, signed char* HA8o = nullptr, float* SAo = nullptr) {
    const int K = (per - wave + 7) >> 3;
    v4f ga[4], ba[4];
#pragma unroll
    for (int i = 0; i < 2; ++i) { const int e0 = i * 512 + lane * 8; ga[2 * i] = *(const v4f*)(lng + e0); ga[2 * i + 1] = *(const v4f*)(lng + e0 + 4); ba[2 * i] = *(const v4f*)(lnb + e0); ba[2 * i + 1] = *(const v4f*)(lnb + e0 + 4); }
    LAS float* P = (LAS float*)lds;
    const int mrA = row_mod(r0), mrB = row_mod(r0 + per - 1);
    __syncthreads();
    for (int i = tid; i < 6144; i += NTHR) { const int sI = i / 3072, w = (i % 3072) >> 10, e = i & 1023; const float* mm = modl + (sI ? mrB : mrA) * 6144;
        P[i] = w == 0 ? mm[gate_off + e] : (w == 1 ? mm[sc_off + e] + 1.f : mm[sh_off + e]); }
    __syncthreads();
    LnRow A, B;
    auto proc = [&](const LnRow& R, int r) {
        const LAS float* ps = P + (row_mod(r) != mrA ? 3072 : 0);
        float v[16], hq[16]; float s = 0.f;
#pragma unroll
        for (int i = 0; i < 2; ++i) { const v4u yy = R.y[i];
            const float yf[8] = {bflo(yy.x), bfhi(yy.x), bflo(yy.y), bfhi(yy.y), bflo(yy.z), bfhi(yy.z), bflo(yy.w), bfhi(yy.w)};
            v4f x0, x1;
            if constexpr (sizeof(TX) == 4) { x0 = __builtin_bit_cast(v4f, R.xw[2 * i]); x1 = __builtin_bit_cast(v4f, R.xw[2 * i + 1]); }
            else { const v4u xx = R.xw[i]; x0 = (v4f){bflo(xx.x), bfhi(xx.x), bflo(xx.y), bfhi(xx.y)}; x1 = (v4f){bflo(xx.z), bfhi(xx.z), bflo(xx.w), bfhi(xx.w)}; }
            const v4f g0 = *(const LAS v4f*)(ps + i * 512 + lane * 8), g1 = *(const LAS v4f*)(ps + i * 512 + lane * 8 + 4);
#pragma unroll
            for (int c = 0; c < 4; ++c) { v[i * 8 + c] = DN_ALPHA * x0[c] + g0[c] * yf[c]; v[i * 8 + 4 + c] = DN_ALPHA * x1[c] + g1[c] * yf[4 + c]; } }
#pragma unroll
        for (int c = 0; c < 16; ++c) s += v[c];
        const float mu = wave_sum(s) * (1.f / 1024.f);
        float qq = 0.f;
#pragma unroll
        for (int c = 0; c < 16; ++c) { v[c] -= mu; qq += v[c] * v[c]; }
        const float rstd = rsqrtf(wave_sum(qq) * (1.f / 1024.f) + LN_EPS);
#pragma unroll
        for (int i = 0; i < 2; ++i) { const int e0 = i * 512 + lane * 8;
            v4f o0, o1;
#pragma unroll
            for (int c = 0; c < 4; ++c) { o0[c] = v[i * 8 + c] * rstd * ga[2 * i][c] + ba[2 * i][c]; o1[c] = v[i * 8 + 4 + c] * rstd * ga[2 * i + 1][c] + ba[2 * i + 1][c]; }
            st8(XO + (size_t)r * 1024 + e0, o0, o1);
            const v4f s0 = *(const LAS v4f*)(ps + 1024 + e0), s1 = *(const LAS v4f*)(ps + 1024 + e0 + 4), h0 = *(const LAS v4f*)(ps + 2048 + e0), h1 = *(const LAS v4f*)(ps + 2048 + e0 + 4);
            const v4f y0 = o0 * s0 + h0, y1 = o1 * s1 + h1;
            if (!HA8o) st8(HAo + (size_t)r * 1024 + e0, y0, y1);
#pragma unroll
            for (int c = 0; c < 4; ++c) { hq[i * 8 + c] = y0[c]; hq[i * 8 + 4 + c] = y1[c]; } }
        float mx = 0.f;
#pragma unroll
        for (int c = 0; c < 16; ++c) mx = fmaxf(mx, fabsf(hq[c]));
        mx = fmaxf(wave_max(mx), 1e-30f);
        const float inv = 127.f / mx;
        int isum = 0;
#pragma unroll
        for (int i = 0; i < 2; ++i) { unsigned wh = 0u, wl = 0u; v2u wb = {0u, 0u};
#pragma unroll
            for (int c = 0; c < 8; ++c) { int qv = __float2int_rn(hq[i * 8 + c] * inv); qv = qv > 127 ? 127 : (qv < -127 ? -127 : qv); isum += qv;
                wb[c >> 2] |= (unsigned)(qv & 255) << (8 * (c & 3));
                const unsigned u = (unsigned)(qv + 128); const unsigned nh = ((u >> 4) - 8u) & 15u, nl = ((u & 15u) - 8u) & 15u;
                const int sh = (c & 3) * 8 + (c >> 2) * 4;
                wh |= nh << sh; wl |= nl << sh; }
            *(unsigned*)(H8 + (size_t)r * 1024 + (i * 64 + lane) * 4) = wh;
            if (HA8o) *(v2u*)(HA8o + (size_t)r * 1024 + i * 512 + lane * 8) = wb;
            *(unsigned*)(H8 + (size_t)r * 1024 + 512 + (i * 64 + lane) * 4) = wl; }
        const float hsum = wave_sum((float)isum), hsc = mx * (1.f / 127.f);
        if (lane == 0) { HSC[2 * r] = hsc; HSC[2 * r + 1] = 0.5f * hsum; if (SAo) SAo[r] = hsc; }
    };
    if (K > 0) {
        ln1_load(A, xl, xc, Y, r0 + wave, lane);
        for (int k = 0; k < K; k += 2) {
            ln1_load(B, xl, xc, Y, r0 + wave + 8 * (k + 1 < K ? k + 1 : K - 1), lane); proc(A, r0 + wave + 8 * k);
            ln1_load(A, xl, xc, Y, r0 + wave + 8 * (k + 2 < K ? k + 2 : K - 1), lane); if (k + 1 < K) proc(B, r0 + wave + 8 * (k + 1));
        }
    }
    __syncthreads();
}

namespace ml {
constexpr int LP = 272;
constexpr float KS = 0.08838834764831845f;
__device__ __forceinline__ int chunk_row0(int b, int c) { return c < 2 ? ML + b * CTX + c * 128 : b * SEQ + (c - 2) * 128; }
__device__ __forceinline__ float logsig(float x) { return fminf(x, 0.f) - log1pf(__expf(-fabsf(x))); }
__device__ __forceinline__ void load_T(const bf16_t* src  , LAS unsigned char* dst, int tid) {
    const int j0 = tid & 63, part = tid >> 6;
#pragma unroll
    for (int jj = 0; jj < 2; ++jj)
#pragma unroll
        for (int cc = 0; cc < 2; ++cc) { const int j = j0 + 64 * jj, ch = part * 2 + cc;
            const v4u d = *(const v4u*)(src + (size_t)j * ZZP + ch * 8);
#pragma unroll
            for (int e = 0; e < 4; ++e) { *(LAS bf16_t*)(dst + (ch * 8 + 2 * e) * LP + j * 2) = (bf16_t)(d[e] & 0xffffu); *(LAS bf16_t*)(dst + (ch * 8 + 2 * e + 1) * LP + j * 2) = (bf16_t)(d[e] >> 16); } }
}
__device__ __forceinline__ void load_R(const bf16_t* src, int ld, LAS unsigned char* dst, int tid) {
#pragma unroll
    for (int it = 0; it < 4; ++it) { const int i = tid + it * NTHR, r = i >> 4, ch = i & 15; *(LAS v4u*)(dst + r * LP + ch * 16) = *(const v4u*)(src + (size_t)r * ld + ch * 8); }
}
__device__ __forceinline__ void gate_scan(const float* GT, int row0, int h, int dir, const float* gate_b, int lane, LAS float* bvec, LAS float* avec, LAS float* Avec, float& Btot, float& Alast) {
    const float bi = gate_b[(dir * 2) * 4 + h], bfg = gate_b[(dir * 2 + 1) * 4 + h];
    const int p0 = dir ? 127 - 2 * lane : 2 * lane, p1 = dir ? 126 - 2 * lane : 2 * lane + 1;
    const float* z0 = GT + (size_t)(row0 + p0) * 16 + h; const float* z1 = GT + (size_t)(row0 + p1) * 16 + h;
    const float ig0 = z0[(dir * 2) * 4] + bi, ig1 = z1[(dir * 2) * 4] + bi;
    const float l0 = logsig(z0[(dir * 2 + 1) * 4] + bfg), l1 = logsig(z1[(dir * 2 + 1) * 4] + bfg);
    float inc = l0 + l1;
#pragma unroll
    for (int d = 1; d < 64; d <<= 1) { const float t = __shfl_up(inc, d); if (lane >= d) inc += t; }
    const float b1 = inc, b0 = inc - l1;
    const float a0 = ig0 - b0, a1 = ig1 - b1;
    float mx = fmaxf(a0, a1);
#pragma unroll
    for (int d = 1; d < 64; d <<= 1) { const float t = __shfl_up(mx, d); if (lane >= d) mx = fmaxf(mx, t); }
    float ex = __shfl_up(mx, 1); if (lane == 0) ex = -3.0e38f;
    const float A0 = fmaxf(ex, a0), A1 = mx;
    bvec[p0] = b0; bvec[p1] = b1; avec[p0] = a0; avec[p1] = a1; Avec[p0] = A0; Avec[p1] = A1;
    Btot = __shfl(b1, 63); Alast = __shfl(A1, 63);
}
}

__device__ __forceinline__ void ph_mla(const bf16_t* ZZ, const float* GT, const float* gate_b, bf16_t* DCT, float* DN, float* STAT, LAS unsigned char* lds, int tid, int lane, int wave, int vcu, int G) {
    LAS unsigned char* KT = lds; LAS unsigned char* VT = lds + 128 * ml::LP;
    LAS float* vec = (LAS float*)(lds + 272 * ml::LP);
    for (int i = tid; i < 16 * ml::LP / 4; i += NTHR) ((LAS unsigned*)(VT + 128 * ml::LP))[i] = (i < ml::LP / 4) ? 0x3F803F80u : 0u;
    const int n = lane & 15, q4 = lane >> 4;
    for (int unit = vcu; unit < NB * 4 * 66; unit += G) {
        const int c = unit % 66, h = (unit / 66) & 3, b = unit / (66 * 4);
        const int row0 = ml::chunk_row0(b, c);
        __syncthreads();
        ml::load_T(ZZ + (size_t)row0 * ZZP + 512 + h * 128, KT, tid);
        ml::load_T(ZZ + (size_t)row0 * ZZP + 1024 + h * 128, VT, tid);
        if (wave < 2) { const int dir = wave; LAS float* v = vec + dir * 512; float Bt, Al;
            ml::gate_scan(GT, row0, h, dir, gate_b, lane, v, v + 128, v + 256, Bt, Al);
            v[384 + 2 * lane] = __expf(v[128 + 2 * lane] - Al) * ml::KS; v[385 + 2 * lane] = __expf(v[129 + 2 * lane] - Al) * ml::KS;
            const int chain = (b * 4 + h) * 2 + dir; if (lane == 0) { STAT[(chain * 66 + c) * 2] = Bt; STAT[(chain * 66 + c) * 2 + 1] = Al; } }
        __syncthreads();
#pragma unroll
        for (int dir = 0; dir < 2; ++dir) {
            const LAS float* wk = vec + dir * 512 + 384;
            s16x8 bk[4];
#pragma unroll
            for (int ks = 0; ks < 4; ++ks) { const v4u d = *(const LAS v4u*)(KT + (wave * 16 + n) * ml::LP + ks * 64 + q4 * 16);
                const v4f w0 = *(const LAS v4f*)(wk + ks * 32 + q4 * 8), w1 = *(const LAS v4f*)(wk + ks * 32 + q4 * 8 + 4);
                v4u o; o.x = pk2(bflo(d.x) * w0[0], bfhi(d.x) * w0[1]); o.y = pk2(bflo(d.y) * w0[2], bfhi(d.y) * w0[3]); o.z = pk2(bflo(d.z) * w1[0], bfhi(d.z) * w1[1]); o.w = pk2(bflo(d.w) * w1[2], bfhi(d.w) * w1[3]);
                bk[ks] = __builtin_bit_cast(s16x8, o); }
            const int chain = (b * 4 + h) * 2 + dir;
            bf16_t* dct = DCT + (size_t)(chain * 66 + c) * 16384;
#pragma unroll
            for (int t = 0; t < 9; ++t) {
                pg8::f32x4 acc = {0.f, 0.f, 0.f, 0.f};
#pragma unroll
                for (int ks = 0; ks < 4; ++ks) { const s16x8 av = *(const LAS s16x8*)(VT + (t * 16 + n) * ml::LP + ks * 64 + q4 * 16); acc = __builtin_amdgcn_mfma_f32_16x16x32_bf16(av, bk[ks], acc, 0, 0, 0); }
                if (t < 8) {
#pragma unroll
                    for (int r = 0; r < 4; ++r) dct[(size_t)(t * 16 + q4 * 4 + r) * 128 + wave * 16 + n] = f2bf(acc[r]);
                } else if (q4 == 0) DN[(size_t)(chain * 66 + c) * 128 + wave * 16 + n] = acc[0];
            }
        }
    }
}

struct MlsSlot { v4u x0, x1; float Bt, Al; };
template <bool ISN>
__device__ __forceinline__ void mls_chain(const bf16_t* DCT, const float* DN, const float* STAT, bf16_t* CTS, float* NS, float* MPREV, int chain, int off) {
    const int dir = chain & 1;
    auto cidx = [&](int s) { return dir ? (s < 2 ? 1 - s : 67 - s) : s; };
    auto ld = [&](MlsSlot& S, int s) { const int c = cidx(s < 66 ? s : 65); const size_t di = (size_t)chain * 66 + c;
        S.Bt = STAT[di * 2]; S.Al = STAT[di * 2 + 1];
        if (ISN) { S.x0 = *(const v4u*)(DN + di * 128 + off); S.x1 = *(const v4u*)(DN + di * 128 + off + 4); } else { S.x0 = *(const v4u*)(DCT + di * 16384 + off); S.x1 = S.x0; } };
    float acc[8];
#pragma unroll
    for (int e = 0; e < 8; ++e) acc[e] = 0.f;
    float m = 0.f;
    auto step = [&](const MlsSlot& S, int s, bool publish) { const int c = cidx(s);
        if (publish) { const size_t ci = (size_t)chain * 64 + (c - 2);
            if (ISN) { *(v4f*)(NS + ci * 128 + off) = (v4f){acc[0], acc[1], acc[2], acc[3]}; *(v4f*)(NS + ci * 128 + off + 4) = (v4f){acc[4], acc[5], acc[6], acc[7]}; if (off == 0) MPREV[ci] = m; }
            else { v4u o; o.x = pk2(acc[0], acc[1]); o.y = pk2(acc[2], acc[3]); o.z = pk2(acc[4], acc[5]); o.w = pk2(acc[6], acc[7]); *(v4u*)(CTS + ci * 16384 + off) = o; } }
        const float M = fmaxf(m, S.Al), decay = __expf(m - M), scale = __expf(S.Al - M);
        float d[8];
        if (ISN) { const v4f a0 = __builtin_bit_cast(v4f, S.x0), a1 = __builtin_bit_cast(v4f, S.x1);
#pragma unroll
            for (int e = 0; e < 4; ++e) { d[e] = a0[e]; d[4 + e] = a1[e]; } }
        else {
#pragma unroll
            for (int e = 0; e < 4; ++e) { d[2 * e] = bflo(S.x0[e]); d[2 * e + 1] = bfhi(S.x0[e]); } }
#pragma unroll
        for (int e = 0; e < 8; ++e) acc[e] = decay * acc[e] + scale * d[e];
        m = S.Bt + M; };
    MlsSlot A, B, C, E;
    ld(A, 0); ld(B, 1); ld(C, 2);
    ld(E, 3); step(A, 0, false);
    ld(A, 4); step(B, 1, false);
    for (int s = 2; s < 66; s += 4) {
        ld(B, s + 3); step(C, s, true);
        ld(C, s + 4); step(E, s + 1, true);
        ld(E, s + 5); step(A, s + 2, true);
        ld(A, s + 6); step(B, s + 3, true);
    }
}
__device__ __forceinline__ void ph_mls(const bf16_t* DCT, const float* DN, const float* STAT, bf16_t* CTS, float* NS, float* MPREV, int vcu, int tid) {
    if (tid < 256) { const int item = vcu * 256 + tid; mls_chain<false>(DCT, DN, STAT, CTS, NS, MPREV, item >> 11, (item & 2047) * 8); }
    else if (vcu < 2) { const int item = vcu * 256 + (tid - 256); mls_chain<true>(DCT, DN, STAT, CTS, NS, MPREV, item >> 4, (item & 15) * 8); }
}

__device__ __forceinline__ void ph_mlo(const bf16_t* ZZ, const float* GT, const float* gate_b, const float* norm_g, const bf16_t* CTS, const float* NS, const float* MPREV, bf16_t* MIX,
                                       LAS unsigned char* lds, int tid, int lane, int wave, int vcu, int G) {
    LAS unsigned char* QL = lds; LAS unsigned char* KL = lds + 128 * ml::LP; LAS unsigned char* VT = lds + 256 * ml::LP; LAS unsigned char* CT = lds + 400 * ml::LP;
    LAS float* vec0 = (LAS float*)(lds + 544 * ml::LP);
    for (int i = tid; i < 16 * ml::LP / 4; i += NTHR) { ((LAS unsigned*)(VT + 128 * ml::LP))[i] = (i < ml::LP / 4) ? 0x3F803F80u : 0u; ((LAS unsigned*)(CT + 128 * ml::LP))[i] = 0u; }
    const int n = lane & 15, q4 = lane >> 4;
    for (int unit = vcu; unit < NB * 4 * 64; unit += G) {
        const int cl = unit & 63, h = (unit >> 6) & 3, b = unit >> 8;
        const int row0 = b * SEQ + cl * 128;
        __syncthreads();
        ml::load_R(ZZ + (size_t)row0 * ZZP + h * 128, ZZP, QL, tid);
        ml::load_R(ZZ + (size_t)row0 * ZZP + 512 + h * 128, ZZP, KL, tid);
        ml::load_T(ZZ + (size_t)row0 * ZZP + 1024 + h * 128, VT, tid);
        if (wave < 2) { const int dir = wave; LAS float* v = vec0 + dir * 768; float Bt, Al;
            ml::gate_scan(GT, row0, h, dir, gate_b, lane, v, v + 128, v + 256, Bt, Al);
            const float mp = MPREV[(size_t)((b * 4 + h) * 2 + dir) * 64 + cl];
#pragma unroll
            for (int e = 0; e < 2; ++e) { const int p = 2 * lane + e; const float M = fmaxf(mp, v[256 + p]); v[384 + p] = M; v[512 + p] = __expf(mp - M); v[640 + p] = __expf(-v[p] - M); } }
        pg8::f32x4 hs[8];
#pragma unroll
        for (int t = 0; t < 8; ++t) hs[t] = (pg8::f32x4){0.f, 0.f, 0.f, 0.f};
        float ngv[8];
#pragma unroll
        for (int t = 0; t < 8; ++t) ngv[t] = norm_g[h * 128 + t * 16 + n];
        bf16_t omv[4][8];
#pragma unroll
        for (int r = 0; r < 4; ++r)
#pragma unroll
            for (int t = 0; t < 8; ++t) omv[r][t] = ZZ[(size_t)(row0 + wave * 16 + q4 * 4 + r) * ZZP + 1536 + h * 128 + t * 16 + n];
#pragma unroll
        for (int dir = 0; dir < 2; ++dir) {
            const int chain = (b * 4 + h) * 2 + dir; const size_t ci = (size_t)chain * 64 + cl;
            if (dir) __syncthreads();
            ml::load_R(CTS + ci * 16384, 128, CT, tid);
            if (tid < 128) *(LAS bf16_t*)(CT + 128 * ml::LP + tid * 2) = f2bf(NS[ci * 128 + tid]);
            __syncthreads();
            const LAS float* vec = vec0 + dir * 768;
            s16x8 qf[4];
#pragma unroll
            for (int ks = 0; ks < 4; ++ks) qf[ks] = *(const LAS s16x8*)(QL + (wave * 16 + n) * ml::LP + ks * 64 + q4 * 16);
            const int i_row = wave * 16 + n; const float Mi = vec[384 + i_row];
            s16x8 pf[4];
#pragma unroll
            for (int T2 = 0; T2 < 4; ++T2) { unsigned pk[4];
#pragma unroll
                for (int hh = 0; hh < 2; ++hh) { const int T = T2 * 2 + hh;
                    pg8::f32x4 acc = {0.f, 0.f, 0.f, 0.f};
#pragma unroll
                    for (int ks = 0; ks < 4; ++ks) { const s16x8 kf = *(const LAS s16x8*)(KL + (T * 16 + n) * ml::LP + ks * 64 + q4 * 16); acc = __builtin_amdgcn_mfma_f32_16x16x32_bf16(kf, qf[ks], acc, 0, 0, 0); }
                    const v4f aj = *(const LAS v4f*)(vec + 128 + T * 16 + q4 * 4);
                    float pv[4];
#pragma unroll
                    for (int r = 0; r < 4; ++r) { const int j = T * 16 + q4 * 4 + r; const bool ok = dir ? (j >= i_row) : (j <= i_row); pv[r] = ok ? acc[r] * ml::KS * __expf(aj[r] - Mi) : 0.f; }
                    pk[hh * 2] = pk2(pv[0], pv[1]); pk[hh * 2 + 1] = pk2(pv[2], pv[3]); }
                pf[T2] = __builtin_bit_cast(s16x8, (v4u){pk[0], pk[1], pk[2], pk[3]}); }
            const v4f wi = *(const LAS v4f*)(vec + 512 + wave * 16 + q4 * 4), bd = *(const LAS v4f*)(vec + 640 + wave * 16 + q4 * 4);
            pg8::f32x4 o[9];
#pragma unroll
            for (int t = 0; t < 9; ++t) {
                pg8::f32x4 acc = {0.f, 0.f, 0.f, 0.f};
#pragma unroll
                for (int ks = 0; ks < 4; ++ks) { const s16x8 cf = *(const LAS s16x8*)(CT + (t * 16 + n) * ml::LP + ks * 64 + q4 * 16); acc = __builtin_amdgcn_mfma_f32_16x16x32_bf16(qf[ks], cf, acc, 0, 0, 0); }
                acc = acc * wi;
#pragma unroll
                for (int T2 = 0; T2 < 4; ++T2) { const v2u lo = *(const LAS v2u*)(VT + (t * 16 + n) * ml::LP + T2 * 64 + q4 * 8), hi = *(const LAS v2u*)(VT + (t * 16 + n) * ml::LP + T2 * 64 + 32 + q4 * 8);
                    const s16x8 vf = __builtin_bit_cast(s16x8, (v4u){lo.x, lo.y, hi.x, hi.y});
                    acc = __builtin_amdgcn_mfma_f32_16x16x32_bf16(pf[T2], vf, acc, 0, 0, 0); }
                o[t] = acc;
            }
#pragma unroll
            for (int r = 0; r < 4; ++r) { const float den = __shfl(o[8][r], lane & 48); const float rd = 1.f / fmaxf(fabsf(den), bd[r]);
#pragma unroll
                for (int t = 0; t < 8; ++t) hs[t][r] += o[t][r] * rd; }
        }
#pragma unroll
        for (int r = 0; r < 4; ++r) {
            float s = 0.f;
#pragma unroll
            for (int t = 0; t < 8; ++t) s += hs[t][r];
            s += DPP_F(s, 0xB1); s += DPP_F(s, 0x4E); s += DPP_F(s, 0x141); s += DPP_F(s, 0x140);
            const float mu = s * (1.f / 128.f); float qv = 0.f;
#pragma unroll
            for (int t = 0; t < 8; ++t) { const float d = hs[t][r] - mu; qv += d * d; }
            qv += DPP_F(qv, 0xB1); qv += DPP_F(qv, 0x4E); qv += DPP_F(qv, 0x141); qv += DPP_F(qv, 0x140);
            const float rstd = rsqrtf(qv * (1.f / 128.f) + LN_EPS);
            const int row = row0 + wave * 16 + q4 * 4 + r;
#pragma unroll
            for (int t = 0; t < 8; ++t) { const int dv = t * 16 + n; const float om = bf2f(omv[r][t]);
                MIX[(size_t)row * 1024 + h * 128 + dv] = f2bf((hs[t][r] - mu) * rstd * ngv[t] / (1.f + __expf(-om))); }
        }
    }
}


constexpr int N_PHASES = 18;
constexpr int CW_BAR = 1024;
constexpr int MISC_OFF = LDS_BYTES - 64;

struct OneTile { int pm, pn;
    __device__ __forceinline__ bool next(int i, pg8::Unit& u) const { if (i > 0) return false; u.pm = pm; u.pn = pn; return true; }
    __device__ __forceinline__ void a_ready(const pg8::Unit&) const {}
    __device__ __forceinline__ void done(const pg8::Unit&) const {} };

struct Args { const float* in[26]; float* out; unsigned char* ws; int ph_lo, ph_hi, pad0, pad1; };

__global__ void __launch_bounds__(NTHR, 2) mk(Args a) {
    extern __shared__ __attribute__((aligned(16))) unsigned char lds_raw[];
    LAS unsigned char* lds = (LAS unsigned char*)lds_raw;
    const int tid = threadIdx.x, lane = tid & 63, wave = __builtin_amdgcn_readfirstlane(tid >> 6);
    const int G = gridDim.x, bx = blockIdx.x;
    const int vcu = (G % 8 == 0) ? (bx % 8) * (G / 8) + bx / 8 : bx;
    const int gw = vcu * NWAVES + wave, NGW = G * NWAVES;
    unsigned char* ws = a.ws;
    const float* mod = (const float*)(ws + WS_MOD);
    bf16_t* XS = (bf16_t*)(ws + WS_XS);   bf16_t* HA = (bf16_t*)(ws + WS_HA); signed char* HA8 = (signed char*)(ws + WS_HA); float* SA = (float*)(ws + WS_SA); const unsigned* CMX = (const unsigned*)(ws + WS_CTL) + CW_CMAX; bf16_t* ZB = (bf16_t*)(ws + WS_ZB);
    bf16_t* MIX = (bf16_t*)a.out;
    unsigned* IDXG = (unsigned*)(ws + WS_IDXG);
    const unsigned char* UQ = ws + WS_TAB; const unsigned char* VQ = ws + WS_TAB + TAB_VQ; const float* SU = (const float*)(ws + WS_SU);
    signed char* H8 = (signed char*)(ws + WS_ZB + 133 * MiB); float* HSC = (float*)(ws + WS_ZB + 170 * MiB); bf16_t* FB = (bf16_t*)(ws + WS_ZB); float* GT = (float*)((unsigned char*)a.out + 116 * MiB);
    bf16_t* QA = (bf16_t*)((unsigned char*)a.out + 66 * MiB); bf16_t* KA = (bf16_t*)((unsigned char*)a.out + 98 * MiB); bf16_t* VA = (bf16_t*)((unsigned char*)a.out + 107 * MiB);
    bf16_t* DCT = HA; bf16_t* CTS = (bf16_t*)(ws + WS_TAB);
    float* DN = (float*)(ws + WS_IDXG); float* STAT = (float*)(ws + WS_IDXG + 2 * MiB); float* NS = (float*)(ws + WS_IDXG + 3 * MiB); float* MPREV = (float*)(ws + WS_IDXG + 5 * MiB);

    const int lo = a.ph_lo, hi = a.ph_hi;
    const bool multi = (hi - lo) > 1;
    XcdBarrier bar; bar.bar = (unsigned*)(ws + WS_CTL) + CW_BAR; bar.x = 0; bar.st = nullptr;
    if (multi) {
        if (tid < 16) ((LAS unsigned*)(lds + MISC_OFF))[tid] = 0u;
        __syncthreads();
        bar = xcd_barrier_post((unsigned*)(ws + WS_CTL) + CW_BAR, (volatile LAS unsigned*)(lds + MISC_OFF));
    }
#ifndef GEMM_ALIGN
#define GEMM_ALIGN true
#endif
#ifndef GEMM_SP2
#define GEMM_SP2 true
#endif
#define GEMM_PHASE(Aptr, Wptr, Mrows, Ncols, Optr, ldc_, nvalid_) do { \
        pg8::Gemm g{(Aptr), (const bf16_t*)(Wptr), (Mrows), (Ncols), 1024}; EpiStore E{(Optr), (ldc_), (nvalid_)}; \
        pg8::StaticOrder S; S.init((Mrows), (Ncols), G, bx); \
        pg8::gemm_phase<EpiStore, pg8::StaticOrder, GEMM_ALIGN, GEMM_SP2>(lds, g, S, E); } while (0)

#ifndef PROBE_MASK
#define PROBE_MASK 0
#endif
#define GEMM8_PHASE(A8ptr, Wptr, Mrows, Ncols, Optr, ldc_, cm_) do { \
        pg8::Gemm g{(const bf16_t*)(A8ptr), (const bf16_t*)(Wptr), (Mrows), (Ncols), 512}; EpiStoreI8 E{(Optr), (ldc_), (Ncols), SA, CMX + (cm_)}; \
        pg8::StaticOrder S; S.init((Mrows), (Ncols), G, bx); \
        pg8::gemm_phase<EpiStoreI8, pg8::StaticOrder, GEMM_ALIGN, GEMM_SP2, true>(lds, g, S, E); } while (0)
#define IN(k) (lo <= (k) && (k) < hi)
#ifndef PROBE_REPS
#define PROBE_REPS 2
#endif
#define REP(k) for (int rep_ = 0; rep_ < (((PROBE_MASK >> (k)) & 1) ? PROBE_REPS : 1); ++rep_)
#ifndef BAR_REP
#define BAR_REP 1
#endif
#define SEAM(k) do { if (IN(k) && IN((k) + 1)) { for (int br_ = 0; br_ < BAR_REP; ++br_) xcd_barrier(bar); } } while (0)
    if (IN(0)) REP(0) { ph_prologue(a.in, ws, lds, tid, lane, wave, gw, NGW, rep_); } SEAM(0);
    if (IN(1)) REP(1) { ph_moda(a.in[0], a.in[2], mod, 0, 1024, HA8, SA, MT, lane, wave, vcu, G);
                 ph_w8(a.in, ws, lds, lane, wave, gw, NGW);
                 ph_tables(a.in, ws, 0, gw, NGW, lane); } SEAM(1);
    if (IN(2)) REP(2) { pg8::Gemm g{(const bf16_t*)HA8, (const bf16_t*)(ws + WS_W_IN), MT, AB_IN, 512}; EpiGlu E{ZB, SA, CMX + CM_WIN};
                 pg8::StaticOrder S; S.init(MT, AB_IN, G, bx);
                 pg8::gemm_phase<EpiGlu, pg8::StaticOrder, GEMM_ALIGN, GEMM_SP2, true>(lds, g, S, E); } SEAM(2);
    if (IN(3)) REP(3) { ph_mixab(ZB, a.in[11], a.in[12], a.in[13], a.in[14], (signed char*)a.out, SA, lds, tid, lane, wave, vcu, G); } SEAM(3);
    if (IN(4)) { GEMM8_PHASE(a.out, ws + WS_W_OUT8, ML, 1024, ZB, 1024, CM_WOUT); } SEAM(4);
    if (IN(5)) {
        unsigned* tflag = (unsigned*)(ws + WS_CTL) + 16000;
        if (vcu < 240) ph_ln1<float, bf16_t>(a.in[0], a.in[2], ZB, mod, 2048, a.in[6], a.in[7], XS, HA, H8, HSC, 3072, 4096, 135 * vcu, 135, lds, tid, lane, wave, HA8, SA);
        else { const int j = vcu - 240;
            { pg8::Gemm g{(const bf16_t*)a.out, (const bf16_t*)(ws + WS_W_OUT8), MT, 1024, 512}; EpiStoreI8 E{ZB, 1024, 1024, SA, CMX + CM_WOUT}; OneTile S{128 + (j >> 2), j & 3};
              pg8::gemm_phase<EpiStoreI8, OneTile, GEMM_ALIGN, GEMM_SP2, true>(lds, g, S, E); }
            asm volatile("s_waitcnt vmcnt(0)" ::: "memory"); __syncthreads();
            if (tid == 0) { __builtin_amdgcn_fence(__ATOMIC_RELEASE, "agent"); asm volatile("s_waitcnt vmcnt(0)" ::: "memory"); atomicAdd(tflag, 1u); }
            ph_ln1<float, bf16_t>(a.in[0], a.in[2], ZB, mod, 2048, a.in[6], a.in[7], XS, HA, H8, HSC, 3072, 4096, 32400 + 23 * j, 23, lds, tid, lane, wave, HA8, SA);
            if (tid == 0) { unsigned spins = 0; while (__hip_atomic_load(tflag, __ATOMIC_RELAXED, __HIP_MEMORY_SCOPE_AGENT) < 16u && ++spins < (1u << 22)) __builtin_amdgcn_s_sleep(8); }
            __syncthreads(); __builtin_amdgcn_fence(__ATOMIC_ACQUIRE, "agent"); asm volatile("s_waitcnt vmcnt(0)" ::: "memory");
            ph_ln1<float, bf16_t>(a.in[0], a.in[2], ZB, mod, 2048, a.in[6], a.in[7], XS, HA, H8, HSC, 3072, 4096, 32768 + 64 * j, 64, lds, tid, lane, wave, HA8, SA);
        }
    } SEAM(5);
    if (IN(6)) REP(6) { GEMM8_PHASE(HA8, ws + WS_WQ, MT, 2048, ZB, 2048, CM_WQ0); } SEAM(6);
    if (IN(7)) REP(7) { ph_route(ZB, a.in[23], IDXG, MT, lds, tid, lane, wave, vcu, G); }
    if (IN(7) && IN(8)) { asm volatile("s_waitcnt vmcnt(0)" ::: "memory"); __syncthreads(); }
    if (IN(8)) REP(8) { ph_gather<bf16_t>(XS, H8, HSC, IDXG, UQ, SU, VQ, FB, mod, 5120, a.in[6] + 1024, a.in[7] + 1024, XS, HA8, SA, mod + 5 * 6144, 0, 1024, a.in[16] + 2048, CMX + CM_GATE, GT, MT, lds, tid, lane, wave, vcu, G); } SEAM(8);
    if (IN(9)) REP(9) { GEMM8_PHASE(HA8, ws + WS_CD_IN, MT, ZZP, ZB, ZZP, CM_CD); } SEAM(9);
    if (IN(10)) REP(10) { REP(18) ph_mla(ZB, GT, a.in[17], DCT, DN, STAT, lds, tid, lane, wave, vcu, G);
                  REP(19) ph_attn_prep(ZB, a.in[19], a.in[20], QA, KA, VA, gw, NGW, lane); } SEAM(10);
    if (IN(11)) REP(11) { REP(20) ph_mls(DCT, DN, STAT, CTS, NS, MPREV, vcu, tid);
                  const attn_body::AttnTensors AT{(const attn_body::bf16*)QA, (const attn_body::bf16*)KA, (const attn_body::bf16*)VA, (attn_body::bf16*)(MIX + 512)};
                  const attn_body::StaticOrder S(G, bx);
                  attn_body::attn_phase<attn_body::StaticOrder>((char*)lds_raw, AT, S); } SEAM(11);
    if (IN(12)) REP(12) { ph_mlo(ZB, GT, a.in[17], a.in[18], CTS, NS, MPREV, MIX, lds, tid, lane, wave, vcu, G); } SEAM(12);
    if (IN(13)) REP(13) { GEMM_PHASE(MIX, ws + WS_CD_OUT, ML, 1024, ZB, 1024, 1024); } SEAM(13);
    if (IN(14)) REP(14) { REP(22) ph_tables(a.in, ws, 1, gw, NGW, lane);
                  ph_ln1<bf16_t, bf16_t>(XS, XS + (size_t)ML * D, ZB, mod + 5 * 6144, 2048, a.in[6] + 2048, a.in[7] + 2048, XS, HA, H8, HSC, 3072, 4096, vcu * (ML / G), ML / G, lds, tid, lane, wave, HA8, SA); } SEAM(14);
    if (IN(15)) REP(15) { GEMM8_PHASE(HA8, ws + WS_WQ + (size_t)4 * MiB, ML, 2048, ZB, 2048, CM_WQ1); } SEAM(15);
    if (IN(16)) REP(16) { ph_route(ZB, a.in[23] + 2 * 128 * 128, IDXG, ML, lds, tid, lane, wave, vcu, G); }
    if (IN(16) && IN(17)) { asm volatile("s_waitcnt vmcnt(0)" ::: "memory"); __syncthreads(); }
    if (IN(17)) REP(17) { ph_gather<float>(XS, H8, HSC, IDXG, UQ, SU, VQ, FB, mod + 5 * 6144, 5120, a.in[6] + 3072, a.in[7] + 3072, a.out, nullptr, nullptr, nullptr, 0, 0, nullptr, nullptr, nullptr, ML, lds, tid, lane, wave, vcu, G); }
#undef IN
#undef SEAM
#undef GEMM_PHASE
#undef GEMM8_PHASE
}

extern "C" void kernel_launch(void* const* d_in, const int* in_sizes, int n_in, void* d_out, int out_size, void* d_ws, size_t ws_size, hipStream_t stream) {
    static int grid = 0;
    if (grid == 0) {
        if (n_in != 26 || out_size != ML * D || ws_size < WS_END) { fprintf(stderr, "kernel_launch: unexpected sizes n_in %d out %d ws %zu\n", n_in, out_size, ws_size); grid = -1; return; }
        int dev = 0, cus = 0, per_cu = 0;
        (void)hipGetDevice(&dev); (void)hipDeviceGetAttribute(&cus, hipDeviceAttributeMultiprocessorCount, dev);
        if (hipFuncSetAttribute((const void*)mk, hipFuncAttributeMaxDynamicSharedMemorySize, LDS_BYTES) != hipSuccess) { fprintf(stderr, "kernel_launch: hipFuncSetAttribute failed\n"); grid = -1; return; }
        (void)hipOccupancyMaxActiveBlocksPerMultiprocessor(&per_cu, (const void*)mk, NTHR, LDS_BYTES);
        (void)hipGetLastError();
        if (cus != 256) { fprintf(stderr, "kernel_launch: built for a 256-CU device, found %d CUs; nothing launched\n", cus); grid = -1; return; }
        if (per_cu < 1) { fprintf(stderr, "kernel_launch: occupancy query says %d blocks per CU\n", per_cu); }
        grid = cus * (per_cu < 1 ? 1 : 1);
    }
    if (grid < 0) return;
    if (hipMemsetAsync((char*)d_ws + WS_CTL, 0, CTL_ZERO_BYTES, stream) != hipSuccess) { fprintf(stderr, "kernel_launch: memset failed\n"); return; }
    Args a{}; for (int i = 0; i < 26; ++i) a.in[i] = (const float*)d_in[i]; a.out = (float*)d_out; a.ws = (unsigned char*)d_ws;
#if defined(MK_PER_PHASE)
    for (int p = 0; p < N_PHASES; ++p) { a.ph_lo = p; a.ph_hi = p + 1; hipLaunchKernelGGL(mk, dim3(grid), dim3(NTHR), LDS_BYTES, stream, a); }
#else
    a.ph_lo = 0; a.ph_hi = N_PHASES;
    void* args[] = {&a};
    hipError_t e = hipLaunchCooperativeKernel((const void*)mk, dim3(grid), dim3(NTHR), args, LDS_BYTES, stream);
    if (e != hipSuccess) fprintf(stderr, "kernel_launch: cooperative launch failed: %s (grid %d)\n", hipGetErrorString(e), grid);
#endif
}
```
